# Optimizing an MI355X kernel written in HIP

```python
import math
import jax, jax.numpy as jnp
from jax import lax
import numpy as np

D_MODEL = 1024
BATCH = 2
SEQ = 16384
DEPTH = 2
DEC_BATCH = 8
DEC_SEQ = 16
PAST_LEN = 1024

CHUNK = 64
N_EVEN = (DEPTH + 1) // 2
N_ODD = DEPTH // 2
N_HEADS = 8
KV_HEADS = 2
HEAD_DIM = 64
GROUP = N_HEADS // KV_HEADS
WINDOW = 128
BAND_PREV = WINDOW // CHUNK
ATTN_WIDTH = N_HEADS * HEAD_DIM
KV_WIDTH = KV_HEADS * HEAD_DIM
NUM_BUCKETS = 32
MAX_DISTANCE = 128
POOL_WINDOWS = (2, 4, 8, 16)
POOL_GROUPS = 4
POOL_WIDTH = D_MODEL // 2
POOL_GW = POOL_WIDTH // POOL_GROUPS
POOL_HIST = max(POOL_WINDOWS) - 1
EVEN_IN = ATTN_WIDTH + 2 * KV_WIDTH + POOL_WIDTH
MIX_WIDTH = ATTN_WIDTH + POOL_WIDTH
CONV_WIDTH = 3
CONV_HIST = CONV_WIDTH - 1
D_FF = 4 * D_MODEL
EPS = 1e-6
NEG_INF = -1e30

kernel_name = 'hybrid_swa_pool_shortconv_stream_step'


def rms_norm(x, g):
    xf = x.astype(jnp.float32)
    y = xf * lax.rsqrt(jnp.mean(xf * xf, axis=-1, keepdims=True) + EPS)
    return (y * g.astype(jnp.float32)).astype(x.dtype)


def rel_bucket(rel):
    half = NUM_BUCKETS // 2
    max_exact = half // 2
    n = jnp.abs(rel)
    large = max_exact + (jnp.log(jnp.maximum(n, 1).astype(jnp.float32) / max_exact)
                         / math.log(MAX_DISTANCE / max_exact) * (half - max_exact)).astype(jnp.int32)
    large = jnp.minimum(large, half - 1)
    return jnp.where(rel > 0, half, 0) + jnp.where(n < max_exact, n, large)


def head_bias(rel_bias, rel):
    b = rel_bias[rel_bucket(rel)].astype(jnp.float32)
    q_len, k_len = rel.shape
    return jnp.transpose(b, (2, 0, 1)).reshape(KV_HEADS, GROUP, q_len, k_len)


def sink_softmax(logits, sinks):
    s = sinks.reshape(KV_HEADS, GROUP)[:, :, None, None].astype(jnp.float32)
    m = jnp.maximum(jnp.max(logits, axis=-1, keepdims=True), s)
    e = jnp.exp(logits - m)
    return e / (jnp.sum(e, axis=-1, keepdims=True) + jnp.exp(s - m))


def banded_attention_prompt(q, k, v, sinks, rel_bias):
    B, S = q.shape[:2]
    nc = S // CHUNK
    band = (BAND_PREV + 1) * CHUNK
    qb = q.reshape(B, nc, CHUNK, KV_HEADS, GROUP, HEAD_DIM)
    pad = ((0, 0), (BAND_PREV * CHUNK, 0), (0, 0), (0, 0))
    kc = jnp.pad(k, pad).reshape(B, nc + BAND_PREV, CHUNK, KV_HEADS, HEAD_DIM)
    vc = jnp.pad(v, pad).reshape(B, nc + BAND_PREV, CHUNK, KV_HEADS, HEAD_DIM)
    kb = jnp.concatenate([kc[:, j:j + nc] for j in range(BAND_PREV + 1)], axis=2)
    vb = jnp.concatenate([vc[:, j:j + nc] for j in range(BAND_PREV + 1)], axis=2)
    logits = jnp.einsum('bnqhgd,bnkhd->bnhgqk', qb, kb).astype(jnp.float32) * (HEAD_DIM ** -0.5)
    rel = jnp.arange(band)[None, :] - BAND_PREV * CHUNK - jnp.arange(CHUNK)[:, None]
    bias = head_bias(rel_bias, rel)
    valid = (jnp.arange(nc)[:, None] - BAND_PREV + jnp.arange(band)[None, :] // CHUNK) >= 0
    logits = jnp.where(valid[None, :, None, None, None, :], logits + bias, NEG_INF)
    p = sink_softmax(logits, sinks)
    out = jnp.einsum('bnhgqk,bnkhd->bnqhgd', p.astype(v.dtype), vb)
    return out.reshape(B, S, ATTN_WIDTH)


def window_attention_sample(q, k, v, cache_k, cache_v, sinks, rel_bias):
    B, L = q.shape[:2]
    wc = cache_k.shape[1]
    k_all = jnp.concatenate([cache_k, k], axis=1)
    v_all = jnp.concatenate([cache_v, v], axis=1)
    qh = q.reshape(B, L, KV_HEADS, GROUP, HEAD_DIM)
    logits = jnp.einsum('bqhgd,bkhd->bhgqk', qh, k_all).astype(jnp.float32) * (HEAD_DIM ** -0.5)
    qpos = PAST_LEN + jnp.arange(L)
    kpos = PAST_LEN - wc + jnp.arange(wc + L)
    p = sink_softmax(logits + head_bias(rel_bias, kpos[None, :] - qpos[:, None]), sinks)
    out = jnp.einsum('bhgqk,bkhd->bqhgd', p.astype(v.dtype), v_all)
    return out.reshape(B, L, ATTN_WIDTH), k_all[:, -wc:], v_all[:, -wc:]


def multiscale_pool(u_prev, u, pos0, w_map, scale):
    B, L = u.shape[:2]
    ext = jnp.concatenate([u_prev, u], axis=1)
    cs = jnp.cumsum(ext.astype(jnp.float32), axis=1)
    cs = jnp.pad(cs, ((0, 0), (1, 0), (0, 0)))
    pos = (pos0 + jnp.arange(L)).astype(jnp.float32)[None, :, None]
    uf = u.astype(jnp.float32)
    diffs = []
    for g, w in enumerate(POOL_WINDOWS):
        sl = slice(g * POOL_GW, (g + 1) * POOL_GW)
        s = cs[:, POOL_HIST + 1:, sl] - cs[:, POOL_HIST + 1 - w:POOL_HIST + 1 - w + L, sl]
        cnt = jnp.minimum(pos + 1.0, float(w))
        diffs.append(s / cnt - uf[..., sl])
    d = jnp.stack(diffs, axis=2).astype(u.dtype)
    y = jnp.einsum('blgc,gcd->blgd', d, w_map).reshape(B, L, POOL_WIDTH) * scale
    return y, ext[:, -POOL_HIST:]


def short_conv_mixer(xn, conv_prev, w_in, w_conv, w_out):
    L = xn.shape[1]
    b, c, h = jnp.split(xn @ w_in, 3, axis=-1)
    ext = jnp.concatenate([conv_prev, c * h], axis=1)
    y = sum(w_conv[j] * ext[:, j:j + L] for j in range(CONV_WIDTH))
    return (b * y) @ w_out, ext[:, -CONV_HIST:]


def sq_relu_mlp(xn, w1, w2):
    return jnp.square(jax.nn.relu(xn @ w1)) @ w2


def trunk(x, cache_k, cache_v, st_pool, st_conv, win, pos0, weights):
    (norm_mix, norm_ffn, ffn_w1, ffn_w2, ev_w_in, ev_w_out, q_norm, k_norm, attn_sinks,
     rel_bias, pool_w, pool_scale, conv_w_in, conv_w, conv_w_out) = weights
    prompt = cache_k is None
    B, L = x.shape[:2]
    nk, nv, npool, nconv = [], [], [], []
    for l in range(DEPTH):
        i = l // 2
        xn = rms_norm(x, norm_mix[l])
        if l % 2 == 0:
            q, k, v, u = jnp.split(xn @ ev_w_in[i], [ATTN_WIDTH, ATTN_WIDTH + KV_WIDTH, ATTN_WIDTH + 2 * KV_WIDTH], axis=-1)
            q = rms_norm(q.reshape(B, L, N_HEADS, HEAD_DIM), q_norm[i])
            k = rms_norm(k.reshape(B, L, KV_HEADS, HEAD_DIM), k_norm[i])
            v = v.reshape(B, L, KV_HEADS, HEAD_DIM)
            if prompt:
                a = banded_attention_prompt(q, k, v, attn_sinks[i], rel_bias)
                k_new, v_new = k[:, -win:], v[:, -win:]
                u_prev = jnp.zeros((B, POOL_HIST, POOL_WIDTH), u.dtype)
            else:
                a, k_new, v_new = window_attention_sample(q, k, v, cache_k[i], cache_v[i], attn_sinks[i], rel_bias)
                u_prev = st_pool[i]
            p, pool_new = multiscale_pool(u_prev, u, pos0, pool_w[i], pool_scale[i])
            y = jnp.concatenate([a, p], axis=-1) @ ev_w_out[i]
            nk.append(k_new); nv.append(v_new); npool.append(pool_new)
        else:
            conv_prev = jnp.zeros((B, CONV_HIST, D_MODEL), x.dtype) if prompt else st_conv[i]
            y, conv_new = short_conv_mixer(xn, conv_prev, conv_w_in[i], conv_w[i], conv_w_out[i])
            nconv.append(conv_new)
        x = x + y
        x = x + sq_relu_mlp(rms_norm(x, norm_ffn[l]), ffn_w1[l], ffn_w2[l])
    return x, jnp.stack(nk), jnp.stack(nv), jnp.stack(npool), jnp.stack(nconv)


def setup_inputs(seed: int = 0) -> dict:
    key = jax.random.key(seed)
    ks = jax.random.split(key, 24)
    f32 = jnp.float32
    nrm = lambda k, shape, s: jax.random.normal(k, shape, f32) * s
    win = min(WINDOW, PAST_LEN)
    return {
        'x_prompt': nrm(ks[0], (BATCH, SEQ, D_MODEL), 1.0),
        'x_sample': nrm(ks[1], (DEC_BATCH, DEC_SEQ, D_MODEL), 1.0),
        'cache_k': nrm(ks[2], (N_EVEN, DEC_BATCH, win, KV_HEADS, HEAD_DIM), 1.0),
        'cache_v': nrm(ks[3], (N_EVEN, DEC_BATCH, win, KV_HEADS, HEAD_DIM), 1.0),
        'state_pool': nrm(ks[4], (N_EVEN, DEC_BATCH, POOL_HIST, POOL_WIDTH), 1.0),
        'state_conv': nrm(ks[5], (N_ODD, DEC_BATCH, CONV_HIST, D_MODEL), 1.0),
        'norm_mix': 1.0 + nrm(ks[6], (DEPTH, D_MODEL), 0.05),
        'norm_ffn': 1.0 + nrm(ks[7], (DEPTH, D_MODEL), 0.05),
        'ffn_w1': nrm(ks[8], (DEPTH, D_MODEL, D_FF), D_MODEL ** -0.5),
        'ffn_w2': nrm(ks[9], (DEPTH, D_FF, D_MODEL), D_FF ** -0.5),
        'ev_w_in': nrm(ks[10], (N_EVEN, D_MODEL, EVEN_IN), D_MODEL ** -0.5),
        'ev_w_out': nrm(ks[11], (N_EVEN, MIX_WIDTH, D_MODEL), MIX_WIDTH ** -0.5),
        'q_norm': 1.0 + nrm(ks[12], (N_EVEN, HEAD_DIM), 0.05),
        'k_norm': 1.0 + nrm(ks[13], (N_EVEN, HEAD_DIM), 0.05),
        'attn_sinks': nrm(ks[14], (N_EVEN, N_HEADS), 0.5),
        'rel_bias': nrm(ks[15], (NUM_BUCKETS, N_HEADS), 0.5),
        'pool_w': nrm(ks[16], (N_EVEN, POOL_GROUPS, POOL_GW, POOL_GW), POOL_GW ** -0.5),
        'pool_scale': 1.0 + nrm(ks[17], (N_EVEN, POOL_WIDTH), 0.1),
        'conv_w_in': nrm(ks[18], (N_ODD, D_MODEL, 3 * D_MODEL), D_MODEL ** -0.5),
        'conv_w': nrm(ks[19], (N_ODD, CONV_WIDTH, D_MODEL), 0.5),
        'conv_w_out': nrm(ks[20], (N_ODD, D_MODEL, D_MODEL), D_MODEL ** -0.5),
    }


def reference(x_prompt, x_sample, cache_k, cache_v, state_pool, state_conv, norm_mix, norm_ffn, ffn_w1, ffn_w2,
              ev_w_in, ev_w_out, q_norm, k_norm, attn_sinks, rel_bias, pool_w, pool_scale, conv_w_in, conv_w, conv_w_out):
    weights = (norm_mix, norm_ffn, ffn_w1, ffn_w2, ev_w_in, ev_w_out, q_norm, k_norm, attn_sinks,
               rel_bias, pool_w, pool_scale, conv_w_in, conv_w, conv_w_out)
    win = cache_k.shape[2]
    y_prompt, k_p, v_p, pool_p, conv_p = trunk(x_prompt, None, None, None, None, win, 0, weights)
    y_sample, k_s, v_s, pool_s, conv_s = trunk(x_sample, cache_k, cache_v, state_pool, state_conv, win, PAST_LEN, weights)
    return (y_prompt, y_sample, k_p, v_p, pool_p, conv_p, k_s, v_s, pool_s, conv_s)
```

```cpp
#include <hip/hip_runtime.h>
#include <cstdio>
#include <cstdint>

#define LAS __attribute__((address_space(3)))
#define GAS __attribute__((address_space(1)))
typedef unsigned short bf16;
typedef short bf16x8 __attribute__((ext_vector_type(8)));
typedef short s16x4 __attribute__((ext_vector_type(4)));
typedef float f32x2 __attribute__((ext_vector_type(2)));
typedef float f32x4 __attribute__((ext_vector_type(4)));
typedef float f32x16 __attribute__((ext_vector_type(16)));
typedef unsigned u32x2 __attribute__((ext_vector_type(2)));
typedef unsigned u32x4 __attribute__((ext_vector_type(4)));
typedef __bf16 bf16x2_t __attribute__((ext_vector_type(2)));

#ifndef MK_N_LAUNCHES
#define MK_N_LAUNCHES 1
#endif
constexpr int NPH = 11;
constexpr int N_LAUNCHES = MK_N_LAUNCHES;
static_assert(N_LAUNCHES == 1 || N_LAUNCHES == NPH, "MK_N_LAUNCHES is 1 or 11");

constexpr int DM = 1024, SEQ = 16384, NBATCH = 2, MPR = NBATCH * SEQ, MSR = 128, MT = MPR + MSR, NTILE = 128;
constexpr int EVIN = 1280, DFF = 4096, CIN = 3072;
constexpr float EPS = 1e-6f, LOG2E = 1.4426950408889634f, QSCALE = 0.125f * 1.4426950408889634f;
constexpr size_t O_YP = 0, O_YS = 33554432, O_KP = 33685504, O_VP = 33718272, O_PP = 33751040, O_CP = 33766400, O_KS = 33770496, O_VS = 33901568, O_PS = 34032640, O_CS = 34094080, O_END = 34110464;
constexpr size_t KiB = 1024, MiB = 1024 * 1024;
constexpr size_t WS_CTL = 0, CTL_ZERO_BYTES = 256 * KiB;
constexpr size_t WS_RINV0 = 256 * KiB;
constexpr size_t WS_SS = 512 * KiB;
constexpr size_t WS_POOLW = 2816 * KiB;
constexpr size_t WS_WIN = 3 * MiB;
constexpr size_t WS_WOUT = WS_WIN + 2560 * KiB;
constexpr size_t WS_W1 = WS_WOUT + 2 * MiB;
constexpr size_t WS_W2 = WS_W1 + 8 * MiB;
constexpr size_t WS_WCIN = WS_W2 + 8 * MiB;
constexpr size_t WS_WCOUT = WS_WCIN + 6 * MiB;
constexpr size_t WS_S0 = 32 * MiB;
constexpr size_t WS_S1 = WS_S0 + 65 * MiB;
constexpr size_t WS_QKVU = WS_S1 + 65 * MiB;
constexpr size_t WS_H = WS_QKVU + 81 * MiB;
constexpr size_t WS_W2B = WS_H + 257 * MiB;
constexpr size_t WS_END = WS_W2B + 8 * MiB;
static_assert(WS_WCOUT + 2 * MiB <= WS_S0 && (size_t)MT * 2048 <= 65 * MiB && (size_t)MT * 2560 <= 81 * MiB && (size_t)MT * 8192 <= 257 * MiB && WS_END <= 512 * MiB, "ws map");
static_assert(WS_SS + (size_t)MT * 64 + 128 * 32 * 4 <= WS_POOLW, "ws map ss (+ the sample rows' 32-slot table behind it)");
constexpr int CW_BAR = 4096;

__device__ __forceinline__ unsigned pk2(float lo, float hi) { f32x2 v = {lo, hi}; bf16x2_t b = __builtin_convertvector(v, bf16x2_t); return __builtin_bit_cast(unsigned, b); }
__device__ __forceinline__ u32x4 pk8(f32x4 a, f32x4 b) { u32x4 w; w.x = pk2(a[0], a[1]); w.y = pk2(a[2], a[3]); w.z = pk2(b[0], b[1]); w.w = pk2(b[2], b[3]); return w; }
__device__ __forceinline__ float bf_lo(unsigned w) { return __uint_as_float(w << 16); }
__device__ __forceinline__ float bf_hi(unsigned w) { return __uint_as_float(w & 0xffff0000u); }
__device__ __forceinline__ float sq4(f32x4 v) { return (v[0] * v[0] + v[1] * v[1]) + (v[2] * v[2] + v[3] * v[3]); }
__device__ __forceinline__ float wave_sum(float v) {
#pragma unroll
    for (int o = 1; o < 64; o <<= 1) v += __shfl_xor(v, o);
    return v;
}
__device__ __forceinline__ size_t qk_off(size_t r, int c) { return (r >> 8) * (size_t)(256 * 1280) + (size_t)(c >> 5) * 8192 + (r & 255) * 32 + (c & 31); }
__device__ __forceinline__ size_t be_off(size_t r, int c) { return (r >> 8) * (size_t)(256 * 2048) + (size_t)(c >> 5) * 8192 + (r & 255) * 32 + (c & 31); }
#define LDS_WAIT() asm volatile("s_waitcnt lgkmcnt(0)" ::: "memory")
#define VM_WAIT() asm volatile("s_waitcnt vmcnt(0)" ::: "memory")

namespace pg8 {
constexpr int RVT_UNITS_ = 12;
constexpr int BM = 256, BK = 64, HALF = 128, HTB = HALF * BK * 2, STAGE_BYTES = 8 * HTB, NXCD = 8, WGM = 8;
__host__ __device__ __forceinline__ int lds_byte(int r, int c) { const int st = (r >> 4) * 2 + (c >> 5), rr = r & 15, cc = c & 31, ob = rr * 64 + cc * 2; return st * 1024 + (ob ^ (((ob >> 9) & 1) << 5)); }
__host__ __device__ __forceinline__ void stage_rc(int b, int& R, int& C) { const int st = b / 1024, sb = b % 1024, swz = sb ^ (((sb >> 9) & 1) << 5); R = (st >> 1) * 16 + swz / 64; C = (st & 1) * 32 + (swz % 64) / 2; }
__host__ __device__ __forceinline__ int perm32(int rho) { const int n = rho >> 4, i = rho & 15; return 8 * (i >> 2) + 4 * n + (i & 3); }
struct Unit { int pm, pn, idx; };
struct StaticOrder {
    int nM, nN, nwg, G, c;
    __device__ void init(int nM_, int nN_, int G_, int c_) { nM = nM_; nN = nN_; nwg = nM * nN; G = G_; c = c_; }
    __device__ bool next(int i, Unit& u) const {
        const long L = (long)i * G + c; if (L >= nwg) return false;
        int wgid = (int)L; { const int q = nwg / NXCD, r = nwg % NXCD, xcd = wgid % NXCD, off = wgid / NXCD; wgid = (xcd < r ? xcd * (q + 1) : r * (q + 1) + (xcd - r) * q) + off; }
        const int nig = WGM * nN, gid = wgid / nig, fm = gid * WGM, gsz = (nM - fm) < WGM ? (nM - fm) : WGM;
        u.pm = fm + ((wgid % nig) % gsz); u.pn = (wgid % nig) / gsz; return true;
    }
};
template <int K> struct MapPlain {
    static constexpr int BMODE = 0; static constexpr bool ATILE = false;
    const char* A; const char* Bt;
    __device__ __forceinline__ void ptrs(const Unit& u, const char*& a, size_t& aH, const char*& b, size_t& bH) const {
        a = A + (size_t)u.pm * 256 * K * 2; aH = (size_t)128 * K * 2;
        b = Bt + (size_t)u.pn * 256 * K * 2; bH = (size_t)128 * K * 2; }
};
template <int K> struct MapHead {
    static constexpr int BMODE = 1; static constexpr bool ATILE = false;
    const char* A; const char* Bt;
    __device__ __forceinline__ void ptrs(const Unit& u, const char*& a, size_t& aH, const char*& b, size_t& bH) const {
        a = A + (size_t)u.pm * 256 * K * 2; aH = (size_t)128 * K * 2;
        b = Bt + (size_t)u.pn * 256 * K * 2; bH = (size_t)32 * K * 2; }
};
template <int K> struct MapHeadAT {
    static constexpr int BMODE = 1; static constexpr bool ATILE = true;
    const char* A; const char* Bt;
    __device__ __forceinline__ void ptrs(const Unit& u, const char*& a, size_t& aH, const char*& b, size_t& bH) const {
        a = A + (size_t)u.pm * 256 * K * 2; aH = (size_t)128 * 32 * 2;
        b = Bt + (size_t)u.pn * 256 * K * 2; bH = (size_t)32 * K * 2; }
};
template <int K> struct MapConvIn {
    static constexpr int BMODE = 0; static constexpr bool ATILE = false;
    const char* A; const char* Bt;
    __device__ __forceinline__ void ptrs(const Unit& u, const char*& a, size_t& aH, const char*& b, size_t& bH) const {
        a = A + (size_t)u.pm * 256 * K * 2; aH = (size_t)128 * K * 2;
        if (u.pn < 4) { b = Bt + (size_t)u.pn * 256 * K * 2; bH = (size_t)128 * K * 2; }
        else { b = Bt + (size_t)(1024 + 128 * (u.pn - 4)) * K * 2; bH = (size_t)1024 * K * 2; } }
};

template <int K, class Epi, class Map>
__device__ __forceinline__ void gemm_phase(LAS unsigned char* lds, const Map& MPp, const StaticOrder& S, const Epi& E) {
    int tid = threadIdx.x; asm volatile("" : "+v"(tid));
    const int wid = __builtin_amdgcn_readfirstlane(tid >> 6), lane = tid & 63, wr = wid >> 2, wc = wid & 3, fr = lane & 15, fq = lane >> 4;
    constexpr int nt = K / BK;
    unsigned voffA[2], voffB[2];
#pragma unroll
    for (int i = 0; i < 2; ++i) { int R, C; stage_rc(tid * 16 + i * 8192, R, C);
        const int Rb = (Map::BMODE == 1) ? (64 * (R >> 5) + perm32(R & 31)) : ((R & ~31) + perm32(R & 31));
        voffA[i] = Map::ATILE ? (unsigned)((C >> 5) * 8192 + R * 32 + (C & 31)) * 2u : (unsigned)(R * K + C) * 2u; voffB[i] = (unsigned)(Rb * K + C) * 2u; }
    const size_t kstep = (size_t)(BK * 2), kstepA = Map::ATILE ? (size_t)(256 * 64 * 2) : (size_t)(BK * 2);
    const unsigned ldsw = (unsigned)wid * 1024u;
    const int aoff = lds_byte(wr * 64 + fr, fq * 8), boff = lds_byte(wc * 32 + fr, fq * 8);
#define PG8_SA(b, h) (((b) * 2 + (h)) * HTB)
#define PG8_SB(b, h) ((4 + (b) * 2 + (h)) * HTB)
#define PG8_STAGE(bufoff, gbase, voff) do { _Pragma("unroll") for (int _i = 0; _i < 2; ++_i) \
        __builtin_amdgcn_global_load_lds((const unsigned*)((const char*)(gbase) + (voff)[_i]), (LAS unsigned*)(lds + (bufoff) + ldsw + _i * 8192), 16, 0, 0); } while (0)
#define PG8_LDA(dst, b, h) do { _Pragma("unroll") for (int m = 0; m < 4; ++m) _Pragma("unroll") for (int k = 0; k < 2; ++k) dst[m][k] = *(const LAS bf16x8*)(lds + PG8_SA(b, h) + aoff + m * 2048 + k * 1024); } while (0)
#define PG8_LDB(dst, b, h) do { _Pragma("unroll") for (int n = 0; n < 2; ++n) _Pragma("unroll") for (int k = 0; k < 2; ++k) dst[n][k] = *(const LAS bf16x8*)(lds + PG8_SB(b, h) + boff + n * 2048 + k * 1024); } while (0)
#define PG8_MMA(ai, bj, At, Bt) do { __builtin_amdgcn_s_setprio(1); _Pragma("unroll") for (int m = 0; m < 4; ++m) _Pragma("unroll") for (int n = 0; n < 2; ++n) _Pragma("unroll") for (int k = 0; k < 2; ++k) \
        acc[ai][bj][m][n] = __builtin_amdgcn_mfma_f32_16x16x32_bf16(Bt[n][k], At[m][k], acc[ai][bj][m][n], 0, 0, 0); __builtin_amdgcn_s_setprio(0); } while (0)
#define PG8_WAIT_V(n) asm volatile("s_waitcnt vmcnt(" #n ")" ::: "memory")
#define PG8_WAIT_L(n) asm volatile("s_waitcnt lgkmcnt(" #n ")" ::: "memory")
#define PG8_BAR __builtin_amdgcn_s_barrier()
#define PG8_SCHED __builtin_amdgcn_sched_barrier(0)
    Unit cur, nxt; int ui = 0; cur.idx = 0;
    if (!S.next(0, cur)) return;
    f32x4 acc[2][2][4][2];
#pragma unroll
    for (int a = 0; a < 2; ++a)
#pragma unroll
        for (int b = 0; b < 2; ++b)
#pragma unroll
            for (int m = 0; m < 4; ++m)
#pragma unroll
                for (int n = 0; n < 2; ++n) acc[a][b][m][n] = (f32x4){0.f, 0.f, 0.f, 0.f};
    bf16x8 At[4][2], B0[2][2], B1[2][2];
    const char* cA; const char* cB; size_t cAH, cBH;
    MPp.ptrs(cur, cA, cAH, cB, cBH);
    PG8_STAGE(PG8_SB(0, 0), cB, voffB); PG8_STAGE(PG8_SB(0, 1), cB + cBH, voffB); PG8_STAGE(PG8_SA(0, 0), cA, voffA); PG8_STAGE(PG8_SA(0, 1), cA + cAH, voffA);
    if (wr == 1) PG8_BAR;
    PG8_WAIT_V(2); PG8_BAR;
    PG8_STAGE(PG8_SB(1, 0), cB + kstep, voffB); PG8_STAGE(PG8_SA(1, 0), cA + kstepA, voffA); PG8_STAGE(PG8_SB(1, 1), cB + cBH + kstep, voffB);
    PG8_WAIT_V(6); PG8_BAR;
    for (;;) {
        const bool has_next = S.next(ui + 1, nxt); nxt.idx = ui + 1;
        const char* nA = cA; const char* nB = cB; size_t nAH = cAH, nBH = cBH;
        if (has_next) MPp.ptrs(nxt, nA, nAH, nB, nBH);
        for (int t = 0; t < nt; t += 2) {
            const bool last = (t == nt - 2);
            const char* a1 = cA + (size_t)(t + 1) * kstepA;
            const char* a2 = last ? nA : cA + (size_t)(t + 2) * kstepA; const char* b2 = last ? nB : cB + (size_t)(t + 2) * kstep;
            const size_t a2H = last ? nAH : cAH, b2H = last ? nBH : cBH;
            const char* a3 = a2 + kstepA; const char* b3 = b2 + kstep;
            PG8_LDB(B0, 0, 0); PG8_LDB(B1, 0, 1); PG8_SCHED; PG8_LDA(At, 0, 0); PG8_STAGE(PG8_SA(1, 1), a1 + cAH, voffA);
            PG8_WAIT_V(8); PG8_WAIT_L(0); PG8_BAR; PG8_MMA(0, 0, At, B0); PG8_MMA(0, 1, At, B1); PG8_BAR; PG8_SCHED;
            PG8_LDA(At, 0, 1); PG8_STAGE(PG8_SB(0, 0), b2, voffB); PG8_STAGE(PG8_SB(0, 1), b2 + b2H, voffB); PG8_STAGE(PG8_SA(0, 0), a2, voffA);
            PG8_WAIT_V(8); PG8_WAIT_L(0); PG8_BAR; PG8_MMA(1, 0, At, B0); PG8_MMA(1, 1, At, B1); PG8_BAR; PG8_SCHED;
            PG8_LDB(B0, 1, 0); PG8_LDB(B1, 1, 1); PG8_SCHED; PG8_LDA(At, 1, 0); PG8_STAGE(PG8_SA(0, 1), a2 + a2H, voffA);
            PG8_WAIT_V(8); PG8_WAIT_L(0); PG8_BAR; PG8_MMA(0, 0, At, B0); PG8_MMA(0, 1, At, B1); PG8_BAR; PG8_SCHED;
            PG8_LDA(At, 1, 1); PG8_STAGE(PG8_SB(1, 0), b3, voffB); PG8_STAGE(PG8_SB(1, 1), b3 + b2H, voffB); PG8_STAGE(PG8_SA(1, 0), a3, voffA);
            PG8_WAIT_V(8); PG8_WAIT_L(0); PG8_BAR; PG8_MMA(1, 0, At, B0); PG8_MMA(1, 1, At, B1); PG8_BAR; PG8_SCHED;
        }
        if (wr == 0) PG8_BAR;
        E(acc, cur, wr, wc, fr, fq);
        if (!has_next) break;
#pragma unroll
        for (int a = 0; a < 2; ++a)
#pragma unroll
            for (int b = 0; b < 2; ++b)
#pragma unroll
                for (int m = 0; m < 4; ++m)
#pragma unroll
                    for (int n = 0; n < 2; ++n) acc[a][b][m][n] = (f32x4){0.f, 0.f, 0.f, 0.f};
        cur = nxt; cA = nA; cB = nB; cAH = nAH; cBH = nBH; ++ui;
        if (wr == 1) PG8_BAR;
    }
    PG8_WAIT_V(0);
    PG8_BAR;
#undef PG8_SA
#undef PG8_SB
#undef PG8_STAGE
#undef PG8_LDA
#undef PG8_LDB
#undef PG8_MMA
#undef PG8_WAIT_V
#undef PG8_WAIT_L
#undef PG8_BAR
#undef PG8_SCHED
}

typedef const f32x4 (&AccRef)[2][2][4][2];
struct EpiInProj {
    bf16* QKVU; const float* rinv0; const float* qn; const float* kn; float* out;
    __device__ __forceinline__ void operator()(AccRef acc, const Unit& u, int wr, int wc, int fr, int fq) const {
        asm volatile("" : "+v"(fr), "+v"(fq));
        const int pn = u.pn;
        const int cb = 256 * pn + 64 * wc;
        const int kind = pn < 2 ? 0 : (pn == 2 ? (wc < 2 ? 1 : 2) : 3);
        const int g = wc & 1;
        f32x4 gv[2][2];
#pragma unroll
        for (int bj = 0; bj < 2; ++bj)
#pragma unroll
            for (int n = 0; n < 2; ++n) gv[bj][n] = (f32x4){1.f, 1.f, 1.f, 1.f};
        if (kind <= 1) { const float* gp = kind == 0 ? qn : kn; const float sc = kind == 0 ? QSCALE : 1.f;
#pragma unroll
            for (int bj = 0; bj < 2; ++bj)
#pragma unroll
                for (int n = 0; n < 2; ++n) gv[bj][n] = *(const f32x4*)(gp + 32 * bj + 8 * fq + 4 * n) * sc; }
        float rvs[2][4];
#pragma unroll
        for (int ai = 0; ai < 2; ++ai)
#pragma unroll
            for (int m = 0; m < 4; ++m) rvs[ai][m] = rinv0[256 * u.pm + 128 * ai + 64 * wr + 16 * m + fr];
#pragma unroll
        for (int ai = 0; ai < 2; ++ai) {
#pragma unroll
            for (int m = 0; m < 4; ++m) {
                const int rt = 128 * ai + 64 * wr + 16 * m + fr; const int r = 256 * u.pm + rt;
                const float rv = rvs[ai][m];
                f32x4 v[2][2];
#pragma unroll
                for (int bj = 0; bj < 2; ++bj)
#pragma unroll
                    for (int n = 0; n < 2; ++n) v[bj][n] = acc[ai][bj][m][n] * rv;
                if (kind <= 1) {
                    float ss = (sq4(v[0][0]) + sq4(v[0][1])) + (sq4(v[1][0]) + sq4(v[1][1]));
                    ss += __shfl_xor(ss, 16); ss += __shfl_xor(ss, 32);
                    const float rn = rsqrtf(ss * (1.0f / 64.0f) + EPS);
#pragma unroll
                    for (int bj = 0; bj < 2; ++bj)
#pragma unroll
                        for (int n = 0; n < 2; ++n) v[bj][n] = v[bj][n] * rn * gv[bj][n];
                }
                bf16* rowp = QKVU + qk_off((size_t)r, cb + 8 * fq);
#pragma unroll
                for (int bj = 0; bj < 2; ++bj) *(u32x4*)(rowp + 8192 * bj) = pk8(v[bj][0], v[bj][1]);
                if (kind == 1 || kind == 2) {
                    float* dst = nullptr;
                    if (ai == 1 && (u.pm & 63) == 63) { const int bb = u.pm >> 6, j = rt - 128; dst = out + (kind == 1 ? O_KP : O_VP) + ((size_t)(bb * 128 + j) * 2 + g) * 64; }
                    if (dst) {
#pragma unroll
                        for (int bj = 0; bj < 2; ++bj)
#pragma unroll
                            for (int n = 0; n < 2; ++n) *(f32x4*)(dst + 32 * bj + 8 * fq + 4 * n) = v[bj][n]; }
                } else if (kind == 3) {
                    const int ucol = 256 * (pn - 3) + 64 * wc + 8 * fq;
                    float* dst = nullptr;
                    if (ai == 1 && (u.pm & 63) == 63 && rt >= 241) { const int bb = u.pm >> 6; dst = out + O_PP + (size_t)(bb * 15 + rt - 241) * 512 + ucol; }
                    if (dst) {
#pragma unroll
                        for (int bj = 0; bj < 2; ++bj)
#pragma unroll
                            for (int n = 0; n < 2; ++n) *(f32x4*)(dst + 32 * bj + 4 * n) = v[bj][n]; }
                }
            }
        }
    }
};
__device__ __forceinline__ f32x4 bf4_lo(u32x4 w) { return (f32x4){bf_lo(w.x), bf_hi(w.x), bf_lo(w.y), bf_hi(w.y)}; }
__device__ __forceinline__ f32x4 bf4_hi(u32x4 w) { return (f32x4){bf_lo(w.z), bf_hi(w.z), bf_lo(w.w), bf_hi(w.w)}; }
template <int MODE> struct EpiResid {
    const float* xin_f; bf16* XR; float* SS; float* yout;
    __device__ __forceinline__ void operator()(AccRef acc, const Unit& u, int wr, int wc, int fr, int fq) const {
        asm volatile("" : "+v"(fr), "+v"(fq));
        const int c0 = 256 * u.pn + 64 * wc + 8 * fq;
        const size_t rbase = (size_t)256 * u.pm + 64 * wr + fr;
        if (MODE == 0) {
#pragma unroll
            for (int ai = 0; ai < 2; ++ai) {
                f32x4 xr[4][2][2];
#pragma unroll
                for (int m = 0; m < 4; ++m)
#pragma unroll
                    for (int bj = 0; bj < 2; ++bj) { const float* p = xin_f + (rbase + 128 * ai + 16 * m) * DM + c0 + 32 * bj; xr[m][bj][0] = *(const f32x4*)p; xr[m][bj][1] = *(const f32x4*)(p + 4); }
#pragma unroll
                for (int m = 0; m < 4; ++m) { const size_t r = rbase + 128 * ai + 16 * m; float ss = 0.f;
#pragma unroll
                    for (int bj = 0; bj < 2; ++bj) { const f32x4 v0 = acc[ai][bj][m][0] + xr[m][bj][0], v1 = acc[ai][bj][m][1] + xr[m][bj][1]; ss += sq4(v0) + sq4(v1);
                        *(u32x4*)(XR + r * DM + c0 + 32 * bj) = pk8(v0, v1); }
                    ss += __shfl_xor(ss, 16); ss += __shfl_xor(ss, 32); if (fq == 0) SS[r * 16 + 4 * u.pn + wc] = ss; }
            }
        } else {
            u32x4 xr[2][4][2];
#pragma unroll
            for (int ai = 0; ai < 2; ++ai)
#pragma unroll
                for (int m = 0; m < 4; ++m)
#pragma unroll
                    for (int bj = 0; bj < 2; ++bj) xr[ai][m][bj] = *(const u32x4*)(XR + (rbase + 128 * ai + 16 * m) * DM + c0 + 32 * bj);
#pragma unroll
            for (int ai = 0; ai < 2; ++ai)
#pragma unroll
                for (int m = 0; m < 4; ++m) { const size_t r = rbase + 128 * ai + 16 * m; float ss = 0.f;
#pragma unroll
                    for (int bj = 0; bj < 2; ++bj) { const f32x4 v0 = acc[ai][bj][m][0] + bf4_lo(xr[ai][m][bj]), v1 = acc[ai][bj][m][1] + bf4_hi(xr[ai][m][bj]);
                        if (MODE == 1) { ss += sq4(v0) + sq4(v1); *(u32x4*)(XR + r * DM + c0 + 32 * bj) = pk8(v0, v1); }
                        else { float* yp = yout + r * DM + c0 + 32 * bj; *(f32x4*)yp = v0; *(f32x4*)(yp + 4) = v1; } }
                    if (MODE == 1) { ss += __shfl_xor(ss, 16); ss += __shfl_xor(ss, 32); if (fq == 0) SS[r * 16 + 4 * u.pn + wc] = ss; } }
        }
    }
};
__device__ __forceinline__ float row_rinv(const float* SS, size_t r, int fq) {
    const f32x4 s4 = *(const f32x4*)(SS + r * 16 + 4 * fq); float s = (s4[0] + s4[1]) + (s4[2] + s4[3]);
    s += __shfl_xor(s, 16); s += __shfl_xor(s, 32);
    return rsqrtf(s * (1.0f / 1024.0f) + EPS);
}
__device__ __forceinline__ void rows_rinv(const float* SS, size_t rbase, int fq, float (&rv)[2][4]) {
    f32x4 s4[2][4];
#pragma unroll
    for (int ai = 0; ai < 2; ++ai)
#pragma unroll
        for (int m = 0; m < 4; ++m) s4[ai][m] = *(const f32x4*)(SS + (rbase + 128 * ai + 16 * m) * 16 + 4 * fq);
#pragma unroll
    for (int ai = 0; ai < 2; ++ai)
#pragma unroll
        for (int m = 0; m < 4; ++m) { float t = (s4[ai][m][0] + s4[ai][m][1]) + (s4[ai][m][2] + s4[ai][m][3]); t += __shfl_xor(t, 16); t += __shfl_xor(t, 32); rv[ai][m] = rsqrtf(t * (1.0f / 1024.0f) + EPS); }
}
struct EpiUp {
    bf16* H; const LAS float* rvt; const float* SS;
    __device__ __forceinline__ void operator()(AccRef acc, const Unit& u, int wr, int wc, int fr, int fq) const {
        asm volatile("" : "+v"(fr), "+v"(fq));
        const int c0 = 256 * u.pn + 64 * wc + 8 * fq;
        float rvs[2][4];
        if (u.idx < RVT_UNITS_) {
#pragma unroll
            for (int ai = 0; ai < 2; ++ai)
#pragma unroll
                for (int m = 0; m < 4; ++m) rvs[ai][m] = rvt[u.idx * 256 + 128 * ai + 64 * wr + 16 * m + fr];
        } else rows_rinv(SS, (size_t)256 * u.pm + 64 * wr + fr, fq, rvs);
#pragma unroll
        for (int ai = 0; ai < 2; ++ai) {
#pragma unroll
            for (int m = 0; m < 4; ++m) {
                const size_t r = (size_t)256 * u.pm + 128 * ai + 64 * wr + 16 * m + fr;
                const float rv = rvs[ai][m];
#pragma unroll
                for (int bj = 0; bj < 2; ++bj) {
                    f32x4 v0 = acc[ai][bj][m][0] * rv, v1 = acc[ai][bj][m][1] * rv;
#pragma unroll
                    for (int i = 0; i < 4; ++i) { const float a = fmaxf(v0[i], 0.f), b = fmaxf(v1[i], 0.f); v0[i] = a * a; v1[i] = b * b; }
                    *(u32x4*)(H + (size_t)u.pm * 256 * DFF + (size_t)(8 * u.pn + 2 * wc + bj) * 8192 + (size_t)(128 * ai + 64 * wr + 16 * m + fr) * 32 + 8 * fq) = pk8(v0, v1);
                }
            }
        }
    }
};
struct EpiConvIn {
    bf16* BE; const LAS float* rvt; const float* SS; float* out;
    __device__ __forceinline__ void operator()(AccRef acc, const Unit& u, int wr, int wc, int fr, int fq) const {
        asm volatile("" : "+v"(fr), "+v"(fq));
        const int pn = u.pn;
        float rvs[2][4];
        if (u.idx < RVT_UNITS_) {
#pragma unroll
            for (int ai = 0; ai < 2; ++ai)
#pragma unroll
                for (int m = 0; m < 4; ++m) rvs[ai][m] = rvt[u.idx * 256 + 128 * ai + 64 * wr + 16 * m + fr];
        } else rows_rinv(SS, (size_t)256 * u.pm + 64 * wr + fr, fq, rvs);
#pragma unroll
        for (int ai = 0; ai < 2; ++ai) {
#pragma unroll
            for (int m = 0; m < 4; ++m) {
                const int rt = 128 * ai + 64 * wr + 16 * m + fr; const size_t r = (size_t)256 * u.pm + rt;
                const float rv = rvs[ai][m];
                if (pn < 4) {
#pragma unroll
                    for (int bj = 0; bj < 2; ++bj) *(u32x4*)(BE + be_off(r, 256 * pn + 128 * bj + 32 * wc + 8 * fq)) = pk8(acc[ai][bj][m][0] * rv, acc[ai][bj][m][1] * rv);
                } else {
                    const int ch0 = 128 * (pn - 4) + 32 * wc + 8 * fq;
                    const f32x4 e0 = (acc[ai][0][m][0] * rv) * (acc[ai][1][m][0] * rv), e1 = (acc[ai][0][m][1] * rv) * (acc[ai][1][m][1] * rv);
                    *(u32x4*)(BE + be_off(r, 1024 + ch0)) = pk8(e0, e1);
                    float* dst = nullptr;
                    if (ai == 1 && (u.pm & 63) == 63 && rt >= 254) { const int bb = u.pm >> 6; dst = out + O_CP + (size_t)(bb * 2 + rt - 254) * 1024 + ch0; }
                    if (dst) { *(f32x4*)dst = e0; *(f32x4*)(dst + 4) = e1; }
                }
            }
        }
    }
};
}


template <int K, int NF, int KS, class BRow, class Epi>
__device__ __forceinline__ void sample_gemm(LAS unsigned char* lds, const bf16* As, const int n_items, const int first, const int stride, const BRow& brow, const Epi& E, int lane, const int wave) {
    asm volatile("" : "+v"(lane));
    const int fr = lane & 15, fq = lane >> 4;
    constexpr int KQ = K / KS, UPI = (KS == 4) ? 4 : 8;
    for (int un = first; un < n_items * UPI; un += stride) {
        const int item = (KS == 4) ? (un >> 2) : (un >> 3), rg = (KS == 4) ? (un & 3) : ((un >> 1) & 3), mf = (KS == 4) ? (wave & 1) : (un & 1), kq = (KS == 4) ? (wave >> 1) : wave, mfs = (KS == 4) ? mf : 0;
        const int row = 32 * rg + 16 * mf + fr;
        const bf16* ap = As + (size_t)row * K + kq * KQ + 8 * fq;
        const bf16* bp[NF];
#pragma unroll
        for (int nf = 0; nf < NF; ++nf) bp[nf] = brow(item, nf) + (size_t)fr * K + kq * KQ + 8 * fq;
        f32x4 acc[NF];
#pragma unroll
        for (int nf = 0; nf < NF; ++nf) acc[nf] = (f32x4){0.f, 0.f, 0.f, 0.f};
        typename Epi::Pre pre = {};
        if (kq == 0) pre = E.pre(item, row, fr, fq);
#pragma unroll 8
        for (int ks = 0; ks < KQ / 32; ++ks) {
            const bf16x8 a = *(const bf16x8*)(ap + 32 * ks);
#pragma unroll
            for (int nf = 0; nf < NF; ++nf) { const bf16x8 b = *(const bf16x8*)(bp[nf] + 32 * ks); acc[nf] = __builtin_amdgcn_mfma_f32_16x16x32_bf16(b, a, acc[nf], 0, 0, 0); }
        }
        LAS f32x4* red = (LAS f32x4*)lds;
        if (kq > 0) {
#pragma unroll
            for (int nf = 0; nf < NF; ++nf) red[(((kq - 1) * 2 + mfs) * 64 + lane) * NF + nf] = acc[nf]; }
        __syncthreads();
        if (kq == 0) {
#pragma unroll
            for (int q = 0; q < KS - 1; ++q)
#pragma unroll
                for (int nf = 0; nf < NF; ++nf) acc[nf] += red[((q * 2 + mfs) * 64 + lane) * NF + nf];
            E(item, row, fr, fq, acc, pre);
        }
        __syncthreads();
    }
}
struct BRowPlain { const bf16* Bt; int K, NF; __device__ __forceinline__ const bf16* operator()(int item, int nf) const { return Bt + (size_t)(item * NF + nf) * 16 * K; } };
struct BRowConvIn { const bf16* Bt; __device__ __forceinline__ const bf16* operator()(int item, int nf) const { return Bt + (size_t)(1024 * nf + 16 * item) * DM; } };
struct SEpiInProj {
    bf16* QKVU; const float* rinv0; const float* qn; const float* kn; float* out;
    struct Pre { float rv; };
    __device__ __forceinline__ Pre pre(int item, int row, int fr, int fq) const { Pre p; p.rv = rinv0[(size_t)MPR + row]; return p; }
    __device__ __forceinline__ void operator()(int item, int row, int fr, int fq, f32x4 (&acc)[4], const Pre& pr) const {
        const int kind = item < 8 ? 0 : (item < 10 ? 1 : (item < 12 ? 2 : 3)), g = item & 1;
        const size_t r = (size_t)MPR + row; const float rv = pr.rv;
        f32x4 v[4];
#pragma unroll
        for (int nf = 0; nf < 4; ++nf) v[nf] = acc[nf] * rv;
        if (kind <= 1) {
            float ss = (sq4(v[0]) + sq4(v[1])) + (sq4(v[2]) + sq4(v[3]));
            ss += __shfl_xor(ss, 16); ss += __shfl_xor(ss, 32);
            const float rn = rsqrtf(ss * (1.0f / 64.0f) + EPS) * (kind == 0 ? QSCALE : 1.f); const float* gp = (kind == 0 ? qn : kn) + 4 * fq;
#pragma unroll
            for (int nf = 0; nf < 4; ++nf) v[nf] = v[nf] * rn * *(const f32x4*)(gp + 16 * nf);
        }
        bf16* rowp = QKVU + r * EVIN + 64 * item + 4 * fq;
#pragma unroll
        for (int nf = 0; nf < 4; ++nf) { u32x2 w; w.x = pk2(v[nf][0], v[nf][1]); w.y = pk2(v[nf][2], v[nf][3]); *(u32x2*)(rowp + 16 * nf) = w; }
        const int b = row >> 4, i16 = row & 15;
        float* dst = nullptr;
        if (kind == 1 || kind == 2) dst = out + (kind == 1 ? O_KS : O_VS) + ((size_t)(b * 128 + 112 + i16) * 2 + g) * 64 + 4 * fq;
        else if (kind == 3 && i16 >= 1) dst = out + O_PS + (size_t)(b * 15 + i16 - 1) * 512 + 64 * (item - 12) + 4 * fq;
        if (dst) {
#pragma unroll
            for (int nf = 0; nf < 4; ++nf) *(f32x4*)(dst + 16 * nf) = v[nf]; }
    }
};
template <int MODE, int NF> struct SEpiResid {
    const float* xin_f; bf16* XR; float* SSS; float* yout;
    struct Pre { u32x2 w[NF]; };
    __device__ __forceinline__ Pre pre(int item, int row, int fr, int fq) const { Pre p;
#pragma unroll
        for (int nf = 0; nf < NF; ++nf) p.w[nf] = *(const u32x2*)(XR + ((size_t)MPR + row) * DM + 16 * NF * item + 4 * fq + 16 * nf);
        return p; }
    __device__ __forceinline__ void operator()(int item, int row, int fr, int fq, f32x4 (&acc)[NF], const Pre& pr) const {
        const size_t r = (size_t)MPR + row; const int c = 16 * NF * item + 4 * fq;
        float ss = 0.f;
#pragma unroll
        for (int nf = 0; nf < NF; ++nf) {
            f32x4 x;
            if (MODE == 0) x = *(const f32x4*)(xin_f + (size_t)row * DM + c + 16 * nf);
            else { const u32x2 w = pr.w[nf]; x[0] = bf_lo(w.x); x[1] = bf_hi(w.x); x[2] = bf_lo(w.y); x[3] = bf_hi(w.y); }
            const f32x4 v = acc[nf] + x;
            if (MODE == 2) *(f32x4*)(yout + (size_t)row * DM + c + 16 * nf) = v;
            else { ss += sq4(v); u32x2 w; w.x = pk2(v[0], v[1]); w.y = pk2(v[2], v[3]); *(u32x2*)(XR + r * DM + c + 16 * nf) = w; }
        }
        if (MODE != 2) { static_assert(MODE == 2 || NF == 2, "32-slot layout"); ss += __shfl_xor(ss, 16); ss += __shfl_xor(ss, 32); if (fq == 0) SSS[row * 32 + item] = ss; }
    }
};
struct SRowPre { f32x4 a, b; };
__device__ __forceinline__ SRowPre srow_pre(const float* SSS, int row, int fq) { SRowPre p; p.a = *(const f32x4*)(SSS + row * 32 + 8 * fq); p.b = *(const f32x4*)(SSS + row * 32 + 8 * fq + 4); return p; }
__device__ __forceinline__ float srow_rinv(const SRowPre& p) {
    float s = ((p.a[0] + p.a[1]) + (p.a[2] + p.a[3])) + ((p.b[0] + p.b[1]) + (p.b[2] + p.b[3]));
    s += __shfl_xor(s, 16); s += __shfl_xor(s, 32);
    return rsqrtf(s * (1.0f / 1024.0f) + EPS);
}
struct SEpiUp {
    bf16* H; const float* SS;
    typedef SRowPre Pre;
    __device__ __forceinline__ Pre pre(int item, int row, int fr, int fq) const { return srow_pre(SS, row, fq); }
    __device__ __forceinline__ void operator()(int item, int row, int fr, int fq, f32x4 (&acc)[4], const Pre& pr) const {
        const size_t r = (size_t)MPR + row; const float rv = srow_rinv(pr);
#pragma unroll
        for (int nf = 0; nf < 4; ++nf) { f32x4 v = acc[nf] * rv;
#pragma unroll
            for (int i = 0; i < 4; ++i) { const float a = fmaxf(v[i], 0.f); v[i] = a * a; }
            u32x2 w; w.x = pk2(v[0], v[1]); w.y = pk2(v[2], v[3]); *(u32x2*)(H + r * DFF + 64 * item + 16 * nf + 4 * fq) = w; }
    }
};
struct SEpiConvIn {
    bf16* BE; const float* SS; float* out;
    typedef SRowPre Pre;
    __device__ __forceinline__ Pre pre(int item, int row, int fr, int fq) const { return srow_pre(SS, row, fq); }
    __device__ __forceinline__ void operator()(int item, int row, int fr, int fq, f32x4 (&acc)[3], const Pre& pr) const {
        const size_t r = (size_t)MPR + row; const float rv = srow_rinv(pr);
        const int ch0 = 16 * item + 4 * fq;
        { const f32x4 v = acc[0] * rv; u32x2 w; w.x = pk2(v[0], v[1]); w.y = pk2(v[2], v[3]); *(u32x2*)(BE + r * 2048 + ch0) = w; }
        const f32x4 e = (acc[1] * rv) * (acc[2] * rv);
        u32x2 w; w.x = pk2(e[0], e[1]); w.y = pk2(e[2], e[3]); *(u32x2*)(BE + r * 2048 + 1024 + ch0) = w;
        const int b = row >> 4, i16 = row & 15;
        if (i16 >= 14) *(f32x4*)(out + O_CS + (size_t)(b * 2 + i16 - 14) * 1024 + ch0) = e;
    }
};

#define XB_TMO      128
#define XB_XCNT(j)  (256  + 64 * (j))
#define XB_XSUB(j)  (1280 + 64 * (j))
#define XB_XGEN(j)  (2304 + 64 * (j))
#define XB_TOP      3328
#define XB_TOPGEN   3392
#define XCD_BAR_WORDS 3456
#define XB_SPIN_CAP (1u << 18)
__device__ __forceinline__ unsigned xb_ld(unsigned* p)              { return __hip_atomic_load(p, __ATOMIC_RELAXED, __HIP_MEMORY_SCOPE_AGENT); }
__device__ __forceinline__ unsigned xb_add(unsigned* p, unsigned v) { return __hip_atomic_fetch_add(p, v, __ATOMIC_RELAXED, __HIP_MEMORY_SCOPE_AGENT); }
__device__ __forceinline__ unsigned xb_xcc_id() { return (unsigned)__builtin_amdgcn_s_getreg((3 << 11) | 20) & 0xFu; }
#define XB_SPIN(cond, bar) do { unsigned _sp = 0; while (cond) { __builtin_amdgcn_s_sleep(1); \
    if ((++_sp & 255u) == 0u) { if (xb_ld(&(bar)[XB_TMO])) break; if (_sp > XB_SPIN_CAP) { atomicAdd(&(bar)[XB_TMO], 1u); break; } } } } while (0)
struct XcdBarrier { unsigned* bar; unsigned x; volatile LAS unsigned* st; };
__device__ __forceinline__ XcdBarrier xcd_barrier_post(unsigned* bar, volatile LAS unsigned* st) {
    XcdBarrier b; b.bar = bar; b.x = xb_xcc_id(); b.st = st;
    if (threadIdx.x == 0) (void)xb_add(&bar[XB_XCNT(b.x)], 1u);
    return b;
}
__device__ __forceinline__ void xcd_barrier_complete(unsigned* bar, unsigned x, unsigned& nloc, unsigned& nx) {
    const unsigned G = gridDim.x * gridDim.y * gridDim.z;
    unsigned sum, cnt, mine, sp = 0u;
    for (;;) {
        sum = 0u; cnt = 0u; mine = 0u;
#pragma unroll
        for (unsigned j = 0; j < 16; ++j) { const unsigned c = xb_ld(&bar[XB_XCNT(j)]); sum += c; cnt += (c > 0u) ? 1u : 0u; mine = (j == x) ? c : mine; }
        if (sum == G) break;
        __builtin_amdgcn_s_sleep(1);
        if ((++sp & 255u) == 0u) { if (xb_ld(&bar[XB_TMO])) break; if (sp > XB_SPIN_CAP) { atomicAdd(&bar[XB_TMO], 1u); break; } }
    }
    nloc = mine > 0u ? mine : 1u; nx = cnt > 0u ? cnt : 1u;
}
__device__ __forceinline__ void xcd_barrier(const XcdBarrier& b) {
    asm volatile("s_waitcnt vmcnt(0)" ::: "memory");
    __syncthreads();
    if (threadIdx.x == 0) {
        unsigned* bar = b.bar; asm volatile("" : "+s"(bar));
        __builtin_amdgcn_s_waitcnt(0);
        unsigned nloc = b.st[0], nx = b.st[1];
        if (nloc == 0u) { xcd_barrier_complete(bar, b.x, nloc, nx); b.st[0] = nloc; b.st[1] = nx; }
        const unsigned old = xb_add(&bar[XB_XSUB(b.x)], 1u);
        const unsigned gen = old / nloc;
        if (old + 1u == (gen + 1u) * nloc) {
            __builtin_amdgcn_fence(__ATOMIC_RELEASE, "agent");
            asm volatile("s_waitcnt vmcnt(0)" ::: "memory");
            const unsigned og = xb_add(&bar[XB_TOP], 1u);
            const unsigned tg = og / nx;
            __builtin_amdgcn_fence(__ATOMIC_ACQUIRE, "agent");
            if (og + 1u == (tg + 1u) * nx) xb_add(&bar[XB_TOPGEN], 1u);
            else XB_SPIN(xb_ld(&bar[XB_TOPGEN]) == tg, bar);
            xb_add(&bar[XB_XGEN(b.x)], 1u);
            asm volatile("s_waitcnt vmcnt(0)" ::: "memory");
        } else {
            __builtin_amdgcn_fence(__ATOMIC_ACQUIRE, "agent");
            XB_SPIN(xb_ld(&bar[XB_XGEN(b.x)]) == gen, bar);
            asm volatile("s_waitcnt vmcnt(0)" ::: "memory");
        }
    }
    __syncthreads();
}

constexpr int RING_OFF = 0, RING_BYTES = 131072;
constexpr int LDSCTL_OFF = RING_BYTES, MISC_OFF = LDSCTL_OFF + 320;
constexpr int RVT_OFF = LDSCTL_OFF + 512, RVT_UNITS = pg8::RVT_UNITS_;
constexpr int LDS_BYTES = 147456;
constexpr int AT_KL = 0, AT_VL = 24576, AT_BIAS = 49152, AT_WSF = 57344, AT_OST = 59392;
constexpr int PL_D = 0, PL_W = 32768;

__device__ __forceinline__ void build_row_scales(LAS unsigned char* lds, const pg8::StaticOrder& S, const float* SS) {
    int tid = threadIdx.x; asm volatile("" : "+v"(tid));
    LAS float* tab = (LAS float*)(lds + RVT_OFF);
    const int half = tid >> 8, t = tid & 255;
    for (int i0 = 0; i0 < RVT_UNITS; i0 += 4) {
        f32x4 p[2][4]; bool ok[2];
#pragma unroll
        for (int j = 0; j < 2; ++j) { pg8::Unit u; ok[j] = S.next(i0 + 2 * j + half, u); const size_t r = ok[j] ? (size_t)256 * u.pm + t : 0;
#pragma unroll
            for (int q = 0; q < 4; ++q) p[j][q] = *(const f32x4*)(SS + r * 16 + 4 * q); }
#pragma unroll
        for (int j = 0; j < 2; ++j) if (ok[j]) { const f32x4 a = (p[j][0] + p[j][1]) + (p[j][2] + p[j][3]); tab[(i0 + 2 * j + half) * 256 + t] = rsqrtf(((a[0] + a[1]) + (a[2] + a[3])) * (1.0f / 1024.0f) + EPS); }
        pg8::Unit u2; if (!S.next(i0 + 4, u2)) break;
    }
    __syncthreads();
}

template <bool GAIN>
__device__ __forceinline__ void transpose_item(const float* W, int K, int N, bf16* WT, const float* gain, LAS float* scr, int item, int lane) {
    const int nblk = N / 32, kb = item / nblk, nb = item % nblk, k0 = 64 * kb, n0 = 32 * nb;
    float wv[32];
    const float* wp = W + (size_t)(k0 + (lane >> 5)) * N + n0 + (lane & 31);
#pragma unroll
    for (int i = 0; i < 32; ++i) wv[i] = wp[(size_t)(2 * i) * N];
    float gl = 1.f; if (GAIN) gl = gain[k0 + lane];
#pragma unroll
    for (int i = 0; i < 32; ++i) { const int kk = 2 * i + (lane >> 5); const float gk = GAIN ? __shfl(gl, kk) : 1.f; scr[kk * 33 + (lane & 31)] = wv[i] * gk; }
    LDS_WAIT(); asm volatile("" ::: "memory");
    const int c = lane & 7;
#pragma unroll
    for (int j = 0; j < 4; ++j) { const int n = (lane >> 3) + 8 * j; const LAS float* s = scr + (8 * c) * 33 + n;
        u32x4 o; o.x = pk2(s[0 * 33], s[1 * 33]); o.y = pk2(s[2 * 33], s[3 * 33]); o.z = pk2(s[4 * 33], s[5 * 33]); o.w = pk2(s[6 * 33], s[7 * 33]);
        *(u32x4*)(WT + (size_t)(n0 + n) * K + k0 + 8 * c) = o; }
    LDS_WAIT(); asm volatile("" ::: "memory");
}

__device__ __forceinline__ int crow(int r, int hi) { return (r & 3) + 8 * (r >> 2) + 4 * hi; }
__device__ __forceinline__ void pv64(f32x16* o, int vb, bf16x8 pa0, bf16x8 pa1, bf16x8 pa2, bf16x8 pa3) {
#pragma unroll
    for (int d0 = 0; d0 < 2; ++d0) { s16x4 lo[4], hi[4];
#pragma unroll
        for (int ks = 0; ks < 4; ++ks) {
            asm volatile("ds_read_b64_tr_b16 %0,%1 offset:%c2" : "=&v"(lo[ks]) : "v"(vb), "i"(d0 * 4096 + ks * 1024) : "memory");
            asm volatile("ds_read_b64_tr_b16 %0,%1 offset:%c2" : "=&v"(hi[ks]) : "v"(vb), "i"(d0 * 4096 + ks * 1024 + 512) : "memory"); }
        asm volatile("s_waitcnt lgkmcnt(0)" ::: "memory"); __builtin_amdgcn_sched_barrier(0);
#define PK(k) (bf16x8){lo[k][0], lo[k][1], lo[k][2], lo[k][3], hi[k][0], hi[k][1], hi[k][2], hi[k][3]}
        o[d0] = __builtin_amdgcn_mfma_f32_32x32x16_bf16(pa0, PK(0), o[d0], 0, 0, 0);
        o[d0] = __builtin_amdgcn_mfma_f32_32x32x16_bf16(pa1, PK(1), o[d0], 0, 0, 0);
        o[d0] = __builtin_amdgcn_mfma_f32_32x32x16_bf16(pa2, PK(2), o[d0], 0, 0, 0);
        o[d0] = __builtin_amdgcn_mfma_f32_32x32x16_bf16(pa3, PK(3), o[d0], 0, 0, 0);
#undef PK
    }
}
__device__ __forceinline__ void attn_unit(LAS unsigned char* lds, const bf16* QKVU, bf16* MIX, const float* cache_k, const float* cache_v, const float* sinks,
                                          const int samp, const int b, const int c, const int g, const int wid) {
    int tid = threadIdx.x; asm volatile("" : "+v"(tid)); const int lane = tid & 63;
    LAS unsigned char* kl = lds + AT_KL; LAS unsigned char* vl = lds + AT_VL;
    u32x4 kvr[3], vvr[3];
    if (!samp) {
#pragma unroll
        for (int i = 0; i < 3; ++i) {
            const int p = tid + 512 * i, key = p >> 3, ch = p & 7;
            long t = 64 * (c - 2) + key; if (t < 0) t = 0;
            const bf16* rowp = QKVU + qk_off((size_t)b * SEQ + (size_t)t, 512 + 64 * g + 8 * ch);
            kvr[i] = *(const u32x4*)rowp; vvr[i] = *(const u32x4*)(rowp + 4 * 8192);
        }
    } else {
        f32x4 ck[2][2], cv[2][2];
#pragma unroll
        for (int i = 0; i < 2; ++i) { const int p = tid + 512 * i, key = p >> 3, ch = p & 7; const size_t o = ((size_t)(b * 128 + key) * 2 + g) * 64 + 8 * ch;
            ck[i][0] = *(const f32x4*)(cache_k + o); ck[i][1] = *(const f32x4*)(cache_k + o + 4); cv[i][0] = *(const f32x4*)(cache_v + o); cv[i][1] = *(const f32x4*)(cache_v + o + 4); }
        { const int p = tid + 1024, key = p >> 3, ch = p & 7; const int kk = key < 144 ? key - 128 : 0;
          const bf16* rowp = QKVU + (size_t)(MPR + 16 * b + kk) * EVIN;
          kvr[2] = *(const u32x4*)(rowp + 512 + 64 * g + 8 * ch); vvr[2] = *(const u32x4*)(rowp + 640 + 64 * g + 8 * ch);
          if (key >= 144) { kvr[2] = (u32x4){0u, 0u, 0u, 0u}; vvr[2] = kvr[2]; } }
#pragma unroll
        for (int i = 0; i < 2; ++i) { kvr[i] = pk8(ck[i][0], ck[i][1]); vvr[i] = pk8(cv[i][0], cv[i][1]); }
    }
#pragma unroll
    for (int i = 0; i < 3; ++i) {
        const int p = tid + 512 * i, key = p >> 3, ch = p & 7;
        *(LAS u32x4*)(kl + (key >> 6) * 8192 + ch * 1024 + (key & 63) * 16) = kvr[i];
        *(LAS u32x4*)(vl + (key >> 6) * 8192 + (ch >> 2) * 4096 + ((key & 63) >> 4) * 1024 + (key & 15) * 64 + (ch & 3) * 16) = vvr[i];
    }
    const int hl = wid >> 1, qh = wid & 1, r32 = lane & 31, hi = lane >> 5, head = 4 * g + hl;
    const int q = samp ? (r32 & 15) : (32 * qh + r32);
    const size_t qrow = samp ? (size_t)(MPR + 16 * b + (r32 & 15)) : ((size_t)b * SEQ + 64 * c + q);
    const bf16* qp = samp ? QKVU + qrow * EVIN + 64 * head + 8 * hi : QKVU + qk_off(qrow, 64 * head + 8 * hi);
    const int qs2 = samp ? 32 : 8192;
    bf16x8 qr[4];
#pragma unroll
    for (int d0 = 0; d0 < 4; ++d0) qr[d0] = *(const bf16x8*)(qp + 16 * (d0 & 1) + qs2 * (d0 >> 1));
    __syncthreads();
    const LAS float* bt = (const LAS float*)(lds + AT_BIAS) + head * 256 + 63 - q;
    f32x16 p[6];
#pragma unroll
    for (int kt = 0; kt < 6; ++kt)
#pragma unroll
        for (int r = 0; r < 16; ++r) p[kt][r] = bt[32 * kt + crow(r, hi)];
#pragma unroll
    for (int kt = 0; kt < 6; ++kt) {
        const LAS unsigned char* kb = kl + (kt >> 1) * 8192 + hi * 1024 + ((kt & 1) * 32 + r32) * 16;
#pragma unroll
        for (int d0 = 0; d0 < 4; ++d0) { const bf16x8 kf = *(const LAS bf16x8*)(kb + d0 * 2048); p[kt] = __builtin_amdgcn_mfma_f32_32x32x16_bf16(kf, qr[d0], p[kt], 0, 0, 0); }
    }
    const int j0 = samp ? 0 : (c >= 2 ? 0 : 128 - 64 * c), j1 = samp ? 144 : 192;
    if (j0 > 0 || j1 < 192) {
#pragma unroll
        for (int kt = 0; kt < 6; ++kt)
#pragma unroll
            for (int r = 0; r < 16; ++r) { const int j = 32 * kt + crow(r, hi); if (j < j0 || j >= j1) p[kt][r] = -1e30f; }
    }
    const float sk = sinks[head] * LOG2E;
    float mx = sk;
#pragma unroll
    for (int kt = 0; kt < 6; ++kt)
#pragma unroll
        for (int r = 0; r < 16; ++r) mx = fmaxf(mx, p[kt][r]);
    mx = fmaxf(mx, __shfl_xor(mx, 32));
    float sum = 0.f;
#pragma unroll
    for (int kt = 0; kt < 6; ++kt)
#pragma unroll
        for (int r = 0; r < 16; ++r) { const float e = __builtin_amdgcn_exp2f(p[kt][r] - mx); p[kt][r] = e; sum += e; }
    sum += __shfl_xor(sum, 32);
    const float inv = 1.0f / (sum + __builtin_amdgcn_exp2f(sk - mx));
    f32x16 o[2]; o[0] = f32x16{}; o[1] = f32x16{};
    const int vb0 = (int)(unsigned)(uintptr_t)vl + ((lane >> 4) & 1) * 32 + (lane & 3) * 8 + (4 * hi + ((lane & 15) >> 2)) * 64;
#pragma unroll
    for (int t = 0; t < 3; ++t) {
        const f32x16& pa = p[2 * t]; const f32x16& pb = p[2 * t + 1];
        const u32x4 w0 = {pk2(pa[0], pa[1]), pk2(pa[2], pa[3]), pk2(pa[4], pa[5]), pk2(pa[6], pa[7])}, w1 = {pk2(pa[8], pa[9]), pk2(pa[10], pa[11]), pk2(pa[12], pa[13]), pk2(pa[14], pa[15])};
        const u32x4 w2 = {pk2(pb[0], pb[1]), pk2(pb[2], pb[3]), pk2(pb[4], pb[5]), pk2(pb[6], pb[7])}, w3 = {pk2(pb[8], pb[9]), pk2(pb[10], pb[11]), pk2(pb[12], pb[13]), pk2(pb[14], pb[15])};
        pv64(o, vb0 + t * 8192, __builtin_bit_cast(bf16x8, w0), __builtin_bit_cast(bf16x8, w1), __builtin_bit_cast(bf16x8, w2), __builtin_bit_cast(bf16x8, w3));
    }
    int lane2 = threadIdx.x & 63; asm volatile("" : "+v"(lane2));
    const int r32b = lane2 & 31, hib = lane2 >> 5;
    LAS float* wsf = (LAS float*)(lds + AT_WSF) + wid * 64;
    if (hib == 0) wsf[r32b] = inv;
    LDS_WAIT(); __builtin_amdgcn_wave_barrier();
    float rli[16];
#pragma unroll
    for (int r = 0; r < 16; ++r) rli[r] = wsf[crow(r, hib)];
    LAS bf16* stg = (LAS bf16*)(lds + AT_OST) + wid * 2048;
#pragma unroll
    for (int r = 0; r < 16; ++r) { const int orow = crow(r, hib);
#pragma unroll
        for (int d0 = 0; d0 < 2; ++d0) stg[orow * 64 + d0 * 32 + r32b] = (bf16)(pk2(o[d0][r] * rli[r], 0.f) & 0xffffu); }
    LDS_WAIT(); __builtin_amdgcn_wave_barrier();
#pragma unroll
    for (int i = 0; i < 4; ++i) { const int row = i * 8 + (lane2 >> 3), ch = lane2 & 7; const u32x4 v = *(const LAS u32x4*)(stg + row * 64 + ch * 8);
        if (!samp) *(u32x4*)(MIX + ((size_t)b * SEQ + 64 * c + 32 * qh + row) * DM + 64 * head + ch * 8) = v;
        else if (qh == 0 && row < 16) *(u32x4*)(MIX + (size_t)(MPR + 16 * b + row) * DM + 64 * head + ch * 8) = v; }
    __syncthreads();
}

template <int W> __device__ __forceinline__ void pool_group(LAS unsigned char* dt, const float (&x0)[31], const float (&x1)[31], const int pos0, const bool fixed_cnt, const int lane) {
    float s0 = 0.f, s1 = 0.f;
#pragma unroll
    for (int k = 1; k < W; ++k) { s0 += x0[15 - k]; s1 += x1[15 - k]; }
#pragma unroll
    for (int i = 0; i < 16; ++i) {
        s0 += x0[15 + i]; s1 += x1[15 + i];
        const int pos = pos0 + i; const float cnt = fixed_cnt ? (float)W : (float)((pos + 1) < W ? (pos + 1) : W);
        const float ic = 1.0f / cnt;
        const float d0 = s0 * ic - x0[15 + i], d1 = s1 * ic - x1[15 + i];
        *(LAS unsigned*)(dt + i * 256 + ((((lane >> 2) ^ i) & 15) << 4) + (lane & 3) * 4) = pk2(d0, d1);
        s0 -= x0[15 + i - (W - 1)]; s1 -= x1[15 + i - (W - 1)];
    }
}
template <bool WLDS>
__device__ __forceinline__ void pool_item(LAS unsigned char* lds, const bf16* QKVU, bf16* MIX, const float* state_pool, const bf16* POOLW, const float* pool_scale,
                                          const int samp, const size_t row0  , const int sb  , const int g, const int wid) {
    int lane = threadIdx.x & 63; asm volatile("" : "+v"(lane));
    LAS unsigned char* dt = lds + PL_D + wid * 4096;
    const int fr = lane & 15, fq = lane >> 4;
    const int t0 = samp ? 1024 : (int)(row0 & (SEQ - 1));
    {
        float x0[31], x1[31];
        const int col = 768 + 128 * g + 2 * lane;
        unsigned wseg[16];
#pragma unroll
        for (int e = 0; e < 16; ++e) wseg[e] = *(const unsigned*)(QKVU + (row0 + e) * EVIN + col);
        if (samp) {
            const float* sp = state_pool + (size_t)sb * 15 * 512 + 128 * g + 2 * lane;
            f32x2 hv[15];
#pragma unroll
            for (int e = 0; e < 15; ++e) hv[e] = *(const f32x2*)(sp + (size_t)e * 512);
#pragma unroll
            for (int e = 0; e < 15; ++e) { x0[e] = hv[e][0]; x1[e] = hv[e][1]; }
        } else if (t0 == 0) {
#pragma unroll
            for (int e = 0; e < 15; ++e) { x0[e] = 0.f; x1[e] = 0.f; }
        } else {
            unsigned wh[15];
#pragma unroll
            for (int e = 0; e < 15; ++e) wh[e] = *(const unsigned*)(QKVU + (row0 - 15 + e) * EVIN + col);
#pragma unroll
            for (int e = 0; e < 15; ++e) { x0[e] = bf_lo(wh[e]); x1[e] = bf_hi(wh[e]); }
        }
#pragma unroll
        for (int e = 0; e < 16; ++e) { x0[15 + e] = bf_lo(wseg[e]); x1[15 + e] = bf_hi(wseg[e]); }
        if (g == 0) pool_group<2>(dt, x0, x1, t0, samp != 0, lane);
        else if (g == 1) pool_group<4>(dt, x0, x1, t0, samp != 0, lane);
        else if (g == 2) pool_group<8>(dt, x0, x1, t0, samp != 0, lane);
        else pool_group<16>(dt, x0, x1, t0, samp != 0, lane);
    }
    LDS_WAIT(); __builtin_amdgcn_wave_barrier();
    bf16x8 wf[8][4];
    if (WLDS) {
        const LAS unsigned char* pw = lds + PL_W + (g & 1) * 32768 + fr * 256;
#pragma unroll
        for (int nf = 0; nf < 8; ++nf)
#pragma unroll
            for (int ks = 0; ks < 4; ++ks) wf[nf][ks] = *(const LAS bf16x8*)(pw + nf * 4096 + ((((4 * ks + fq) ^ fr) & 15) << 4));
    } else {
        const bf16* wp = POOLW + (size_t)g * 16384 + (size_t)fr * 128 + 8 * fq;
#pragma unroll
        for (int nf = 0; nf < 8; ++nf)
#pragma unroll
            for (int ks = 0; ks < 4; ++ks) wf[nf][ks] = *(const bf16x8*)(wp + (size_t)nf * 16 * 128 + 32 * ks);
    }
    bf16x8 af[4];
#pragma unroll
    for (int ks = 0; ks < 4; ++ks) af[ks] = *(const LAS bf16x8*)(dt + fr * 256 + ((((4 * ks + fq) ^ fr) & 15) << 4));
    const float* scp = pool_scale + 128 * g + 4 * fq;
    bf16* orow = MIX + (row0 + fr) * DM + 512 + 128 * g + 4 * fq;
#pragma unroll
    for (int nf = 0; nf < 8; ++nf) {
        f32x4 acc = {0.f, 0.f, 0.f, 0.f};
#pragma unroll
        for (int ks = 0; ks < 4; ++ks) acc = __builtin_amdgcn_mfma_f32_16x16x32_bf16(wf[nf][ks], af[ks], acc, 0, 0, 0);
        const f32x4 sc = *(const f32x4*)(scp + 16 * nf);
        acc = acc * sc;
        u32x2 w; w.x = pk2(acc[0], acc[1]); w.y = pk2(acc[2], acc[3]);
        *(u32x2*)(orow + 16 * nf) = w;
    }
    LDS_WAIT(); __builtin_amdgcn_wave_barrier();
}

template <int W> __device__ __forceinline__ void pool_seg_loads(const bf16* QKVU, const size_t row0, const int g, const int lane, unsigned (&raw)[W + 15]) {
    const bf16* p = QKVU + qk_off(row0, 768 + 128 * g + 2 * lane);
#pragma unroll
    for (int e = 0; e < 16; ++e) raw[W - 1 + e] = *(const unsigned*)(p + e * 32);
}
template <int W> __device__ __forceinline__ void pool_halo_loads(const bf16* QKVU, const size_t row0, const int g, const int lane, unsigned (&raw)[W + 15]) {
#pragma unroll
    for (int e = 0; e < W - 1; ++e) raw[e] = *(const unsigned*)(QKVU + qk_off(row0 - (size_t)(W - 1 - e), 768 + 128 * g + 2 * lane));
}
template <int W> __device__ __forceinline__ void pool_halo_zero(unsigned (&raw)[W + 15]) {
#pragma unroll
    for (int e = 0; e < W - 1; ++e) raw[e] = 0u;
}
template <int W> __device__ __forceinline__ void pool_compute(LAS unsigned char* lds, bf16* MIX, const float* pool_scale, const unsigned (&raw)[W + 15], const size_t row0, const int t0, const int g, const int wid, const int lane) {
    LAS unsigned char* dt = lds + PL_D + wid * 4096;
    const int fr = lane & 15, fq = lane >> 4;
    float s0 = 0.f, s1 = 0.f;
#pragma unroll
    for (int e = 0; e < W - 1; ++e) { s0 += bf_lo(raw[e]); s1 += bf_hi(raw[e]); }
#pragma unroll
    for (int i = 0; i < 16; ++i) {
        const float u0 = bf_lo(raw[W - 1 + i]), u1 = bf_hi(raw[W - 1 + i]);
        s0 += u0; s1 += u1;
        const int pos = t0 + i; const float ic = 1.0f / (float)((pos + 1) < W ? (pos + 1) : W);
        *(LAS unsigned*)(dt + i * 256 + ((((lane >> 2) ^ i) & 15) << 4) + (lane & 3) * 4) = pk2(s0 * ic - u0, s1 * ic - u1);
        s0 -= bf_lo(raw[i]); s1 -= bf_hi(raw[i]);
    }
    LDS_WAIT(); __builtin_amdgcn_wave_barrier();
    bf16x8 wf[8][4];
    const LAS unsigned char* pw = lds + PL_W + (g & 1) * 32768 + fr * 256;
#pragma unroll
    for (int nf = 0; nf < 8; ++nf)
#pragma unroll
        for (int ks = 0; ks < 4; ++ks) wf[nf][ks] = *(const LAS bf16x8*)(pw + nf * 4096 + ((((4 * ks + fq) ^ fr) & 15) << 4));
    bf16x8 af[4];
#pragma unroll
    for (int ks = 0; ks < 4; ++ks) af[ks] = *(const LAS bf16x8*)(dt + fr * 256 + ((((4 * ks + fq) ^ fr) & 15) << 4));
    const float* scp = pool_scale + 128 * g + 4 * fq;
    bf16* orow = MIX + (row0 + fr) * DM + 512 + 128 * g + 4 * fq;
#pragma unroll
    for (int nf = 0; nf < 8; ++nf) {
        f32x4 acc = {0.f, 0.f, 0.f, 0.f};
#pragma unroll
        for (int ks = 0; ks < 4; ++ks) acc = __builtin_amdgcn_mfma_f32_16x16x32_bf16(wf[nf][ks], af[ks], acc, 0, 0, 0);
        const f32x4 sc = *(const f32x4*)(scp + 16 * nf);
        acc = acc * sc;
        u32x2 w; w.x = pk2(acc[0], acc[1]); w.y = pk2(acc[2], acc[3]);
        *(u32x2*)(orow + 16 * nf) = w;
    }
    LDS_WAIT(); __builtin_amdgcn_wave_barrier();
}
__device__ __forceinline__ void pool_stage_weights(LAS unsigned char* lds, const u32x4 (&wv)[8], const int t2) {
#pragma unroll
    for (int i = 0; i < 8; ++i) { const int chunk = t2 + 512 * i, row = chunk >> 4, c16 = chunk & 15; *(LAS u32x4*)(lds + PL_W + row * 256 + (((c16 ^ row) & 15) << 4)) = wv[i]; }
}
__device__ __forceinline__ void pool_unit_prompt(LAS unsigned char* lds, const bf16* QKVU, bf16* MIX, const bf16* POOLW, const float* pool_scale, const size_t row0, const int wid) {
    int t2 = threadIdx.x; asm volatile("" : "+v"(t2)); const int lane = t2 & 63;
    const int t0 = (int)(row0 & (SEQ - 1));
    u32x4 wv0[8], wv1[8];
#pragma unroll
    for (int i = 0; i < 8; ++i) wv0[i] = *(const u32x4*)(POOLW + (size_t)(t2 + 512 * i) * 8);
    unsigned r0[17], r1[19], r2[23], r3[31];
    pool_seg_loads<2>(QKVU, row0, 0, lane, r0); pool_seg_loads<4>(QKVU, row0, 1, lane, r1); pool_seg_loads<8>(QKVU, row0, 2, lane, r2); pool_seg_loads<16>(QKVU, row0, 3, lane, r3);
    if (t0 != 0) { pool_halo_loads<2>(QKVU, row0, 0, lane, r0); pool_halo_loads<4>(QKVU, row0, 1, lane, r1); pool_halo_loads<8>(QKVU, row0, 2, lane, r2); pool_halo_loads<16>(QKVU, row0, 3, lane, r3); }
    else { pool_halo_zero<2>(r0); pool_halo_zero<4>(r1); pool_halo_zero<8>(r2); pool_halo_zero<16>(r3); }
#pragma unroll
    for (int i = 0; i < 8; ++i) wv1[i] = *(const u32x4*)(POOLW + 32768 + (size_t)(t2 + 512 * i) * 8);
    pool_stage_weights(lds, wv0, t2);
    __syncthreads();
    pool_compute<2>(lds, MIX, pool_scale, r0, row0, t0, 0, wid, lane);
    pool_compute<4>(lds, MIX, pool_scale, r1, row0, t0, 1, wid, lane);
    __syncthreads();
    pool_stage_weights(lds, wv1, t2);
    __syncthreads();
    pool_compute<8>(lds, MIX, pool_scale, r2, row0, t0, 2, wid, lane);
    pool_compute<16>(lds, MIX, pool_scale, r3, row0, t0, 3, wid, lane);
    __syncthreads();
}

struct Args { const float* in[21]; float* out; unsigned char* ws; int ph_lo, ph_hi; };
static_assert(sizeof(Args) == 21 * 8 + 8 + 8 + 8, "Args has no padding");
static_assert(RVT_OFF + RVT_UNITS * 1024 <= LDS_BYTES, "row-scale table fits");

#define CAS __attribute__((address_space(4)))
__global__ void __launch_bounds__(512, 2) trunk_fwd(Args args_unused) {
    extern __shared__ __attribute__((aligned(16))) unsigned char lds_raw[];
    LAS unsigned char* lds = (LAS unsigned char*)lds_raw;
    volatile LAS unsigned* MISC = (volatile LAS unsigned*)(lds + MISC_OFF);
    const int wave = __builtin_amdgcn_readfirstlane(threadIdx.x >> 6);
    const int G = gridDim.x; const int bx = blockIdx.x; const int vcu = (G % 8 == 0) ? (bx % 8) * (G / 8) + bx / 8 : bx;
    const CAS Args* kp0 = (const CAS Args*)__builtin_amdgcn_kernarg_segment_ptr();
#define KP(name) const CAS Args* name = kp0; asm volatile("" : "+s"(name))
#define WSP(kp, off) ((kp)->ws + (off))
    for (int u = threadIdx.x; u < (LDS_BYTES - LDSCTL_OFF) / 4; u += 512) ((LAS unsigned*)(lds + LDSCTL_OFF))[u] = 0u;
    __syncthreads();
    XcdBarrier bar;
    { KP(kp); unsigned* ctl = (unsigned*)WSP(kp, WS_CTL); bar.bar = ctl + CW_BAR; bar.x = 0; bar.st = nullptr;
      if (N_LAUNCHES == 1) bar = xcd_barrier_post(ctl + CW_BAR, MISC + 8); }
    const int lo = kp0->ph_lo, hi = kp0->ph_hi;
#ifndef PROBE_DUP
#define PROBE_DUP (-1)
#endif
#define REP(k) for (int rep_ = 0; rep_ < ((PROBE_DUP == (k)) ? 2 : 1); ++rep_)
#define IN(k) (lo <= (k) && (k) < hi)
#define PH_TID() int tid = threadIdx.x; asm volatile("" : "+v"(tid)); const int lane = tid & 63
#define SEAM(k) do { if (IN(k) && IN((k) + 1)) xcd_barrier(bar); } while (0)
    const int gw = vcu * 8 + wave, NGW = G * 8;

    REP(0) {
    if (IN(0)) {
        PH_TID(); KP(kp); unsigned char* ws = kp->ws; float* out = kp->out;
        const float* x_prompt = kp->in[0]; const float* x_sample = kp->in[1]; const float* cache_k = kp->in[2]; const float* cache_v = kp->in[3];
        const float* norm_mix = kp->in[6]; const float* norm_ffn = kp->in[7]; const float* ffn_w1 = kp->in[8]; const float* ffn_w2 = kp->in[9]; const float* ev_w_in = kp->in[10]; const float* ev_w_out = kp->in[11];
        const float* pool_w = kp->in[16]; const float* conv_w_in = kp->in[18]; const float* conv_w_out = kp->in[20];
        float* RINV0 = (float*)(ws + WS_RINV0); bf16* POOLW = (bf16*)(ws + WS_POOLW); bf16* WIN = (bf16*)(ws + WS_WIN); bf16* WOUT = (bf16*)(ws + WS_WOUT); bf16* W1 = (bf16*)(ws + WS_W1); bf16* W2 = (bf16*)(ws + WS_W2);
        bf16* WCIN = (bf16*)(ws + WS_WCIN); bf16* WCOUT = (bf16*)(ws + WS_WCOUT); bf16* S1 = (bf16*)(ws + WS_S1);
        LAS float* scr = (LAS float*)(lds + RING_OFF + wave * 16384);
        constexpr int I_IN = 16 * 40, I_OUT = 16 * 32, I_W1 = 16 * 128, I_W2 = 64 * 32, I_CIN = 16 * 96, I_COUT = 16 * 32, I_PW = 4 * 8;
        constexpr int NITEMS = I_IN + I_OUT + I_W1 + I_W2 + I_CIN + I_COUT + I_PW;
        for (int it = gw; it < NITEMS; it += NGW) {
            int r = it;
            if (r < I_IN) { transpose_item<true>(ev_w_in, DM, EVIN, WIN, norm_mix, scr, r, lane); continue; } r -= I_IN;
            if (r < I_OUT) { transpose_item<false>(ev_w_out, DM, DM, WOUT, nullptr, scr, r, lane); continue; } r -= I_OUT;
            if (r < I_W1) { transpose_item<true>(ffn_w1, DM, DFF, W1, norm_ffn, scr, r, lane); continue; } r -= I_W1;
            if (r < I_W2) { transpose_item<false>(ffn_w2, DFF, DM, W2, nullptr, scr, r, lane); continue; } r -= I_W2;
            if (r < I_CIN) { transpose_item<true>(conv_w_in, DM, CIN, WCIN, norm_mix + DM, scr, r, lane); continue; } r -= I_CIN;
            if (r < I_COUT) { transpose_item<false>(conv_w_out, DM, DM, WCOUT, nullptr, scr, r, lane); continue; } r -= I_COUT;
            { const int g = r >> 3; transpose_item<false>(pool_w + (size_t)g * 16384, 128, 128, POOLW + (size_t)g * 16384, nullptr, scr, r & 7, lane); }
        }
        for (int m = gw * 4; m < MT; m += NGW * 4) {
            const float* xr = (m < MPR) ? x_prompt + (size_t)m * DM : x_sample + (size_t)(m - MPR) * DM;
            const f32x4* x4 = (const f32x4*)xr + lane;
            f32x4 v[4][4]; float sr[4];
#pragma unroll
            for (int q = 0; q < 4; ++q)
#pragma unroll
                for (int j = 0; j < 4; ++j) v[q][j] = x4[256 * q + 64 * j];
#pragma unroll
            for (int q = 0; q < 4; ++q) { sr[q] = (sq4(v[q][0]) + sq4(v[q][1])) + (sq4(v[q][2]) + sq4(v[q][3])); }
#pragma unroll
            for (int o = 1; o < 64; o <<= 1) {
#pragma unroll
                for (int q = 0; q < 4; ++q) sr[q] += __shfl_xor(sr[q], o); }
            if (lane < 4) { const float sv = lane == 0 ? sr[0] : (lane == 1 ? sr[1] : (lane == 2 ? sr[2] : sr[3])); RINV0[m + lane] = rsqrtf(sv * (1.0f / 1024.0f) + EPS); }
#pragma unroll
            for (int q = 0; q < 4; ++q) { u32x2* o8 = (u32x2*)(S1 + (size_t)(m + q) * DM) + lane;
#pragma unroll
                for (int j = 0; j < 4; ++j) { u32x2 w; w.x = pk2(v[q][j][0], v[q][j][1]); w.y = pk2(v[q][j][2], v[q][j][3]); o8[64 * j] = w; } }
        }
        { const f32x4* ck = (const f32x4*)cache_k; const f32x4* cv = (const f32x4*)cache_v; f32x4* ok = (f32x4*)(out + O_KS); f32x4* ov = (f32x4*)(out + O_VS);
          for (int e = vcu * 512 + tid; e < 2 * 8 * 3584; e += G * 512) { const int which = e / 28672, rem = e % 28672, b = rem / 3584, i = rem % 3584;
              if (which == 0) ok[b * 4096 + i] = ck[b * 4096 + 512 + i]; else ov[b * 4096 + i] = cv[b * 4096 + 512 + i]; } }
    }
    SEAM(0);
    }

    REP(1) {
    if (IN(1)) {
        PH_TID(); KP(kp); unsigned char* ws = kp->ws; float* out = kp->out; const float* q_norm = kp->in[12]; const float* k_norm = kp->in[13];
        bf16* S1 = (bf16*)(ws + WS_S1); bf16* WIN = (bf16*)(ws + WS_WIN); bf16* QKVU = (bf16*)(ws + WS_QKVU); float* RINV0 = (float*)(ws + WS_RINV0);
        { BRowPlain br{WIN, DM, 4}; SEpiInProj SE{QKVU, RINV0, q_norm, k_norm, out};
          sample_gemm<DM, 4, 4>(lds + RING_OFF, S1 + (size_t)MPR * DM, 20, (bx + G / 2) % G, G, br, SE, lane, wave); }
        pg8::MapHead<DM> mp{(const char*)S1, (const char*)WIN}; pg8::StaticOrder S; S.init(NTILE, EVIN / 256, G, bx);
        pg8::EpiInProj E{QKVU, RINV0, q_norm, k_norm, out};
        pg8::gemm_phase<DM, pg8::EpiInProj, pg8::MapHead<DM>>(lds + RING_OFF, mp, S, E);
        { const int nun = NTILE * (EVIN / 256), rem = nun % G, nlate = (rem == 0) ? G : G - rem;
          if (rem == 0 || bx >= rem) {
              const float* norm_ffn = kp->in[7]; const float* ffn_w1 = kp->in[8]; const float* ffn_w2 = kp->in[9];
              bf16* W1B = (bf16*)(out + O_YP); bf16* W2B = (bf16*)(ws + WS_W2B);
              LAS float* scr = (LAS float*)(lds + RING_OFF + wave * 16384);
              constexpr int I_W1 = 16 * 128, I_W2 = 64 * 32;
              for (int it = ((rem == 0) ? bx : bx - rem) * 8 + wave; it < I_W1 + I_W2; it += nlate * 8) {
                  if (it < I_W1) transpose_item<true>(ffn_w1 + (size_t)DM * DFF, DM, DFF, W1B, norm_ffn + DM, scr, it, lane);
                  else transpose_item<false>(ffn_w2 + (size_t)DFF * DM, DFF, DM, W2B, nullptr, scr, it - I_W1, lane); } } }
    }
    SEAM(1);
    }

    REP(2) {
    if (IN(2)) {
        PH_TID(); KP(kp); unsigned char* ws = kp->ws; const float* cache_k = kp->in[2]; const float* cache_v = kp->in[3]; const float* state_pool = kp->in[4];
        const float* attn_sinks = kp->in[14]; const float* rel_bias = kp->in[15]; const float* pool_scale = kp->in[17];
        bf16* QKVU = (bf16*)(ws + WS_QKVU); bf16* POOLW = (bf16*)(ws + WS_POOLW);
        bf16* MIX = (bf16*)(ws + WS_S0);
        { LAS float* bt = (LAS float*)(lds + AT_BIAS);
          for (int e = tid; e < 8 * 256; e += 512) { const int h = e >> 8, idx = e & 255; float v = 0.f;
              if (idx < 255) { const int rel = idx - 191, n = rel < 0 ? -rel : rel; int bk = n < 8 ? n : (33 - __builtin_clz((unsigned)(n * n))); if (bk > 15) bk = 15; if (rel > 0) bk += 16; v = rel_bias[bk * 8 + h] * LOG2E; }
              bt[e] = v; } }
        __syncthreads();
        for (int un = vcu * 4, cnt = 0; un < 1040; ) {
            const int samp = un >= 1024 ? 1 : 0, sidx = un - 1024;
            const int ub = samp ? (sidx >> 1) : (un >> 9), ug = samp ? (sidx & 1) : ((un >> 8) & 1), uc = samp ? 0 : (un & 255);
            attn_unit(lds, QKVU, MIX, cache_k, cache_v, attn_sinks, samp, ub, uc, ug, wave);
            ++cnt;
            if (cnt < 4) ++un;
            else if (cnt == 4) un = (4 * G >= 1024) ? 1024 + vcu : 4 * G + vcu;
            else un += G;
        }
        for (int pu = vcu; pu < 256; pu += G) pool_unit_prompt(lds, QKVU, MIX, POOLW, pool_scale, (size_t)pu * 128 + wave * 16, wave);
        if (wave == 0) for (int it = (G >= 64) ? vcu - G / 2 : vcu; it >= 0 && it < 32; it += G) pool_item<false>(lds, QKVU, MIX, state_pool, POOLW, pool_scale, 1, (size_t)MPR + (it >> 2) * 16, it >> 2, it & 3, wave);
    }
    SEAM(2);
    }

    REP(3) {
    if (IN(3)) {
        PH_TID(); KP(kp); unsigned char* ws = kp->ws; float* out = kp->out; const float* x_prompt = kp->in[0]; const float* x_sample = kp->in[1];
        bf16* S0 = (bf16*)(ws + WS_S0); bf16* S1 = (bf16*)(ws + WS_S1); bf16* WOUT = (bf16*)(ws + WS_WOUT); float* SS = (float*)(ws + WS_SS); float* XP = out + O_YP; float* XS = out + O_YS;
        pg8::MapHead<DM> mp{(const char*)S0, (const char*)WOUT}; pg8::StaticOrder S; S.init(NTILE, DM / 256, G, bx);
        { BRowPlain br{WOUT, DM, 2}; SEpiResid<1, 2> SE{nullptr, S1, SS + (size_t)MT * 16, nullptr}; sample_gemm<DM, 2, 8>(lds + RING_OFF, S0 + (size_t)MPR * DM, 32, vcu, G, br, SE, lane, wave); }
        pg8::EpiResid<1> E{nullptr, S1, SS, nullptr};
        pg8::gemm_phase<DM, pg8::EpiResid<1>, pg8::MapHead<DM>>(lds + RING_OFF, mp, S, E);
    }
    SEAM(3);
    }
    REP(4) {
    if (IN(4)) {
        PH_TID(); KP(kp); unsigned char* ws = kp->ws; bf16* S1 = (bf16*)(ws + WS_S1); bf16* W1 = (bf16*)(ws + WS_W1); bf16* H = (bf16*)(ws + WS_H); float* SS = (float*)(ws + WS_SS);
        { BRowPlain br{W1, DM, 4}; SEpiUp SE{H, SS + (size_t)MT * 16}; sample_gemm<DM, 4, 4>(lds + RING_OFF, S1 + (size_t)MPR * DM, 64, vcu, G, br, SE, lane, wave); }
        pg8::MapHead<DM> mp{(const char*)S1, (const char*)W1}; pg8::StaticOrder S; S.init(NTILE, DFF / 256, G, bx);
        build_row_scales(lds, S, SS);
        pg8::EpiUp E{H, (const LAS float*)(lds + RVT_OFF), SS};
        pg8::gemm_phase<DM, pg8::EpiUp, pg8::MapHead<DM>>(lds + RING_OFF, mp, S, E);
    }
    SEAM(4);
    }
    REP(5) {
    if (IN(5)) {
        PH_TID(); KP(kp); unsigned char* ws = kp->ws; float* out = kp->out; bf16* S1 = (bf16*)(ws + WS_S1); bf16* W2 = (bf16*)(ws + WS_W2); bf16* H = (bf16*)(ws + WS_H); float* SS = (float*)(ws + WS_SS); float* XP = out + O_YP; float* XS = out + O_YS;
        pg8::MapHeadAT<DFF> mp{(const char*)H, (const char*)W2}; pg8::StaticOrder S; S.init(NTILE, DM / 256, G, bx);
        { BRowPlain br{W2, DFF, 2}; SEpiResid<1, 2> SE{nullptr, S1, SS + (size_t)MT * 16, nullptr}; sample_gemm<DFF, 2, 8>(lds + RING_OFF, H + (size_t)MPR * DFF, 32, vcu, G, br, SE, lane, wave); }
        pg8::EpiResid<1> E{nullptr, S1, SS, nullptr};
        pg8::gemm_phase<DFF, pg8::EpiResid<1>, pg8::MapHeadAT<DFF>>(lds + RING_OFF, mp, S, E);
    }
    SEAM(5);
    }
    REP(6) {
    if (IN(6)) {
        PH_TID(); KP(kp); unsigned char* ws = kp->ws; float* out = kp->out; bf16* S1 = (bf16*)(ws + WS_S1); bf16* WCIN = (bf16*)(ws + WS_WCIN); bf16* BE = (bf16*)(ws + WS_H); float* SS = (float*)(ws + WS_SS);
        pg8::MapConvIn<DM> mp{(const char*)S1, (const char*)WCIN}; pg8::StaticOrder S; S.init(NTILE, CIN / 256, G, bx);
        { BRowConvIn br{WCIN}; SEpiConvIn SE{BE, SS + (size_t)MT * 16, out}; sample_gemm<DM, 3, 4>(lds + RING_OFF, S1 + (size_t)MPR * DM, 64, vcu, G, br, SE, lane, wave); }
        build_row_scales(lds, S, SS);
        pg8::EpiConvIn E{BE, (const LAS float*)(lds + RVT_OFF), SS, out};
        pg8::gemm_phase<DM, pg8::EpiConvIn, pg8::MapConvIn<DM>>(lds + RING_OFF, mp, S, E);
    }
    SEAM(6);
    }
    REP(7) {
    if (IN(7)) {
        PH_TID(); KP(kp); unsigned char* ws = kp->ws; const float* state_conv = kp->in[5]; const float* norm_ffn = kp->in[7]; const float* ffn_w1 = kp->in[8]; const float* ffn_w2 = kp->in[9]; const float* conv_w = kp->in[19];
        bf16* S0 = (bf16*)(ws + WS_S0); bf16* W1 = (bf16*)(ws + WS_W1); bf16* W2 = (bf16*)(ws + WS_W2); bf16* BE = (bf16*)(ws + WS_H);
        const int cg = tid & 127, seg = tid >> 7;
        f32x4 w0a = *(const f32x4*)(conv_w + 8 * cg), w0b = *(const f32x4*)(conv_w + 8 * cg + 4);
        f32x4 w1a = *(const f32x4*)(conv_w + DM + 8 * cg), w1b = *(const f32x4*)(conv_w + DM + 8 * cg + 4);
        f32x4 w2a = *(const f32x4*)(conv_w + 2 * DM + 8 * cg), w2b = *(const f32x4*)(conv_w + 2 * DM + 8 * cg + 4);
        for (int un = vcu; un < MPR / 64; un += G) {
            const size_t r0 = (size_t)un * 64 + seg * 16;
            f32x4 p2a, p2b, p1a, p1b;
            if (r0 >= (size_t)MPR) { const int b = (int)((r0 - MPR) >> 4); const float* sp = state_conv + (size_t)b * 2 * DM + 8 * cg;
                p2a = *(const f32x4*)sp; p2b = *(const f32x4*)(sp + 4); p1a = *(const f32x4*)(sp + DM); p1b = *(const f32x4*)(sp + DM + 4); }
            else if ((r0 & (SEQ - 1)) == 0) { p2a = (f32x4){0.f, 0.f, 0.f, 0.f}; p2b = p2a; p1a = p2a; p1b = p2a; }
            else { const u32x4 e2 = *(const u32x4*)(BE + be_off(r0 - 2, 1024 + 8 * cg)), e1 = *(const u32x4*)(BE + be_off(r0 - 1, 1024 + 8 * cg));
                p2a = (f32x4){bf_lo(e2.x), bf_hi(e2.x), bf_lo(e2.y), bf_hi(e2.y)}; p2b = (f32x4){bf_lo(e2.z), bf_hi(e2.z), bf_lo(e2.w), bf_hi(e2.w)};
                p1a = (f32x4){bf_lo(e1.x), bf_hi(e1.x), bf_lo(e1.y), bf_hi(e1.y)}; p1b = (f32x4){bf_lo(e1.z), bf_hi(e1.z), bf_lo(e1.w), bf_hi(e1.w)}; }
#pragma unroll 8
            for (int i = 0; i < 16; ++i) {
                const size_t r = r0 + i;
                const u32x4 bw = *(const u32x4*)(BE + be_off(r, 8 * cg)), ew = *(const u32x4*)(BE + be_off(r, 1024 + 8 * cg));
                const f32x4 ea = {bf_lo(ew.x), bf_hi(ew.x), bf_lo(ew.y), bf_hi(ew.y)}, eb = {bf_lo(ew.z), bf_hi(ew.z), bf_lo(ew.w), bf_hi(ew.w)};
                const f32x4 ba = {bf_lo(bw.x), bf_hi(bw.x), bf_lo(bw.y), bf_hi(bw.y)}, bb = {bf_lo(bw.z), bf_hi(bw.z), bf_lo(bw.w), bf_hi(bw.w)};
                const f32x4 ya = w0a * p2a + w1a * p1a + w2a * ea, yb = w0b * p2b + w1b * p1b + w2b * eb;
                *(u32x4*)(S0 + r * DM + 8 * cg) = pk8(ba * ya, bb * yb);
                p2a = p1a; p2b = p1b; p1a = ea; p1b = eb;
            }
        }
        for (int b = (G >= 8) ? vcu - (G - 8) : vcu; b >= 0 && b < 8; b += G) {
            const size_t r0 = (size_t)MPR + 16 * b + 4 * seg;
            f32x4 p2a, p2b, p1a, p1b;
            if (seg == 0) { const float* sp = state_conv + (size_t)b * 2 * DM + 8 * cg;
                p2a = *(const f32x4*)sp; p2b = *(const f32x4*)(sp + 4); p1a = *(const f32x4*)(sp + DM); p1b = *(const f32x4*)(sp + DM + 4); }
            else { const u32x4 e2 = *(const u32x4*)(BE + (r0 - 2) * 2048 + 1024 + 8 * cg), e1 = *(const u32x4*)(BE + (r0 - 1) * 2048 + 1024 + 8 * cg);
                p2a = (f32x4){bf_lo(e2.x), bf_hi(e2.x), bf_lo(e2.y), bf_hi(e2.y)}; p2b = (f32x4){bf_lo(e2.z), bf_hi(e2.z), bf_lo(e2.w), bf_hi(e2.w)};
                p1a = (f32x4){bf_lo(e1.x), bf_hi(e1.x), bf_lo(e1.y), bf_hi(e1.y)}; p1b = (f32x4){bf_lo(e1.z), bf_hi(e1.z), bf_lo(e1.w), bf_hi(e1.w)}; }
#pragma unroll
            for (int i = 0; i < 4; ++i) {
                const size_t r = r0 + i;
                const u32x4 bw = *(const u32x4*)(BE + r * 2048 + 8 * cg), ew = *(const u32x4*)(BE + r * 2048 + 1024 + 8 * cg);
                const f32x4 ea = {bf_lo(ew.x), bf_hi(ew.x), bf_lo(ew.y), bf_hi(ew.y)}, eb = {bf_lo(ew.z), bf_hi(ew.z), bf_lo(ew.w), bf_hi(ew.w)};
                const f32x4 ba = {bf_lo(bw.x), bf_hi(bw.x), bf_lo(bw.y), bf_hi(bw.y)}, bb = {bf_lo(bw.z), bf_hi(bw.z), bf_lo(bw.w), bf_hi(bw.w)};
                const f32x4 ya = w0a * p2a + w1a * p1a + w2a * ea, yb = w0b * p2b + w1b * p1b + w2b * eb;
                *(u32x4*)(S0 + r * DM + 8 * cg) = pk8(ba * ya, bb * yb);
                p2a = p1a; p2b = p1b; p1a = ea; p1b = eb;
            }
        }
    }
    SEAM(7);
    }
    REP(8) {
    if (IN(8)) {
        PH_TID(); KP(kp); unsigned char* ws = kp->ws; float* out = kp->out; bf16* S0 = (bf16*)(ws + WS_S0); bf16* S1 = (bf16*)(ws + WS_S1); bf16* WCOUT = (bf16*)(ws + WS_WCOUT); float* SS = (float*)(ws + WS_SS); float* XP = out + O_YP; float* XS = out + O_YS;
        pg8::MapHead<DM> mp{(const char*)S0, (const char*)WCOUT}; pg8::StaticOrder S; S.init(NTILE, DM / 256, G, bx);
        { BRowPlain br{WCOUT, DM, 2}; SEpiResid<1, 2> SE{nullptr, S1, SS + (size_t)MT * 16, nullptr}; sample_gemm<DM, 2, 8>(lds + RING_OFF, S0 + (size_t)MPR * DM, 32, vcu, G, br, SE, lane, wave); }
        pg8::EpiResid<1> E{nullptr, S1, SS, nullptr};
        pg8::gemm_phase<DM, pg8::EpiResid<1>, pg8::MapHead<DM>>(lds + RING_OFF, mp, S, E);
    }
    SEAM(8);
    }
    REP(9) {
    if (IN(9)) {
        PH_TID(); KP(kp); unsigned char* ws = kp->ws; bf16* S1 = (bf16*)(ws + WS_S1); bf16* W1 = (bf16*)(kp->out + O_YP); bf16* H = (bf16*)(ws + WS_H); float* SS = (float*)(ws + WS_SS);
        { BRowPlain br{W1, DM, 4}; SEpiUp SE{H, SS + (size_t)MT * 16}; sample_gemm<DM, 4, 4>(lds + RING_OFF, S1 + (size_t)MPR * DM, 64, vcu, G, br, SE, lane, wave); }
        pg8::MapHead<DM> mp{(const char*)S1, (const char*)W1}; pg8::StaticOrder S; S.init(NTILE, DFF / 256, G, bx);
        build_row_scales(lds, S, SS);
        pg8::EpiUp E{H, (const LAS float*)(lds + RVT_OFF), SS};
        pg8::gemm_phase<DM, pg8::EpiUp, pg8::MapHead<DM>>(lds + RING_OFF, mp, S, E);
    }
    SEAM(9);
    }
    if (IN(10)) {
        PH_TID(); KP(kp); unsigned char* ws = kp->ws; float* out = kp->out; bf16* S1 = (bf16*)(ws + WS_S1); bf16* W2 = (bf16*)(ws + WS_W2B); bf16* H = (bf16*)(ws + WS_H); float* XP = out + O_YP; float* XS = out + O_YS;
        pg8::MapHeadAT<DFF> mp{(const char*)H, (const char*)W2}; pg8::StaticOrder S; S.init(NTILE, DM / 256, G, bx);
        { BRowPlain br{W2, DFF, 2}; SEpiResid<2, 2> SE{nullptr, S1, nullptr, XS}; sample_gemm<DFF, 2, 8>(lds + RING_OFF, H + (size_t)MPR * DFF, 32, vcu, G, br, SE, lane, wave); }
        pg8::EpiResid<2> E{nullptr, S1, nullptr, XP};
        pg8::gemm_phase<DFF, pg8::EpiResid<2>, pg8::MapHeadAT<DFF>>(lds + RING_OFF, mp, S, E);
    }
#undef IN
#undef SEAM
#undef KP
#undef WSP
}

extern "C" void kernel_launch(void* const* d_in, const int* in_sizes, int n_in, void* d_out, int out_size, void* d_ws, size_t ws_size, hipStream_t stream) {
    static int grid = 0;
    if (grid == 0) {
        if (n_in != 21 || in_sizes[0] != MPR * DM || (size_t)out_size != O_END || ws_size < WS_END) {
            fprintf(stderr, "kernel_launch: unexpected problem: n_in %d in0 %d out %d ws %zu (need %zu); nothing launched\n", n_in, n_in > 0 ? in_sizes[0] : -1, out_size, ws_size, (size_t)WS_END); grid = -1; return; }
        int dev = 0, cus = 0, per_cu = 0;
        if (hipGetDevice(&dev) != hipSuccess || hipDeviceGetAttribute(&cus, hipDeviceAttributeMultiprocessorCount, dev) != hipSuccess) { fprintf(stderr, "kernel_launch: device query failed\n"); grid = -1; return; }
        if (hipFuncSetAttribute((const void*)trunk_fwd, hipFuncAttributeMaxDynamicSharedMemorySize, LDS_BYTES) != hipSuccess) { fprintf(stderr, "kernel_launch: hipFuncSetAttribute failed\n"); grid = -1; return; }
        if (hipOccupancyMaxActiveBlocksPerMultiprocessor(&per_cu, (const void*)trunk_fwd, 512, LDS_BYTES) != hipSuccess || per_cu < 1) {
            fprintf(stderr, "kernel_launch: occupancy query reports %d workgroups per CU; nothing launched\n", per_cu); (void)hipGetLastError(); grid = -1; return; }
        grid = cus;
    }
    if (grid < 0) return;
    if (hipMemsetAsync((char*)d_ws + WS_CTL, 0, CTL_ZERO_BYTES, stream) != hipSuccess) { fprintf(stderr, "kernel_launch: memset failed\n"); return; }
    Args a{};
    for (int i = 0; i < 21; ++i) a.in[i] = (const float*)d_in[i];
    a.out = (float*)d_out; a.ws = (unsigned char*)d_ws;
    for (int li = 0; li < N_LAUNCHES; ++li) {
        a.ph_lo = (N_LAUNCHES == 1) ? 0 : li; a.ph_hi = (N_LAUNCHES == 1) ? NPH : li + 1;
        hipLaunchKernelGGL(trunk_fwd, dim3(grid), dim3(512), LDS_BYTES, stream, a);
        const hipError_t le = hipPeekAtLastError();
        if (le != hipSuccess) { fprintf(stderr, "kernel_launch: launch %d failed: %s\n", li, hipGetErrorName(le)); break; }
    }
}
```

```cpp
#include <hip/hip_runtime.h>
#include <cstdio>
#include <cstdint>

#define LAS __attribute__((address_space(3)))
#define GAS __attribute__((address_space(1)))
typedef unsigned short bf16;
typedef short bf16x8 __attribute__((ext_vector_type(8)));
typedef short s16x4 __attribute__((ext_vector_type(4)));
typedef float f32x2 __attribute__((ext_vector_type(2)));
typedef float f32x4 __attribute__((ext_vector_type(4)));
typedef float f32x16 __attribute__((ext_vector_type(16)));
typedef unsigned u32x2 __attribute__((ext_vector_type(2)));
typedef unsigned u32x4 __attribute__((ext_vector_type(4)));
typedef __bf16 bf16x2_t __attribute__((ext_vector_type(2)));

#ifndef MK_N_LAUNCHES
#define MK_N_LAUNCHES 1
#endif
constexpr int NPH = 11;
constexpr int N_LAUNCHES = MK_N_LAUNCHES;
static_assert(N_LAUNCHES == 1 || N_LAUNCHES == NPH, "MK_N_LAUNCHES is 1 or 11");

constexpr int DM = 1024, SEQ = 16384, NBATCH = 2, MPR = NBATCH * SEQ, MSR = 128, MT = MPR + MSR, NTILE = 128;
constexpr int EVIN = 1280, DFF = 4096, CIN = 3072;
constexpr float EPS = 1e-6f, LOG2E = 1.4426950408889634f, QSCALE = 0.125f * 1.4426950408889634f;
constexpr size_t O_YP = 0, O_YS = 33554432, O_KP = 33685504, O_VP = 33718272, O_PP = 33751040, O_CP = 33766400, O_KS = 33770496, O_VS = 33901568, O_PS = 34032640, O_CS = 34094080, O_END = 34110464;
constexpr size_t KiB = 1024, MiB = 1024 * 1024;
constexpr size_t WS_CTL = 0, CTL_ZERO_BYTES = 256 * KiB;
constexpr size_t WS_RINV0 = 256 * KiB;
constexpr size_t WS_SS = 512 * KiB;
constexpr size_t WS_POOLW = 2816 * KiB;
constexpr size_t WS_WIN = 3 * MiB;
constexpr size_t WS_WOUT = WS_WIN + 2560 * KiB;
constexpr size_t WS_W1 = WS_WOUT + 2 * MiB;
constexpr size_t WS_W2 = WS_W1 + 8 * MiB;
constexpr size_t WS_WCIN = WS_W2 + 8 * MiB;
constexpr size_t WS_WCOUT = WS_WCIN + 6 * MiB;
constexpr size_t WS_S0 = 32 * MiB;
constexpr size_t WS_S1 = WS_S0 + 65 * MiB;
constexpr size_t WS_QKVU = WS_S1 + 65 * MiB;
constexpr size_t WS_H = WS_QKVU + 81 * MiB;
constexpr size_t WS_W2B = WS_H + 257 * MiB;
constexpr size_t WS_END = WS_W2B + 8 * MiB;
static_assert(WS_WCOUT + 2 * MiB <= WS_S0 && (size_t)MT * 2048 <= 65 * MiB && (size_t)MT * 2560 <= 81 * MiB && (size_t)MT * 8192 <= 257 * MiB && WS_END <= 512 * MiB, "ws map");
static_assert(WS_SS + (size_t)MT * 64 + 128 * 32 * 4 <= WS_POOLW, "ws map ss (+ the sample rows' 32-slot table behind it)");
constexpr int CW_BAR = 4096;

__device__ __forceinline__ unsigned pk2(float lo, float hi) { f32x2 v = {lo, hi}; bf16x2_t b = __builtin_convertvector(v, bf16x2_t); return __builtin_bit_cast(unsigned, b); }
__device__ __forceinline__ u32x4 pk8(f32x4 a, f32x4 b) { u32x4 w; w.x = pk2(a[0], a[1]); w.y = pk2(a[2], a[3]); w.z = pk2(b[0], b[1]); w.w = pk2(b[2], b[3]); return w; }
__device__ __forceinline__ float bf_lo(unsigned w) { return __uint_as_float(w << 16); }
__device__ __forceinline__ float bf_hi(unsigned w) { return __uint_as_float(w & 0xffff0000u); }
__device__ __forceinline__ float sq4(f32x4 v) { return (v[0] * v[0] + v[1] * v[1]) + (v[2] * v[2] + v[3] * v[3]); }
__device__ __forceinline__ float wave_sum(float v) {
#pragma unroll
    for (int o = 1; o < 64; o <<= 1) v += __shfl_xor(v, o);
    return v;
}
__device__ __forceinline__ size_t be_off(size_t r, int c) { return (r >> 8) * (size_t)(256 * 2048) + (size_t)(c >> 5) * 8192 + (r & 255) * 32 + (c & 31); }
#define LDS_WAIT() asm volatile("s_waitcnt lgkmcnt(0)" ::: "memory")
#define VM_WAIT() asm volatile("s_waitcnt vmcnt(0)" ::: "memory")

namespace pg8 {
constexpr int RVT_UNITS_ = 12;
constexpr int BM = 256, BK = 64, HALF = 128, HTB = HALF * BK * 2, STAGE_BYTES = 8 * HTB, NXCD = 8, WGM = 8;
__host__ __device__ __forceinline__ int lds_byte(int r, int c) { const int st = (r >> 4) * 2 + (c >> 5), rr = r & 15, cc = c & 31, ob = rr * 64 + cc * 2; return st * 1024 + (ob ^ (((ob >> 9) & 1) << 5)); }
__host__ __device__ __forceinline__ void stage_rc(int b, int& R, int& C) { const int st = b / 1024, sb = b % 1024, swz = sb ^ (((sb >> 9) & 1) << 5); R = (st >> 1) * 16 + swz / 64; C = (st & 1) * 32 + (swz % 64) / 2; }
__host__ __device__ __forceinline__ int perm32(int rho) { const int n = rho >> 4, i = rho & 15; return 8 * (i >> 2) + 4 * n + (i & 3); }
struct Unit { int pm, pn, idx; };
struct StaticOrder {
    int nM, nN, nwg, G, c;
    __device__ void init(int nM_, int nN_, int G_, int c_) { nM = nM_; nN = nN_; nwg = nM * nN; G = G_; c = c_; }
    __device__ bool next(int i, Unit& u) const {
        const long L = (long)i * G + c; if (L >= nwg) return false;
        int wgid = (int)L; { const int q = nwg / NXCD, r = nwg % NXCD, xcd = wgid % NXCD, off = wgid / NXCD; wgid = (xcd < r ? xcd * (q + 1) : r * (q + 1) + (xcd - r) * q) + off; }
        const int nig = WGM * nN, gid = wgid / nig, fm = gid * WGM, gsz = (nM - fm) < WGM ? (nM - fm) : WGM;
        u.pm = fm + ((wgid % nig) % gsz); u.pn = (wgid % nig) / gsz; return true;
    }
};
template <int K> struct MapPlain {
    static constexpr int BMODE = 0; static constexpr bool ATILE = false;
    const char* A; const char* Bt;
    __device__ __forceinline__ void ptrs(const Unit& u, const char*& a, size_t& aH, const char*& b, size_t& bH) const {
        a = A + (size_t)u.pm * 256 * K * 2; aH = (size_t)128 * K * 2;
        b = Bt + (size_t)u.pn * 256 * K * 2; bH = (size_t)128 * K * 2; }
};
template <int K> struct MapHead {
    static constexpr int BMODE = 1; static constexpr bool ATILE = false;
    const char* A; const char* Bt;
    __device__ __forceinline__ void ptrs(const Unit& u, const char*& a, size_t& aH, const char*& b, size_t& bH) const {
        a = A + (size_t)u.pm * 256 * K * 2; aH = (size_t)128 * K * 2;
        b = Bt + (size_t)u.pn * 256 * K * 2; bH = (size_t)32 * K * 2; }
};
template <int K> struct MapHeadAT {
    static constexpr int BMODE = 1; static constexpr bool ATILE = true;
    const char* A; const char* Bt;
    __device__ __forceinline__ void ptrs(const Unit& u, const char*& a, size_t& aH, const char*& b, size_t& bH) const {
        a = A + (size_t)u.pm * 256 * K * 2; aH = (size_t)128 * 32 * 2;
        b = Bt + (size_t)u.pn * 256 * K * 2; bH = (size_t)32 * K * 2; }
};
template <int K> struct MapConvIn {
    static constexpr int BMODE = 0; static constexpr bool ATILE = true;
    const char* A; const char* Bt;
    __device__ __forceinline__ void ptrs(const Unit& u, const char*& a, size_t& aH, const char*& b, size_t& bH) const {
        a = A + (size_t)u.pm * 256 * K * 2; aH = (size_t)128 * 32 * 2;
        if (u.pn < 4) { b = Bt + (size_t)u.pn * 256 * K * 2; bH = (size_t)128 * K * 2; }
        else { b = Bt + (size_t)(1024 + 128 * (u.pn - 4)) * K * 2; bH = (size_t)1024 * K * 2; } }
};

template <int K, class Epi, class Map>
__device__ __forceinline__ void gemm_phase(LAS unsigned char* lds, const Map& MPp, const StaticOrder& S, const Epi& E) {
    int tid = threadIdx.x; asm volatile("" : "+v"(tid));
    const int wid = __builtin_amdgcn_readfirstlane(tid >> 6), lane = tid & 63, wr = wid >> 2, wc = wid & 3, fr = lane & 15, fq = lane >> 4;
    constexpr int nt = K / BK;
    unsigned voffA[2], voffB[2];
#pragma unroll
    for (int i = 0; i < 2; ++i) { int R, C; stage_rc(tid * 16 + i * 8192, R, C);
        const int Rb = (Map::BMODE == 1) ? (64 * (R >> 5) + perm32(R & 31)) : ((R & ~31) + perm32(R & 31));
        voffA[i] = Map::ATILE ? (unsigned)((C >> 5) * 8192 + R * 32 + (C & 31)) * 2u : (unsigned)(R * K + C) * 2u; voffB[i] = (unsigned)(Rb * K + C) * 2u; }
    const size_t kstep = (size_t)(BK * 2), kstepA = Map::ATILE ? (size_t)(256 * 64 * 2) : (size_t)(BK * 2);
    const unsigned ldsw = (unsigned)wid * 1024u;
    const int aoff = lds_byte(wr * 64 + fr, fq * 8), boff = lds_byte(wc * 32 + fr, fq * 8);
#define PG8_SA(b, h) (((b) * 2 + (h)) * HTB)
#define PG8_SB(b, h) ((4 + (b) * 2 + (h)) * HTB)
#define PG8_STAGE(bufoff, gbase, voff) do { _Pragma("unroll") for (int _i = 0; _i < 2; ++_i) \
        __builtin_amdgcn_global_load_lds((const unsigned*)((const char*)(gbase) + (voff)[_i]), (LAS unsigned*)(lds + (bufoff) + ldsw + _i * 8192), 16, 0, 0); } while (0)
#define PG8_LDA(dst, b, h) do { _Pragma("unroll") for (int m = 0; m < 4; ++m) _Pragma("unroll") for (int k = 0; k < 2; ++k) dst[m][k] = *(const LAS bf16x8*)(lds + PG8_SA(b, h) + aoff + m * 2048 + k * 1024); } while (0)
#define PG8_LDB(dst, b, h) do { _Pragma("unroll") for (int n = 0; n < 2; ++n) _Pragma("unroll") for (int k = 0; k < 2; ++k) dst[n][k] = *(const LAS bf16x8*)(lds + PG8_SB(b, h) + boff + n * 2048 + k * 1024); } while (0)
#define PG8_MMA(ai, bj, At, Bt) do { __builtin_amdgcn_s_setprio(1); _Pragma("unroll") for (int m = 0; m < 4; ++m) _Pragma("unroll") for (int n = 0; n < 2; ++n) _Pragma("unroll") for (int k = 0; k < 2; ++k) \
        acc[ai][bj][m][n] = __builtin_amdgcn_mfma_f32_16x16x32_bf16(Bt[n][k], At[m][k], acc[ai][bj][m][n], 0, 0, 0); __builtin_amdgcn_s_setprio(0); } while (0)
#define PG8_WAIT_V(n) asm volatile("s_waitcnt vmcnt(" #n ")" ::: "memory")
#define PG8_WAIT_L(n) asm volatile("s_waitcnt lgkmcnt(" #n ")" ::: "memory")
#define PG8_BAR __builtin_amdgcn_s_barrier()
#define PG8_SCHED __builtin_amdgcn_sched_barrier(0)
    Unit cur, nxt; int ui = 0; cur.idx = 0;
    if (!S.next(0, cur)) return;
    f32x4 acc[2][2][4][2];
#pragma unroll
    for (int a = 0; a < 2; ++a)
#pragma unroll
        for (int b = 0; b < 2; ++b)
#pragma unroll
            for (int m = 0; m < 4; ++m)
#pragma unroll
                for (int n = 0; n < 2; ++n) acc[a][b][m][n] = (f32x4){0.f, 0.f, 0.f, 0.f};
    bf16x8 At[4][2], B0[2][2], B1[2][2];
    const char* cA; const char* cB; size_t cAH, cBH;
    MPp.ptrs(cur, cA, cAH, cB, cBH);
    PG8_STAGE(PG8_SB(0, 0), cB, voffB); PG8_STAGE(PG8_SB(0, 1), cB + cBH, voffB); PG8_STAGE(PG8_SA(0, 0), cA, voffA); PG8_STAGE(PG8_SA(0, 1), cA + cAH, voffA);
    if (wr == 1) PG8_BAR;
    PG8_WAIT_V(2); PG8_BAR;
    PG8_STAGE(PG8_SB(1, 0), cB + kstep, voffB); PG8_STAGE(PG8_SA(1, 0), cA + kstepA, voffA); PG8_STAGE(PG8_SB(1, 1), cB + cBH + kstep, voffB);
    PG8_WAIT_V(6); PG8_BAR;
    for (;;) {
        const bool has_next = S.next(ui + 1, nxt); nxt.idx = ui + 1;
        const char* nA = cA; const char* nB = cB; size_t nAH = cAH, nBH = cBH;
        if (has_next) MPp.ptrs(nxt, nA, nAH, nB, nBH);
        for (int t = 0; t < nt; t += 2) {
            const bool last = (t == nt - 2);
            const char* a1 = cA + (size_t)(t + 1) * kstepA;
            const char* a2 = last ? nA : cA + (size_t)(t + 2) * kstepA; const char* b2 = last ? nB : cB + (size_t)(t + 2) * kstep;
            const size_t a2H = last ? nAH : cAH, b2H = last ? nBH : cBH;
            const char* a3 = a2 + kstepA; const char* b3 = b2 + kstep;
            PG8_LDB(B0, 0, 0); PG8_LDB(B1, 0, 1); PG8_SCHED; PG8_LDA(At, 0, 0); PG8_STAGE(PG8_SA(1, 1), a1 + cAH, voffA);
            PG8_WAIT_V(8); PG8_WAIT_L(0); PG8_BAR; PG8_MMA(0, 0, At, B0); PG8_MMA(0, 1, At, B1); PG8_BAR; PG8_SCHED;
            PG8_LDA(At, 0, 1); PG8_STAGE(PG8_SB(0, 0), b2, voffB); PG8_STAGE(PG8_SB(0, 1), b2 + b2H, voffB); PG8_STAGE(PG8_SA(0, 0), a2, voffA);
            PG8_WAIT_V(8); PG8_WAIT_L(0); PG8_BAR; PG8_MMA(1, 0, At, B0); PG8_MMA(1, 1, At, B1); PG8_BAR; PG8_SCHED;
            PG8_LDB(B0, 1, 0); PG8_LDB(B1, 1, 1); PG8_SCHED; PG8_LDA(At, 1, 0); PG8_STAGE(PG8_SA(0, 1), a2 + a2H, voffA);
            PG8_WAIT_V(8); PG8_WAIT_L(0); PG8_BAR; PG8_MMA(0, 0, At, B0); PG8_MMA(0, 1, At, B1); PG8_BAR; PG8_SCHED;
            PG8_LDA(At, 1, 1); PG8_STAGE(PG8_SB(1, 0), b3, voffB); PG8_STAGE(PG8_SB(1, 1), b3 + b2H, voffB); PG8_STAGE(PG8_SA(1, 0), a3, voffA);
            PG8_WAIT_V(8); PG8_WAIT_L(0); PG8_BAR; PG8_MMA(1, 0, At, B0); PG8_MMA(1, 1, At, B1); PG8_BAR; PG8_SCHED;
        }
        if (wr == 0) PG8_BAR;
        E(acc, cur, wr, wc, fr, fq);
        if (!has_next) break;
#pragma unroll
        for (int a = 0; a < 2; ++a)
#pragma unroll
            for (int b = 0; b < 2; ++b)
#pragma unroll
                for (int m = 0; m < 4; ++m)
#pragma unroll
                    for (int n = 0; n < 2; ++n) acc[a][b][m][n] = (f32x4){0.f, 0.f, 0.f, 0.f};
        cur = nxt; cA = nA; cB = nB; cAH = nAH; cBH = nBH; ++ui;
        if (wr == 1) PG8_BAR;
    }
    PG8_WAIT_V(0);
    PG8_BAR;
#undef PG8_SA
#undef PG8_SB
#undef PG8_STAGE
#undef PG8_LDA
#undef PG8_LDB
#undef PG8_MMA
#undef PG8_WAIT_V
#undef PG8_WAIT_L
#undef PG8_BAR
#undef PG8_SCHED
}

typedef const f32x4 (&AccRef)[2][2][4][2];
struct EpiInProj {
    bf16* QKVU; const float* rinv0; const float* qn; const float* kn; float* out;
    __device__ __forceinline__ void operator()(AccRef acc, const Unit& u, int wr, int wc, int fr, int fq) const {
        asm volatile("" : "+v"(fr), "+v"(fq));
        const int pn = u.pn;
        const int cb = 256 * pn + 64 * wc;
        const int kind = pn < 2 ? 0 : (pn == 2 ? (wc < 2 ? 1 : 2) : 3);
        const int g = wc & 1;
        f32x4 gv[2][2];
#pragma unroll
        for (int bj = 0; bj < 2; ++bj)
#pragma unroll
            for (int n = 0; n < 2; ++n) gv[bj][n] = (f32x4){1.f, 1.f, 1.f, 1.f};
        if (kind <= 1) { const float* gp = kind == 0 ? qn : kn; const float sc = kind == 0 ? QSCALE : 1.f;
#pragma unroll
            for (int bj = 0; bj < 2; ++bj)
#pragma unroll
                for (int n = 0; n < 2; ++n) gv[bj][n] = *(const f32x4*)(gp + 32 * bj + 8 * fq + 4 * n) * sc; }
        float rvs[2][4];
#pragma unroll
        for (int ai = 0; ai < 2; ++ai)
#pragma unroll
            for (int m = 0; m < 4; ++m) rvs[ai][m] = rinv0[256 * u.pm + 128 * ai + 64 * wr + 16 * m + fr];
#pragma unroll
        for (int ai = 0; ai < 2; ++ai) {
#pragma unroll
            for (int m = 0; m < 4; ++m) {
                const int rt = 128 * ai + 64 * wr + 16 * m + fr; const int r = 256 * u.pm + rt;
                const float rv = rvs[ai][m];
                f32x4 v[2][2];
#pragma unroll
                for (int bj = 0; bj < 2; ++bj)
#pragma unroll
                    for (int n = 0; n < 2; ++n) v[bj][n] = acc[ai][bj][m][n] * rv;
                if (kind <= 1) {
                    float ss = (sq4(v[0][0]) + sq4(v[0][1])) + (sq4(v[1][0]) + sq4(v[1][1]));
                    ss += __shfl_xor(ss, 16); ss += __shfl_xor(ss, 32);
                    const float rn = rsqrtf(ss * (1.0f / 64.0f) + EPS);
#pragma unroll
                    for (int bj = 0; bj < 2; ++bj)
#pragma unroll
                        for (int n = 0; n < 2; ++n) v[bj][n] = v[bj][n] * rn * gv[bj][n];
                }
                bf16* rowp = QKVU + (size_t)r * EVIN + cb + 8 * fq;
#pragma unroll
                for (int bj = 0; bj < 2; ++bj) *(u32x4*)(rowp + 32 * bj) = pk8(v[bj][0], v[bj][1]);
                if (kind == 1 || kind == 2) {
                    float* dst = nullptr;
                    if (ai == 1 && (u.pm & 63) == 63) { const int bb = u.pm >> 6, j = rt - 128; dst = out + (kind == 1 ? O_KP : O_VP) + ((size_t)(bb * 128 + j) * 2 + g) * 64; }
                    if (dst) {
#pragma unroll
                        for (int bj = 0; bj < 2; ++bj)
#pragma unroll
                            for (int n = 0; n < 2; ++n) *(f32x4*)(dst + 32 * bj + 8 * fq + 4 * n) = v[bj][n]; }
                } else if (kind == 3) {
                    const int ucol = 256 * (pn - 3) + 64 * wc + 8 * fq;
                    float* dst = nullptr;
                    if (ai == 1 && (u.pm & 63) == 63 && rt >= 241) { const int bb = u.pm >> 6; dst = out + O_PP + (size_t)(bb * 15 + rt - 241) * 512 + ucol; }
                    if (dst) {
#pragma unroll
                        for (int bj = 0; bj < 2; ++bj)
#pragma unroll
                            for (int n = 0; n < 2; ++n) *(f32x4*)(dst + 32 * bj + 4 * n) = v[bj][n]; }
                }
            }
        }
    }
};
__device__ __forceinline__ f32x4 bf4_lo(u32x4 w) { return (f32x4){bf_lo(w.x), bf_hi(w.x), bf_lo(w.y), bf_hi(w.y)}; }
__device__ __forceinline__ f32x4 bf4_hi(u32x4 w) { return (f32x4){bf_lo(w.z), bf_hi(w.z), bf_lo(w.w), bf_hi(w.w)}; }
template <int MODE> struct EpiResid {
    const float* xin_f; bf16* XR; float* SS; float* yout;
    __device__ __forceinline__ void operator()(AccRef acc, const Unit& u, int wr, int wc, int fr, int fq) const {
        asm volatile("" : "+v"(fr), "+v"(fq));
        const int c0 = 256 * u.pn + 64 * wc + 8 * fq;
        const size_t rbase = (size_t)256 * u.pm + 64 * wr + fr;
        if (MODE == 0) {
#pragma unroll
            for (int ai = 0; ai < 2; ++ai) {
                f32x4 xr[4][2][2];
#pragma unroll
                for (int m = 0; m < 4; ++m)
#pragma unroll
                    for (int bj = 0; bj < 2; ++bj) { const float* p = xin_f + (rbase + 128 * ai + 16 * m) * DM + c0 + 32 * bj; xr[m][bj][0] = *(const f32x4*)p; xr[m][bj][1] = *(const f32x4*)(p + 4); }
#pragma unroll
                for (int m = 0; m < 4; ++m) { const size_t r = rbase + 128 * ai + 16 * m; float ss = 0.f;
#pragma unroll
                    for (int bj = 0; bj < 2; ++bj) { const f32x4 v0 = acc[ai][bj][m][0] + xr[m][bj][0], v1 = acc[ai][bj][m][1] + xr[m][bj][1]; ss += sq4(v0) + sq4(v1);
                        *(u32x4*)(XR + r * DM + c0 + 32 * bj) = pk8(v0, v1); }
                    ss += __shfl_xor(ss, 16); ss += __shfl_xor(ss, 32); if (fq == 0) SS[r * 16 + 4 * u.pn + wc] = ss; }
            }
        } else {
            bf16* xt = XR + (size_t)u.pm * 256 * DM + (size_t)(8 * u.pn + 2 * wc) * 8192 + (size_t)(64 * wr + fr) * 32 + 8 * fq;
            u32x4 xr[2][4][2];
#pragma unroll
            for (int ai = 0; ai < 2; ++ai)
#pragma unroll
                for (int m = 0; m < 4; ++m)
#pragma unroll
                    for (int bj = 0; bj < 2; ++bj) xr[ai][m][bj] = *(const u32x4*)(xt + (size_t)(128 * ai + 16 * m) * 32 + 8192 * bj);
#pragma unroll
            for (int ai = 0; ai < 2; ++ai)
#pragma unroll
                for (int m = 0; m < 4; ++m) { const size_t r = rbase + 128 * ai + 16 * m; float ss = 0.f;
#pragma unroll
                    for (int bj = 0; bj < 2; ++bj) { const f32x4 v0 = acc[ai][bj][m][0] + bf4_lo(xr[ai][m][bj]), v1 = acc[ai][bj][m][1] + bf4_hi(xr[ai][m][bj]);
                        if (MODE == 1) { ss += sq4(v0) + sq4(v1); *(u32x4*)(xt + (size_t)(128 * ai + 16 * m) * 32 + 8192 * bj) = pk8(v0, v1); }
                        else { float* yp = yout + r * DM + c0 + 32 * bj; *(f32x4*)yp = v0; *(f32x4*)(yp + 4) = v1; } }
                    if (MODE == 1) { ss += __shfl_xor(ss, 16); ss += __shfl_xor(ss, 32); if (fq == 0) SS[r * 16 + 4 * u.pn + wc] = ss; } }
        }
    }
};
__device__ __forceinline__ float row_rinv(const float* SS, size_t r, int fq) {
    const f32x4 s4 = *(const f32x4*)(SS + r * 16 + 4 * fq); float s = (s4[0] + s4[1]) + (s4[2] + s4[3]);
    s += __shfl_xor(s, 16); s += __shfl_xor(s, 32);
    return rsqrtf(s * (1.0f / 1024.0f) + EPS);
}
__device__ __forceinline__ void rows_rinv(const float* SS, size_t rbase, int fq, float (&rv)[2][4]) {
    f32x4 s4[2][4];
#pragma unroll
    for (int ai = 0; ai < 2; ++ai)
#pragma unroll
        for (int m = 0; m < 4; ++m) s4[ai][m] = *(const f32x4*)(SS + (rbase + 128 * ai + 16 * m) * 16 + 4 * fq);
#pragma unroll
    for (int ai = 0; ai < 2; ++ai)
#pragma unroll
        for (int m = 0; m < 4; ++m) { float t = (s4[ai][m][0] + s4[ai][m][1]) + (s4[ai][m][2] + s4[ai][m][3]); t += __shfl_xor(t, 16); t += __shfl_xor(t, 32); rv[ai][m] = rsqrtf(t * (1.0f / 1024.0f) + EPS); }
}
struct EpiUp {
    bf16* H; const LAS float* rvt; const float* SS;
    __device__ __forceinline__ void operator()(AccRef acc, const Unit& u, int wr, int wc, int fr, int fq) const {
        asm volatile("" : "+v"(fr), "+v"(fq));
        const int c0 = 256 * u.pn + 64 * wc + 8 * fq;
        float rvs[2][4];
        if (u.idx < RVT_UNITS_) {
#pragma unroll
            for (int ai = 0; ai < 2; ++ai)
#pragma unroll
                for (int m = 0; m < 4; ++m) rvs[ai][m] = rvt[u.idx * 256 + 128 * ai + 64 * wr + 16 * m + fr];
        } else rows_rinv(SS, (size_t)256 * u.pm + 64 * wr + fr, fq, rvs);
#pragma unroll
        for (int ai = 0; ai < 2; ++ai) {
#pragma unroll
            for (int m = 0; m < 4; ++m) {
                const size_t r = (size_t)256 * u.pm + 128 * ai + 64 * wr + 16 * m + fr;
                const float rv = rvs[ai][m];
#pragma unroll
                for (int bj = 0; bj < 2; ++bj) {
                    f32x4 v0 = acc[ai][bj][m][0] * rv, v1 = acc[ai][bj][m][1] * rv;
#pragma unroll
                    for (int i = 0; i < 4; ++i) { const float a = fmaxf(v0[i], 0.f), b = fmaxf(v1[i], 0.f); v0[i] = a * a; v1[i] = b * b; }
                    *(u32x4*)(H + (size_t)u.pm * 256 * DFF + (size_t)(8 * u.pn + 2 * wc + bj) * 8192 + (size_t)(128 * ai + 64 * wr + 16 * m + fr) * 32 + 8 * fq) = pk8(v0, v1);
                }
            }
        }
    }
};
struct EpiConvIn {
    bf16* BE; const LAS float* rvt; const float* SS; float* out;
    __device__ __forceinline__ void operator()(AccRef acc, const Unit& u, int wr, int wc, int fr, int fq) const {
        asm volatile("" : "+v"(fr), "+v"(fq));
        const int pn = u.pn;
        float rvs[2][4];
        if (u.idx < RVT_UNITS_) {
#pragma unroll
            for (int ai = 0; ai < 2; ++ai)
#pragma unroll
                for (int m = 0; m < 4; ++m) rvs[ai][m] = rvt[u.idx * 256 + 128 * ai + 64 * wr + 16 * m + fr];
        } else rows_rinv(SS, (size_t)256 * u.pm + 64 * wr + fr, fq, rvs);
#pragma unroll
        for (int ai = 0; ai < 2; ++ai) {
#pragma unroll
            for (int m = 0; m < 4; ++m) {
                const int rt = 128 * ai + 64 * wr + 16 * m + fr; const size_t r = (size_t)256 * u.pm + rt;
                const float rv = rvs[ai][m];
                if (pn < 4) {
#pragma unroll
                    for (int bj = 0; bj < 2; ++bj) *(u32x4*)(BE + be_off(r, 256 * pn + 128 * bj + 32 * wc + 8 * fq)) = pk8(acc[ai][bj][m][0] * rv, acc[ai][bj][m][1] * rv);
                } else {
                    const int ch0 = 128 * (pn - 4) + 32 * wc + 8 * fq;
                    const f32x4 e0 = (acc[ai][0][m][0] * rv) * (acc[ai][1][m][0] * rv), e1 = (acc[ai][0][m][1] * rv) * (acc[ai][1][m][1] * rv);
                    *(u32x4*)(BE + be_off(r, 1024 + ch0)) = pk8(e0, e1);
                    float* dst = nullptr;
                    if (ai == 1 && (u.pm & 63) == 63 && rt >= 254) { const int bb = u.pm >> 6; dst = out + O_CP + (size_t)(bb * 2 + rt - 254) * 1024 + ch0; }
                    if (dst) { *(f32x4*)dst = e0; *(f32x4*)(dst + 4) = e1; }
                }
            }
        }
    }
};
}


template <int K, int NF, int KS, class BRow, class Epi>
__device__ __forceinline__ void sample_gemm(LAS unsigned char* lds, const bf16* As, const int n_items, const int first, const int stride, const BRow& brow, const Epi& E, int lane, const int wave) {
    asm volatile("" : "+v"(lane));
    const int fr = lane & 15, fq = lane >> 4;
    constexpr int KQ = K / KS, UPI = (KS == 4) ? 4 : 8;
    for (int un = first; un < n_items * UPI; un += stride) {
        const int item = (KS == 4) ? (un >> 2) : (un >> 3), rg = (KS == 4) ? (un & 3) : ((un >> 1) & 3), mf = (KS == 4) ? (wave & 1) : (un & 1), kq = (KS == 4) ? (wave >> 1) : wave, mfs = (KS == 4) ? mf : 0;
        const int row = 32 * rg + 16 * mf + fr;
        const bf16* ap = As + (size_t)row * K + kq * KQ + 8 * fq;
        const bf16* bp[NF];
#pragma unroll
        for (int nf = 0; nf < NF; ++nf) bp[nf] = brow(item, nf) + (size_t)fr * K + kq * KQ + 8 * fq;
        f32x4 acc[NF];
#pragma unroll
        for (int nf = 0; nf < NF; ++nf) acc[nf] = (f32x4){0.f, 0.f, 0.f, 0.f};
        typename Epi::Pre pre = {};
        if (kq == 0) pre = E.pre(item, row, fr, fq);
#pragma unroll 8
        for (int ks = 0; ks < KQ / 32; ++ks) {
            const bf16x8 a = *(const bf16x8*)(ap + 32 * ks);
#pragma unroll
            for (int nf = 0; nf < NF; ++nf) { const bf16x8 b = *(const bf16x8*)(bp[nf] + 32 * ks); acc[nf] = __builtin_amdgcn_mfma_f32_16x16x32_bf16(b, a, acc[nf], 0, 0, 0); }
        }
        LAS f32x4* red = (LAS f32x4*)lds;
        if (kq > 0) {
#pragma unroll
            for (int nf = 0; nf < NF; ++nf) red[(((kq - 1) * 2 + mfs) * 64 + lane) * NF + nf] = acc[nf]; }
        __syncthreads();
        if (kq == 0) {
#pragma unroll
            for (int q = 0; q < KS - 1; ++q)
#pragma unroll
                for (int nf = 0; nf < NF; ++nf) acc[nf] += red[((q * 2 + mfs) * 64 + lane) * NF + nf];
            E(item, row, fr, fq, acc, pre);
        }
        __syncthreads();
    }
}
struct BRowPlain { const bf16* Bt; int K, NF; __device__ __forceinline__ const bf16* operator()(int item, int nf) const { return Bt + (size_t)(item * NF + nf) * 16 * K; } };
struct BRowConvIn { const bf16* Bt; __device__ __forceinline__ const bf16* operator()(int item, int nf) const { return Bt + (size_t)(1024 * nf + 16 * item) * DM; } };
struct SEpiInProj {
    bf16* QKVU; const float* rinv0; const float* qn; const float* kn; float* out;
    struct Pre { float rv; };
    __device__ __forceinline__ Pre pre(int item, int row, int fr, int fq) const { Pre p; p.rv = rinv0[(size_t)MPR + row]; return p; }
    __device__ __forceinline__ void operator()(int item, int row, int fr, int fq, f32x4 (&acc)[4], const Pre& pr) const {
        const int kind = item < 8 ? 0 : (item < 10 ? 1 : (item < 12 ? 2 : 3)), g = item & 1;
        const size_t r = (size_t)MPR + row; const float rv = pr.rv;
        f32x4 v[4];
#pragma unroll
        for (int nf = 0; nf < 4; ++nf) v[nf] = acc[nf] * rv;
        if (kind <= 1) {
            float ss = (sq4(v[0]) + sq4(v[1])) + (sq4(v[2]) + sq4(v[3]));
            ss += __shfl_xor(ss, 16); ss += __shfl_xor(ss, 32);
            const float rn = rsqrtf(ss * (1.0f / 64.0f) + EPS) * (kind == 0 ? QSCALE : 1.f); const float* gp = (kind == 0 ? qn : kn) + 4 * fq;
#pragma unroll
            for (int nf = 0; nf < 4; ++nf) v[nf] = v[nf] * rn * *(const f32x4*)(gp + 16 * nf);
        }
        bf16* rowp = QKVU + r * EVIN + 64 * item + 4 * fq;
#pragma unroll
        for (int nf = 0; nf < 4; ++nf) { u32x2 w; w.x = pk2(v[nf][0], v[nf][1]); w.y = pk2(v[nf][2], v[nf][3]); *(u32x2*)(rowp + 16 * nf) = w; }
        const int b = row >> 4, i16 = row & 15;
        float* dst = nullptr;
        if (kind == 1 || kind == 2) dst = out + (kind == 1 ? O_KS : O_VS) + ((size_t)(b * 128 + 112 + i16) * 2 + g) * 64 + 4 * fq;
        else if (kind == 3 && i16 >= 1) dst = out + O_PS + (size_t)(b * 15 + i16 - 1) * 512 + 64 * (item - 12) + 4 * fq;
        if (dst) {
#pragma unroll
            for (int nf = 0; nf < 4; ++nf) *(f32x4*)(dst + 16 * nf) = v[nf]; }
    }
};
template <int MODE, int NF> struct SEpiResid {
    const float* xin_f; bf16* XR; float* SSS; float* yout;
    struct Pre { u32x2 w[NF]; };
    __device__ __forceinline__ Pre pre(int item, int row, int fr, int fq) const { Pre p;
#pragma unroll
        for (int nf = 0; nf < NF; ++nf) p.w[nf] = *(const u32x2*)(XR + ((size_t)MPR + row) * DM + 16 * NF * item + 4 * fq + 16 * nf);
        return p; }
    __device__ __forceinline__ void operator()(int item, int row, int fr, int fq, f32x4 (&acc)[NF], const Pre& pr) const {
        const size_t r = (size_t)MPR + row; const int c = 16 * NF * item + 4 * fq;
        float ss = 0.f;
#pragma unroll
        for (int nf = 0; nf < NF; ++nf) {
            f32x4 x;
            if (MODE == 0) x = *(const f32x4*)(xin_f + (size_t)row * DM + c + 16 * nf);
            else { const u32x2 w = pr.w[nf]; x[0] = bf_lo(w.x); x[1] = bf_hi(w.x); x[2] = bf_lo(w.y); x[3] = bf_hi(w.y); }
            const f32x4 v = acc[nf] + x;
            if (MODE == 2) *(f32x4*)(yout + (size_t)row * DM + c + 16 * nf) = v;
            else { ss += sq4(v); u32x2 w; w.x = pk2(v[0], v[1]); w.y = pk2(v[2], v[3]); *(u32x2*)(XR + r * DM + c + 16 * nf) = w; }
        }
        if (MODE != 2) { static_assert(MODE == 2 || NF == 2, "32-slot layout"); ss += __shfl_xor(ss, 16); ss += __shfl_xor(ss, 32); if (fq == 0) SSS[row * 32 + item] = ss; }
    }
};
struct SRowPre { f32x4 a, b; };
__device__ __forceinline__ SRowPre srow_pre(const float* SSS, int row, int fq) { SRowPre p; p.a = *(const f32x4*)(SSS + row * 32 + 8 * fq); p.b = *(const f32x4*)(SSS + row * 32 + 8 * fq + 4); return p; }
__device__ __forceinline__ float srow_rinv(const SRowPre& p) {
    float s = ((p.a[0] + p.a[1]) + (p.a[2] + p.a[3])) + ((p.b[0] + p.b[1]) + (p.b[2] + p.b[3]));
    s += __shfl_xor(s, 16); s += __shfl_xor(s, 32);
    return rsqrtf(s * (1.0f / 1024.0f) + EPS);
}
struct SEpiUp {
    bf16* H; const float* SS;
    typedef SRowPre Pre;
    __device__ __forceinline__ Pre pre(int item, int row, int fr, int fq) const { return srow_pre(SS, row, fq); }
    __device__ __forceinline__ void operator()(int item, int row, int fr, int fq, f32x4 (&acc)[4], const Pre& pr) const {
        const size_t r = (size_t)MPR + row; const float rv = srow_rinv(pr);
#pragma unroll
        for (int nf = 0; nf < 4; ++nf) { f32x4 v = acc[nf] * rv;
#pragma unroll
            for (int i = 0; i < 4; ++i) { const float a = fmaxf(v[i], 0.f); v[i] = a * a; }
            u32x2 w; w.x = pk2(v[0], v[1]); w.y = pk2(v[2], v[3]); *(u32x2*)(H + r * DFF + 64 * item + 16 * nf + 4 * fq) = w; }
    }
};
struct SEpiConvIn {
    bf16* BE; const float* SS; float* out;
    typedef SRowPre Pre;
    __device__ __forceinline__ Pre pre(int item, int row, int fr, int fq) const { return srow_pre(SS, row, fq); }
    __device__ __forceinline__ void operator()(int item, int row, int fr, int fq, f32x4 (&acc)[3], const Pre& pr) const {
        const size_t r = (size_t)MPR + row; const float rv = srow_rinv(pr);
        const int ch0 = 16 * item + 4 * fq;
        { const f32x4 v = acc[0] * rv; u32x2 w; w.x = pk2(v[0], v[1]); w.y = pk2(v[2], v[3]); *(u32x2*)(BE + r * 2048 + ch0) = w; }
        const f32x4 e = (acc[1] * rv) * (acc[2] * rv);
        u32x2 w; w.x = pk2(e[0], e[1]); w.y = pk2(e[2], e[3]); *(u32x2*)(BE + r * 2048 + 1024 + ch0) = w;
        const int b = row >> 4, i16 = row & 15;
        if (i16 >= 14) *(f32x4*)(out + O_CS + (size_t)(b * 2 + i16 - 14) * 1024 + ch0) = e;
    }
};

#define XB_TMO      128
#define XB_XCNT(j)  (256  + 64 * (j))
#define XB_XSUB(j)  (1280 + 64 * (j))
#define XB_XGEN(j)  (2304 + 64 * (j))
#define XB_TOP      3328
#define XB_TOPGEN   3392
#define XCD_BAR_WORDS 3456
#define XB_SPIN_CAP (1u << 18)
__device__ __forceinline__ unsigned xb_ld(unsigned* p)              { return __hip_atomic_load(p, __ATOMIC_RELAXED, __HIP_MEMORY_SCOPE_AGENT); }
__device__ __forceinline__ unsigned xb_add(unsigned* p, unsigned v) { return __hip_atomic_fetch_add(p, v, __ATOMIC_RELAXED, __HIP_MEMORY_SCOPE_AGENT); }
__device__ __forceinline__ unsigned xb_xcc_id() { return (unsigned)__builtin_amdgcn_s_getreg((3 << 11) | 20) & 0xFu; }
#define XB_SPIN(cond, bar) do { unsigned _sp = 0; while (cond) { __builtin_amdgcn_s_sleep(1); \
    if ((++_sp & 255u) == 0u) { if (xb_ld(&(bar)[XB_TMO])) break; if (_sp > XB_SPIN_CAP) { atomicAdd(&(bar)[XB_TMO], 1u); break; } } } } while (0)
struct XcdBarrier { unsigned* bar; unsigned x; volatile LAS unsigned* st; };
__device__ __forceinline__ XcdBarrier xcd_barrier_post(unsigned* bar, volatile LAS unsigned* st) {
    XcdBarrier b; b.bar = bar; b.x = xb_xcc_id(); b.st = st;
    if (threadIdx.x == 0) (void)xb_add(&bar[XB_XCNT(b.x)], 1u);
    return b;
}
__device__ __forceinline__ void xcd_barrier_complete(unsigned* bar, unsigned x, unsigned& nloc, unsigned& nx) {
    const unsigned G = gridDim.x * gridDim.y * gridDim.z;
    unsigned sum, cnt, mine, sp = 0u;
    for (;;) {
        sum = 0u; cnt = 0u; mine = 0u;
#pragma unroll
        for (unsigned j = 0; j < 16; ++j) { const unsigned c = xb_ld(&bar[XB_XCNT(j)]); sum += c; cnt += (c > 0u) ? 1u : 0u; mine = (j == x) ? c : mine; }
        if (sum == G) break;
        __builtin_amdgcn_s_sleep(1);
        if ((++sp & 255u) == 0u) { if (xb_ld(&bar[XB_TMO])) break; if (sp > XB_SPIN_CAP) { atomicAdd(&bar[XB_TMO], 1u); break; } }
    }
    nloc = mine > 0u ? mine : 1u; nx = cnt > 0u ? cnt : 1u;
}
__device__ __forceinline__ void xcd_barrier(const XcdBarrier& b) {
    asm volatile("s_waitcnt vmcnt(0)" ::: "memory");
    __syncthreads();
    if (threadIdx.x == 0) {
        unsigned* bar = b.bar; asm volatile("" : "+s"(bar));
        __builtin_amdgcn_s_waitcnt(0);
        unsigned nloc = b.st[0], nx = b.st[1];
        if (nloc == 0u) { xcd_barrier_complete(bar, b.x, nloc, nx); b.st[0] = nloc; b.st[1] = nx; }
        const unsigned old = xb_add(&bar[XB_XSUB(b.x)], 1u);
        const unsigned gen = old / nloc;
        if (old + 1u == (gen + 1u) * nloc) {
            __builtin_amdgcn_fence(__ATOMIC_RELEASE, "agent");
            asm volatile("s_waitcnt vmcnt(0)" ::: "memory");
            const unsigned og = xb_add(&bar[XB_TOP], 1u);
            const unsigned tg = og / nx;
            __builtin_amdgcn_fence(__ATOMIC_ACQUIRE, "agent");
            if (og + 1u == (tg + 1u) * nx) xb_add(&bar[XB_TOPGEN], 1u);
            else XB_SPIN(xb_ld(&bar[XB_TOPGEN]) == tg, bar);
            xb_add(&bar[XB_XGEN(b.x)], 1u);
            asm volatile("s_waitcnt vmcnt(0)" ::: "memory");
        } else {
            __builtin_amdgcn_fence(__ATOMIC_ACQUIRE, "agent");
            XB_SPIN(xb_ld(&bar[XB_XGEN(b.x)]) == gen, bar);
            asm volatile("s_waitcnt vmcnt(0)" ::: "memory");
        }
    }
    __syncthreads();
}

constexpr int RING_OFF = 0, RING_BYTES = 131072;
constexpr int LDSCTL_OFF = RING_BYTES, MISC_OFF = LDSCTL_OFF + 320;
constexpr int RVT_OFF = LDSCTL_OFF + 512, RVT_UNITS = pg8::RVT_UNITS_;
constexpr int LDS_BYTES = 147456;
constexpr int AT_KL = 0, AT_VL = 24576, AT_BIAS = 49152, AT_WSF = 57344, AT_OST = 59392;
constexpr int PL_D = 0, PL_W = 32768;

__device__ __forceinline__ void build_row_scales(LAS unsigned char* lds, const pg8::StaticOrder& S, const float* SS) {
    int tid = threadIdx.x; asm volatile("" : "+v"(tid));
    LAS float* tab = (LAS float*)(lds + RVT_OFF);
    const int half = tid >> 8, t = tid & 255;
    for (int i0 = 0; i0 < RVT_UNITS; i0 += 4) {
        f32x4 p[2][4]; bool ok[2];
#pragma unroll
        for (int j = 0; j < 2; ++j) { pg8::Unit u; ok[j] = S.next(i0 + 2 * j + half, u); const size_t r = ok[j] ? (size_t)256 * u.pm + t : 0;
#pragma unroll
            for (int q = 0; q < 4; ++q) p[j][q] = *(const f32x4*)(SS + r * 16 + 4 * q); }
#pragma unroll
        for (int j = 0; j < 2; ++j) if (ok[j]) { const f32x4 a = (p[j][0] + p[j][1]) + (p[j][2] + p[j][3]); tab[(i0 + 2 * j + half) * 256 + t] = rsqrtf(((a[0] + a[1]) + (a[2] + a[3])) * (1.0f / 1024.0f) + EPS); }
        pg8::Unit u2; if (!S.next(i0 + 4, u2)) break;
    }
    __syncthreads();
}

template <bool GAIN>
__device__ __forceinline__ void transpose_item(const float* W, int K, int N, bf16* WT, const float* gain, LAS float* scr, int item, int lane) {
    const int nblk = N / 32, kb = item / nblk, nb = item % nblk, k0 = 64 * kb, n0 = 32 * nb;
    float wv[32];
    const float* wp = W + (size_t)(k0 + (lane >> 5)) * N + n0 + (lane & 31);
#pragma unroll
    for (int i = 0; i < 32; ++i) wv[i] = wp[(size_t)(2 * i) * N];
    float gl = 1.f; if (GAIN) gl = gain[k0 + lane];
#pragma unroll
    for (int i = 0; i < 32; ++i) { const int kk = 2 * i + (lane >> 5); const float gk = GAIN ? __shfl(gl, kk) : 1.f; scr[kk * 33 + (lane & 31)] = wv[i] * gk; }
    LDS_WAIT(); asm volatile("" ::: "memory");
    const int c = lane & 7;
#pragma unroll
    for (int j = 0; j < 4; ++j) { const int n = (lane >> 3) + 8 * j; const LAS float* s = scr + (8 * c) * 33 + n;
        u32x4 o; o.x = pk2(s[0 * 33], s[1 * 33]); o.y = pk2(s[2 * 33], s[3 * 33]); o.z = pk2(s[4 * 33], s[5 * 33]); o.w = pk2(s[6 * 33], s[7 * 33]);
        *(u32x4*)(WT + (size_t)(n0 + n) * K + k0 + 8 * c) = o; }
    LDS_WAIT(); asm volatile("" ::: "memory");
}

__device__ __forceinline__ int crow(int r, int hi) { return (r & 3) + 8 * (r >> 2) + 4 * hi; }
__device__ __forceinline__ void pv64(f32x16* o, int vb, bf16x8 pa0, bf16x8 pa1, bf16x8 pa2, bf16x8 pa3) {
#pragma unroll
    for (int d0 = 0; d0 < 2; ++d0) { s16x4 lo[4], hi[4];
#pragma unroll
        for (int ks = 0; ks < 4; ++ks) {
            asm volatile("ds_read_b64_tr_b16 %0,%1 offset:%c2" : "=&v"(lo[ks]) : "v"(vb), "i"(d0 * 4096 + ks * 1024) : "memory");
            asm volatile("ds_read_b64_tr_b16 %0,%1 offset:%c2" : "=&v"(hi[ks]) : "v"(vb), "i"(d0 * 4096 + ks * 1024 + 512) : "memory"); }
        asm volatile("s_waitcnt lgkmcnt(0)" ::: "memory"); __builtin_amdgcn_sched_barrier(0);
#define PK(k) (bf16x8){lo[k][0], lo[k][1], lo[k][2], lo[k][3], hi[k][0], hi[k][1], hi[k][2], hi[k][3]}
        o[d0] = __builtin_amdgcn_mfma_f32_32x32x16_bf16(pa0, PK(0), o[d0], 0, 0, 0);
        o[d0] = __builtin_amdgcn_mfma_f32_32x32x16_bf16(pa1, PK(1), o[d0], 0, 0, 0);
        o[d0] = __builtin_amdgcn_mfma_f32_32x32x16_bf16(pa2, PK(2), o[d0], 0, 0, 0);
        o[d0] = __builtin_amdgcn_mfma_f32_32x32x16_bf16(pa3, PK(3), o[d0], 0, 0, 0);
#undef PK
    }
}
__device__ __forceinline__ void attn_unit(LAS unsigned char* lds, const bf16* QKVU, bf16* MIX, const float* cache_k, const float* cache_v, const float* sinks,
                                          const int samp, const int b, const int c, const int g, const int wid) {
    int tid = threadIdx.x; asm volatile("" : "+v"(tid)); const int lane = tid & 63;
    LAS unsigned char* kl = lds + AT_KL; LAS unsigned char* vl = lds + AT_VL;
    u32x4 kvr[3], vvr[3];
    if (!samp) {
#pragma unroll
        for (int i = 0; i < 3; ++i) {
            const int p = tid + 512 * i, key = p >> 3, ch = p & 7;
            long t = 64 * (c - 2) + key; if (t < 0) t = 0;
            const bf16* rowp = QKVU + ((size_t)b * SEQ + (size_t)t) * EVIN;
            kvr[i] = *(const u32x4*)(rowp + 512 + 64 * g + 8 * ch); vvr[i] = *(const u32x4*)(rowp + 640 + 64 * g + 8 * ch);
        }
    } else {
        f32x4 ck[2][2], cv[2][2];
#pragma unroll
        for (int i = 0; i < 2; ++i) { const int p = tid + 512 * i, key = p >> 3, ch = p & 7; const size_t o = ((size_t)(b * 128 + key) * 2 + g) * 64 + 8 * ch;
            ck[i][0] = *(const f32x4*)(cache_k + o); ck[i][1] = *(const f32x4*)(cache_k + o + 4); cv[i][0] = *(const f32x4*)(cache_v + o); cv[i][1] = *(const f32x4*)(cache_v + o + 4); }
        { const int p = tid + 1024, key = p >> 3, ch = p & 7; const int kk = key < 144 ? key - 128 : 0;
          const bf16* rowp = QKVU + (size_t)(MPR + 16 * b + kk) * EVIN;
          kvr[2] = *(const u32x4*)(rowp + 512 + 64 * g + 8 * ch); vvr[2] = *(const u32x4*)(rowp + 640 + 64 * g + 8 * ch);
          if (key >= 144) { kvr[2] = (u32x4){0u, 0u, 0u, 0u}; vvr[2] = kvr[2]; } }
#pragma unroll
        for (int i = 0; i < 2; ++i) { kvr[i] = pk8(ck[i][0], ck[i][1]); vvr[i] = pk8(cv[i][0], cv[i][1]); }
    }
#pragma unroll
    for (int i = 0; i < 3; ++i) {
        const int p = tid + 512 * i, key = p >> 3, ch = p & 7;
        *(LAS u32x4*)(kl + (key >> 6) * 8192 + ch * 1024 + (key & 63) * 16) = kvr[i];
        *(LAS u32x4*)(vl + (key >> 6) * 8192 + (ch >> 2) * 4096 + ((key & 63) >> 4) * 1024 + (key & 15) * 64 + (ch & 3) * 16) = vvr[i];
    }
    const int hl = wid >> 1, qh = wid & 1, r32 = lane & 31, hi = lane >> 5, head = 4 * g + hl;
    const int q = samp ? (r32 & 15) : (32 * qh + r32);
    const size_t qrow = samp ? (size_t)(MPR + 16 * b + (r32 & 15)) : ((size_t)b * SEQ + 64 * c + q);
    const bf16* qp = QKVU + qrow * EVIN + 64 * head + 8 * hi;
    bf16x8 qr[4];
#pragma unroll
    for (int d0 = 0; d0 < 4; ++d0) qr[d0] = *(const bf16x8*)(qp + 16 * d0);
    __syncthreads();
    const LAS float* bt = (const LAS float*)(lds + AT_BIAS) + head * 256 + 63 - q;
    f32x16 p[6];
#pragma unroll
    for (int kt = 0; kt < 6; ++kt)
#pragma unroll
        for (int r = 0; r < 16; ++r) p[kt][r] = bt[32 * kt + crow(r, hi)];
#pragma unroll
    for (int kt = 0; kt < 6; ++kt) {
        const LAS unsigned char* kb = kl + (kt >> 1) * 8192 + hi * 1024 + ((kt & 1) * 32 + r32) * 16;
#pragma unroll
        for (int d0 = 0; d0 < 4; ++d0) { const bf16x8 kf = *(const LAS bf16x8*)(kb + d0 * 2048); p[kt] = __builtin_amdgcn_mfma_f32_32x32x16_bf16(kf, qr[d0], p[kt], 0, 0, 0); }
    }
    const int j0 = samp ? 0 : (c >= 2 ? 0 : 128 - 64 * c), j1 = samp ? 144 : 192;
    if (j0 > 0 || j1 < 192) {
#pragma unroll
        for (int kt = 0; kt < 6; ++kt)
#pragma unroll
            for (int r = 0; r < 16; ++r) { const int j = 32 * kt + crow(r, hi); if (j < j0 || j >= j1) p[kt][r] = -1e30f; }
    }
    const float sk = sinks[head] * LOG2E;
    float mx = sk;
#pragma unroll
    for (int kt = 0; kt < 6; ++kt)
#pragma unroll
        for (int r = 0; r < 16; ++r) mx = fmaxf(mx, p[kt][r]);
    mx = fmaxf(mx, __shfl_xor(mx, 32));
    float sum = 0.f;
#pragma unroll
    for (int kt = 0; kt < 6; ++kt)
#pragma unroll
        for (int r = 0; r < 16; ++r) { const float e = __builtin_amdgcn_exp2f(p[kt][r] - mx); p[kt][r] = e; sum += e; }
    sum += __shfl_xor(sum, 32);
    const float inv = 1.0f / (sum + __builtin_amdgcn_exp2f(sk - mx));
    f32x16 o[2]; o[0] = f32x16{}; o[1] = f32x16{};
    const int vb0 = (int)(unsigned)(uintptr_t)vl + ((lane >> 4) & 1) * 32 + (lane & 3) * 8 + (4 * hi + ((lane & 15) >> 2)) * 64;
#pragma unroll
    for (int t = 0; t < 3; ++t) {
        const f32x16& pa = p[2 * t]; const f32x16& pb = p[2 * t + 1];
        const u32x4 w0 = {pk2(pa[0], pa[1]), pk2(pa[2], pa[3]), pk2(pa[4], pa[5]), pk2(pa[6], pa[7])}, w1 = {pk2(pa[8], pa[9]), pk2(pa[10], pa[11]), pk2(pa[12], pa[13]), pk2(pa[14], pa[15])};
        const u32x4 w2 = {pk2(pb[0], pb[1]), pk2(pb[2], pb[3]), pk2(pb[4], pb[5]), pk2(pb[6], pb[7])}, w3 = {pk2(pb[8], pb[9]), pk2(pb[10], pb[11]), pk2(pb[12], pb[13]), pk2(pb[14], pb[15])};
        pv64(o, vb0 + t * 8192, __builtin_bit_cast(bf16x8, w0), __builtin_bit_cast(bf16x8, w1), __builtin_bit_cast(bf16x8, w2), __builtin_bit_cast(bf16x8, w3));
    }
    int lane2 = threadIdx.x & 63; asm volatile("" : "+v"(lane2));
    const int r32b = lane2 & 31, hib = lane2 >> 5;
    LAS float* wsf = (LAS float*)(lds + AT_WSF) + wid * 64;
    if (hib == 0) wsf[r32b] = inv;
    LDS_WAIT(); __builtin_amdgcn_wave_barrier();
    float rli[16];
#pragma unroll
    for (int r = 0; r < 16; ++r) rli[r] = wsf[crow(r, hib)];
    LAS bf16* stg = (LAS bf16*)(lds + AT_OST) + wid * 2048;
#pragma unroll
    for (int r = 0; r < 16; ++r) { const int orow = crow(r, hib);
#pragma unroll
        for (int d0 = 0; d0 < 2; ++d0) stg[orow * 64 + d0 * 32 + r32b] = (bf16)(pk2(o[d0][r] * rli[r], 0.f) & 0xffffu); }
    LDS_WAIT(); __builtin_amdgcn_wave_barrier();
#pragma unroll
    for (int i = 0; i < 4; ++i) { const int row = i * 8 + (lane2 >> 3), ch = lane2 & 7; const u32x4 v = *(const LAS u32x4*)(stg + row * 64 + ch * 8);
        if (!samp) *(u32x4*)(MIX + ((size_t)b * SEQ + 64 * c + 32 * qh + row) * DM + 64 * head + ch * 8) = v;
        else if (qh == 0 && row < 16) *(u32x4*)(MIX + (size_t)(MPR + 16 * b + row) * DM + 64 * head + ch * 8) = v; }
    __syncthreads();
}

template <int W> __device__ __forceinline__ void pool_group(LAS unsigned char* dt, const float (&x0)[31], const float (&x1)[31], const int pos0, const bool fixed_cnt, const int lane) {
    float s0 = 0.f, s1 = 0.f;
#pragma unroll
    for (int k = 1; k < W; ++k) { s0 += x0[15 - k]; s1 += x1[15 - k]; }
#pragma unroll
    for (int i = 0; i < 16; ++i) {
        s0 += x0[15 + i]; s1 += x1[15 + i];
        const int pos = pos0 + i; const float cnt = fixed_cnt ? (float)W : (float)((pos + 1) < W ? (pos + 1) : W);
        const float ic = 1.0f / cnt;
        const float d0 = s0 * ic - x0[15 + i], d1 = s1 * ic - x1[15 + i];
        *(LAS unsigned*)(dt + i * 256 + ((((lane >> 2) ^ i) & 15) << 4) + (lane & 3) * 4) = pk2(d0, d1);
        s0 -= x0[15 + i - (W - 1)]; s1 -= x1[15 + i - (W - 1)];
    }
}
template <bool WLDS>
__device__ __forceinline__ void pool_item(LAS unsigned char* lds, const bf16* QKVU, bf16* MIX, const float* state_pool, const bf16* POOLW, const float* pool_scale,
                                          const int samp, const size_t row0  , const int sb  , const int g, const int wid) {
    int lane = threadIdx.x & 63; asm volatile("" : "+v"(lane));
    LAS unsigned char* dt = lds + PL_D + wid * 4096;
    const int fr = lane & 15, fq = lane >> 4;
    const int t0 = samp ? 1024 : (int)(row0 & (SEQ - 1));
    {
        float x0[31], x1[31];
        const int col = 768 + 128 * g + 2 * lane;
        unsigned wseg[16];
#pragma unroll
        for (int e = 0; e < 16; ++e) wseg[e] = *(const unsigned*)(QKVU + (row0 + e) * EVIN + col);
        if (samp) {
            const float* sp = state_pool + (size_t)sb * 15 * 512 + 128 * g + 2 * lane;
            f32x2 hv[15];
#pragma unroll
            for (int e = 0; e < 15; ++e) hv[e] = *(const f32x2*)(sp + (size_t)e * 512);
#pragma unroll
            for (int e = 0; e < 15; ++e) { x0[e] = hv[e][0]; x1[e] = hv[e][1]; }
        } else if (t0 == 0) {
#pragma unroll
            for (int e = 0; e < 15; ++e) { x0[e] = 0.f; x1[e] = 0.f; }
        } else {
            unsigned wh[15];
#pragma unroll
            for (int e = 0; e < 15; ++e) wh[e] = *(const unsigned*)(QKVU + (row0 - 15 + e) * EVIN + col);
#pragma unroll
            for (int e = 0; e < 15; ++e) { x0[e] = bf_lo(wh[e]); x1[e] = bf_hi(wh[e]); }
        }
#pragma unroll
        for (int e = 0; e < 16; ++e) { x0[15 + e] = bf_lo(wseg[e]); x1[15 + e] = bf_hi(wseg[e]); }
        if (g == 0) pool_group<2>(dt, x0, x1, t0, samp != 0, lane);
        else if (g == 1) pool_group<4>(dt, x0, x1, t0, samp != 0, lane);
        else if (g == 2) pool_group<8>(dt, x0, x1, t0, samp != 0, lane);
        else pool_group<16>(dt, x0, x1, t0, samp != 0, lane);
    }
    LDS_WAIT(); __builtin_amdgcn_wave_barrier();
    bf16x8 wf[8][4];
    if (WLDS) {
        const LAS unsigned char* pw = lds + PL_W + (g & 1) * 32768 + fr * 256;
#pragma unroll
        for (int nf = 0; nf < 8; ++nf)
#pragma unroll
            for (int ks = 0; ks < 4; ++ks) wf[nf][ks] = *(const LAS bf16x8*)(pw + nf * 4096 + ((((4 * ks + fq) ^ fr) & 15) << 4));
    } else {
        const bf16* wp = POOLW + (size_t)g * 16384 + (size_t)fr * 128 + 8 * fq;
#pragma unroll
        for (int nf = 0; nf < 8; ++nf)
#pragma unroll
            for (int ks = 0; ks < 4; ++ks) wf[nf][ks] = *(const bf16x8*)(wp + (size_t)nf * 16 * 128 + 32 * ks);
    }
    bf16x8 af[4];
#pragma unroll
    for (int ks = 0; ks < 4; ++ks) af[ks] = *(const LAS bf16x8*)(dt + fr * 256 + ((((4 * ks + fq) ^ fr) & 15) << 4));
    const float* scp = pool_scale + 128 * g + 4 * fq;
    bf16* orow = MIX + (row0 + fr) * DM + 512 + 128 * g + 4 * fq;
#pragma unroll
    for (int nf = 0; nf < 8; ++nf) {
        f32x4 acc = {0.f, 0.f, 0.f, 0.f};
#pragma unroll
        for (int ks = 0; ks < 4; ++ks) acc = __builtin_amdgcn_mfma_f32_16x16x32_bf16(wf[nf][ks], af[ks], acc, 0, 0, 0);
        const f32x4 sc = *(const f32x4*)(scp + 16 * nf);
        acc = acc * sc;
        u32x2 w; w.x = pk2(acc[0], acc[1]); w.y = pk2(acc[2], acc[3]);
        *(u32x2*)(orow + 16 * nf) = w;
    }
    LDS_WAIT(); __builtin_amdgcn_wave_barrier();
}

template <int W> __device__ __forceinline__ void pool_seg_loads(const bf16* QKVU, const size_t row0, const int g, const int lane, unsigned (&raw)[W + 15]) {
    const bf16* p = QKVU + row0 * EVIN + 768 + 128 * g + 2 * lane;
#pragma unroll
    for (int e = 0; e < 16; ++e) raw[W - 1 + e] = *(const unsigned*)(p + (size_t)e * EVIN);
}
template <int W> __device__ __forceinline__ void pool_halo_loads(const bf16* QKVU, const size_t row0, const int g, const int lane, unsigned (&raw)[W + 15]) {
    const bf16* p = QKVU + row0 * EVIN + 768 + 128 * g + 2 * lane;
#pragma unroll
    for (int e = 0; e < W - 1; ++e) raw[e] = *(const unsigned*)(p - (size_t)(W - 1 - e) * EVIN);
}
template <int W> __device__ __forceinline__ void pool_halo_zero(unsigned (&raw)[W + 15]) {
#pragma unroll
    for (int e = 0; e < W - 1; ++e) raw[e] = 0u;
}
template <int W> __device__ __forceinline__ void pool_compute(LAS unsigned char* lds, bf16* MIX, const float* pool_scale, const unsigned (&raw)[W + 15], const size_t row0, const int t0, const int g, const int wid, const int lane) {
    LAS unsigned char* dt = lds + PL_D + wid * 4096;
    const int fr = lane & 15, fq = lane >> 4;
    float s0 = 0.f, s1 = 0.f;
#pragma unroll
    for (int e = 0; e < W - 1; ++e) { s0 += bf_lo(raw[e]); s1 += bf_hi(raw[e]); }
#pragma unroll
    for (int i = 0; i < 16; ++i) {
        const float u0 = bf_lo(raw[W - 1 + i]), u1 = bf_hi(raw[W - 1 + i]);
        s0 += u0; s1 += u1;
        const int pos = t0 + i; const float ic = 1.0f / (float)((pos + 1) < W ? (pos + 1) : W);
        *(LAS unsigned*)(dt + i * 256 + ((((lane >> 2) ^ i) & 15) << 4) + (lane & 3) * 4) = pk2(s0 * ic - u0, s1 * ic - u1);
        s0 -= bf_lo(raw[i]); s1 -= bf_hi(raw[i]);
    }
    LDS_WAIT(); __builtin_amdgcn_wave_barrier();
    bf16x8 wf[8][4];
    const LAS unsigned char* pw = lds + PL_W + (g & 1) * 32768 + fr * 256;
#pragma unroll
    for (int nf = 0; nf < 8; ++nf)
#pragma unroll
        for (int ks = 0; ks < 4; ++ks) wf[nf][ks] = *(const LAS bf16x8*)(pw + nf * 4096 + ((((4 * ks + fq) ^ fr) & 15) << 4));
    bf16x8 af[4];
#pragma unroll
    for (int ks = 0; ks < 4; ++ks) af[ks] = *(const LAS bf16x8*)(dt + fr * 256 + ((((4 * ks + fq) ^ fr) & 15) << 4));
    const float* scp = pool_scale + 128 * g + 4 * fq;
    bf16* orow = MIX + (row0 + fr) * DM + 512 + 128 * g + 4 * fq;
#pragma unroll
    for (int nf = 0; nf < 8; ++nf) {
        f32x4 acc = {0.f, 0.f, 0.f, 0.f};
#pragma unroll
        for (int ks = 0; ks < 4; ++ks) acc = __builtin_amdgcn_mfma_f32_16x16x32_bf16(wf[nf][ks], af[ks], acc, 0, 0, 0);
        const f32x4 sc = *(const f32x4*)(scp + 16 * nf);
        acc = acc * sc;
        u32x2 w; w.x = pk2(acc[0], acc[1]); w.y = pk2(acc[2], acc[3]);
        *(u32x2*)(orow + 16 * nf) = w;
    }
    LDS_WAIT(); __builtin_amdgcn_wave_barrier();
}
__device__ __forceinline__ void pool_stage_weights(LAS unsigned char* lds, const u32x4 (&wv)[8], const int t2) {
#pragma unroll
    for (int i = 0; i < 8; ++i) { const int chunk = t2 + 512 * i, row = chunk >> 4, c16 = chunk & 15; *(LAS u32x4*)(lds + PL_W + row * 256 + (((c16 ^ row) & 15) << 4)) = wv[i]; }
}
__device__ __forceinline__ void pool_unit_prompt(LAS unsigned char* lds, const bf16* QKVU, bf16* MIX, const bf16* POOLW, const float* pool_scale, const size_t row0, const int wid) {
    int t2 = threadIdx.x; asm volatile("" : "+v"(t2)); const int lane = t2 & 63;
    const int t0 = (int)(row0 & (SEQ - 1));
    u32x4 wv0[8], wv1[8];
#pragma unroll
    for (int i = 0; i < 8; ++i) wv0[i] = *(const u32x4*)(POOLW + (size_t)(t2 + 512 * i) * 8);
    unsigned r0[17], r1[19], r2[23], r3[31];
    pool_seg_loads<2>(QKVU, row0, 0, lane, r0); pool_seg_loads<4>(QKVU, row0, 1, lane, r1); pool_seg_loads<8>(QKVU, row0, 2, lane, r2); pool_seg_loads<16>(QKVU, row0, 3, lane, r3);
    if (t0 != 0) { pool_halo_loads<2>(QKVU, row0, 0, lane, r0); pool_halo_loads<4>(QKVU, row0, 1, lane, r1); pool_halo_loads<8>(QKVU, row0, 2, lane, r2); pool_halo_loads<16>(QKVU, row0, 3, lane, r3); }
    else { pool_halo_zero<2>(r0); pool_halo_zero<4>(r1); pool_halo_zero<8>(r2); pool_halo_zero<16>(r3); }
#pragma unroll
    for (int i = 0; i < 8; ++i) wv1[i] = *(const u32x4*)(POOLW + 32768 + (size_t)(t2 + 512 * i) * 8);
    pool_stage_weights(lds, wv0, t2);
    __syncthreads();
    pool_compute<2>(lds, MIX, pool_scale, r0, row0, t0, 0, wid, lane);
    pool_compute<4>(lds, MIX, pool_scale, r1, row0, t0, 1, wid, lane);
    __syncthreads();
    pool_stage_weights(lds, wv1, t2);
    __syncthreads();
    pool_compute<8>(lds, MIX, pool_scale, r2, row0, t0, 2, wid, lane);
    pool_compute<16>(lds, MIX, pool_scale, r3, row0, t0, 3, wid, lane);
    __syncthreads();
}

struct Args { const float* in[21]; float* out; unsigned char* ws; int ph_lo, ph_hi; };
static_assert(sizeof(Args) == 21 * 8 + 8 + 8 + 8, "Args has no padding");
static_assert(RVT_OFF + RVT_UNITS * 1024 <= LDS_BYTES, "row-scale table fits");

#define CAS __attribute__((address_space(4)))
__global__ void __launch_bounds__(512, 2) trunk_fwd(Args args_unused) {
    extern __shared__ __attribute__((aligned(16))) unsigned char lds_raw[];
    LAS unsigned char* lds = (LAS unsigned char*)lds_raw;
    volatile LAS unsigned* MISC = (volatile LAS unsigned*)(lds + MISC_OFF);
    const int wave = __builtin_amdgcn_readfirstlane(threadIdx.x >> 6);
    const int G = gridDim.x; const int bx = blockIdx.x; const int vcu = (G % 8 == 0) ? (bx % 8) * (G / 8) + bx / 8 : bx;
    const CAS Args* kp0 = (const CAS Args*)__builtin_amdgcn_kernarg_segment_ptr();
#define KP(name) const CAS Args* name = kp0; asm volatile("" : "+s"(name))
#define WSP(kp, off) ((kp)->ws + (off))
    for (int u = threadIdx.x; u < (LDS_BYTES - LDSCTL_OFF) / 4; u += 512) ((LAS unsigned*)(lds + LDSCTL_OFF))[u] = 0u;
    __syncthreads();
    XcdBarrier bar;
    { KP(kp); unsigned* ctl = (unsigned*)WSP(kp, WS_CTL); bar.bar = ctl + CW_BAR; bar.x = 0; bar.st = nullptr;
      if (N_LAUNCHES == 1) bar = xcd_barrier_post(ctl + CW_BAR, MISC + 8); }
    const int lo = kp0->ph_lo, hi = kp0->ph_hi;
#ifndef PROBE_DUP
#define PROBE_DUP (-1)
#endif
#define REP(k) for (int rep_ = 0; rep_ < ((PROBE_DUP == (k)) ? 2 : 1); ++rep_)
#define IN(k) (lo <= (k) && (k) < hi)
#define PH_TID() int tid = threadIdx.x; asm volatile("" : "+v"(tid)); const int lane = tid & 63
#define SEAM(k) do { if (IN(k) && IN((k) + 1)) xcd_barrier(bar); } while (0)
    const int gw = vcu * 8 + wave, NGW = G * 8;

    REP(0) {
    if (IN(0)) {
        PH_TID(); KP(kp); unsigned char* ws = kp->ws; float* out = kp->out;
        const float* x_prompt = kp->in[0]; const float* x_sample = kp->in[1]; const float* cache_k = kp->in[2]; const float* cache_v = kp->in[3];
        const float* norm_mix = kp->in[6]; const float* norm_ffn = kp->in[7]; const float* ffn_w1 = kp->in[8]; const float* ffn_w2 = kp->in[9]; const float* ev_w_in = kp->in[10]; const float* ev_w_out = kp->in[11];
        const float* pool_w = kp->in[16]; const float* conv_w_in = kp->in[18]; const float* conv_w_out = kp->in[20];
        float* RINV0 = (float*)(ws + WS_RINV0); bf16* POOLW = (bf16*)(ws + WS_POOLW); bf16* WIN = (bf16*)(ws + WS_WIN); bf16* WOUT = (bf16*)(ws + WS_WOUT); bf16* W1 = (bf16*)(ws + WS_W1); bf16* W2 = (bf16*)(ws + WS_W2);
        bf16* WCIN = (bf16*)(ws + WS_WCIN); bf16* WCOUT = (bf16*)(ws + WS_WCOUT); bf16* S1 = (bf16*)(ws + WS_S1);
        LAS float* scr = (LAS float*)(lds + RING_OFF + wave * 16384);
        constexpr int I_IN = 16 * 40, I_OUT = 16 * 32, I_W1 = 16 * 128, I_W2 = 64 * 32, I_CIN = 16 * 96, I_COUT = 16 * 32, I_PW = 4 * 8;
        constexpr int NITEMS = I_IN + I_OUT + I_W1 + I_W2 + I_CIN + I_COUT + I_PW;
        for (int it = gw; it < NITEMS; it += NGW) {
            int r = it;
            if (r < I_IN) { transpose_item<true>(ev_w_in, DM, EVIN, WIN, norm_mix, scr, r, lane); continue; } r -= I_IN;
            if (r < I_OUT) { transpose_item<false>(ev_w_out, DM, DM, WOUT, nullptr, scr, r, lane); continue; } r -= I_OUT;
            if (r < I_W1) { transpose_item<true>(ffn_w1, DM, DFF, W1, norm_ffn, scr, r, lane); continue; } r -= I_W1;
            if (r < I_W2) { transpose_item<false>(ffn_w2, DFF, DM, W2, nullptr, scr, r, lane); continue; } r -= I_W2;
            if (r < I_CIN) { transpose_item<true>(conv_w_in, DM, CIN, WCIN, norm_mix + DM, scr, r, lane); continue; } r -= I_CIN;
            if (r < I_COUT) { transpose_item<false>(conv_w_out, DM, DM, WCOUT, nullptr, scr, r, lane); continue; } r -= I_COUT;
            { const int g = r >> 3; transpose_item<false>(pool_w + (size_t)g * 16384, 128, 128, POOLW + (size_t)g * 16384, nullptr, scr, r & 7, lane); }
        }
        for (int m = gw * 4; m < MT; m += NGW * 4) {
            const float* xr = (m < MPR) ? x_prompt + (size_t)m * DM : x_sample + (size_t)(m - MPR) * DM;
            const f32x4* x4 = (const f32x4*)xr + lane;
            f32x4 v[4][4]; float sr[4];
#pragma unroll
            for (int q = 0; q < 4; ++q)
#pragma unroll
                for (int j = 0; j < 4; ++j) v[q][j] = x4[256 * q + 64 * j];
#pragma unroll
            for (int q = 0; q < 4; ++q) { sr[q] = (sq4(v[q][0]) + sq4(v[q][1])) + (sq4(v[q][2]) + sq4(v[q][3])); }
#pragma unroll
            for (int o = 1; o < 64; o <<= 1) {
#pragma unroll
                for (int q = 0; q < 4; ++q) sr[q] += __shfl_xor(sr[q], o); }
            if (lane < 4) { const float sv = lane == 0 ? sr[0] : (lane == 1 ? sr[1] : (lane == 2 ? sr[2] : sr[3])); RINV0[m + lane] = rsqrtf(sv * (1.0f / 1024.0f) + EPS); }
#pragma unroll
            for (int q = 0; q < 4; ++q) { const int mr = m + q;
                bf16* o8 = (mr < MPR) ? S1 + (size_t)(mr >> 8) * 256 * DM + (size_t)(lane >> 3) * 8192 + (size_t)(mr & 255) * 32 + 4 * (lane & 7) : S1 + (size_t)mr * DM + 4 * lane;
                const size_t js = (mr < MPR) ? (size_t)8 * 8192 : (size_t)256;
#pragma unroll
                for (int j = 0; j < 4; ++j) { u32x2 w; w.x = pk2(v[q][j][0], v[q][j][1]); w.y = pk2(v[q][j][2], v[q][j][3]); *(u32x2*)(o8 + js * j) = w; } }
        }
        { const f32x4* ck = (const f32x4*)cache_k; const f32x4* cv = (const f32x4*)cache_v; f32x4* ok = (f32x4*)(out + O_KS); f32x4* ov = (f32x4*)(out + O_VS);
          for (int e = vcu * 512 + tid; e < 2 * 8 * 3584; e += G * 512) { const int which = e / 28672, rem = e % 28672, b = rem / 3584, i = rem % 3584;
              if (which == 0) ok[b * 4096 + i] = ck[b * 4096 + 512 + i]; else ov[b * 4096 + i] = cv[b * 4096 + 512 + i]; } }
    }
    SEAM(0);
    }

    REP(1) {
    if (IN(1)) {
        PH_TID(); KP(kp); unsigned char* ws = kp->ws; float* out = kp->out; const float* q_norm = kp->in[12]; const float* k_norm = kp->in[13];
        bf16* S1 = (bf16*)(ws + WS_S1); bf16* WIN = (bf16*)(ws + WS_WIN); bf16* QKVU = (bf16*)(ws + WS_QKVU); float* RINV0 = (float*)(ws + WS_RINV0);
        { BRowPlain br{WIN, DM, 4}; SEpiInProj SE{QKVU, RINV0, q_norm, k_norm, out};
          sample_gemm<DM, 4, 4>(lds + RING_OFF, S1 + (size_t)MPR * DM, 20, (bx + G / 2) % G, G, br, SE, lane, wave); }
        pg8::MapHeadAT<DM> mp{(const char*)S1, (const char*)WIN}; pg8::StaticOrder S; S.init(NTILE, EVIN / 256, G, bx);
        pg8::EpiInProj E{QKVU, RINV0, q_norm, k_norm, out};
        pg8::gemm_phase<DM, pg8::EpiInProj, pg8::MapHeadAT<DM>>(lds + RING_OFF, mp, S, E);
        { const int nun = NTILE * (EVIN / 256), rem = nun % G, nlate = (rem == 0) ? G : G - rem;
          if (rem == 0 || bx >= rem) {
              const float* norm_ffn = kp->in[7]; const float* ffn_w1 = kp->in[8]; const float* ffn_w2 = kp->in[9];
              bf16* W1B = (bf16*)(out + O_YP); bf16* W2B = (bf16*)(ws + WS_W2B);
              LAS float* scr = (LAS float*)(lds + RING_OFF + wave * 16384);
              constexpr int I_W1 = 16 * 128, I_W2 = 64 * 32;
              for (int it = ((rem == 0) ? bx : bx - rem) * 8 + wave; it < I_W1 + I_W2; it += nlate * 8) {
                  if (it < I_W1) transpose_item<true>(ffn_w1 + (size_t)DM * DFF, DM, DFF, W1B, norm_ffn + DM, scr, it, lane);
                  else transpose_item<false>(ffn_w2 + (size_t)DFF * DM, DFF, DM, W2B, nullptr, scr, it - I_W1, lane); } } }
    }
    SEAM(1);
    }

    REP(2) {
    if (IN(2)) {
        PH_TID(); KP(kp); unsigned char* ws = kp->ws; const float* cache_k = kp->in[2]; const float* cache_v = kp->in[3]; const float* state_pool = kp->in[4];
        const float* attn_sinks = kp->in[14]; const float* rel_bias = kp->in[15]; const float* pool_scale = kp->in[17];
        bf16* QKVU = (bf16*)(ws + WS_QKVU); bf16* POOLW = (bf16*)(ws + WS_POOLW);
        bf16* MIX = (bf16*)(ws + WS_S0);
        { LAS float* bt = (LAS float*)(lds + AT_BIAS);
          for (int e = tid; e < 8 * 256; e += 512) { const int h = e >> 8, idx = e & 255; float v = 0.f;
              if (idx < 255) { const int rel = idx - 191, n = rel < 0 ? -rel : rel; int bk = n < 8 ? n : (33 - __builtin_clz((unsigned)(n * n))); if (bk > 15) bk = 15; if (rel > 0) bk += 16; v = rel_bias[bk * 8 + h] * LOG2E; }
              bt[e] = v; } }
        __syncthreads();
        for (int un = vcu * 4, cnt = 0; un < 1040; ) {
            const int samp = un >= 1024 ? 1 : 0, sidx = un - 1024;
            const int ub = samp ? (sidx >> 1) : (un >> 9), ug = samp ? (sidx & 1) : ((un >> 8) & 1), uc = samp ? 0 : (un & 255);
            attn_unit(lds, QKVU, MIX, cache_k, cache_v, attn_sinks, samp, ub, uc, ug, wave);
            ++cnt;
            if (cnt < 4) ++un;
            else if (cnt == 4) un = (4 * G >= 1024) ? 1024 + vcu : 4 * G + vcu;
            else un += G;
        }
        for (int pu = vcu; pu < 256; pu += G) pool_unit_prompt(lds, QKVU, MIX, POOLW, pool_scale, (size_t)pu * 128 + wave * 16, wave);
        if (wave == 0) for (int it = (G >= 64) ? vcu - G / 2 : vcu; it >= 0 && it < 32; it += G) pool_item<false>(lds, QKVU, MIX, state_pool, POOLW, pool_scale, 1, (size_t)MPR + (it >> 2) * 16, it >> 2, it & 3, wave);
    }
    SEAM(2);
    }

    REP(3) {
    if (IN(3)) {
        PH_TID(); KP(kp); unsigned char* ws = kp->ws; float* out = kp->out; const float* x_prompt = kp->in[0]; const float* x_sample = kp->in[1];
        bf16* S0 = (bf16*)(ws + WS_S0); bf16* S1 = (bf16*)(ws + WS_S1); bf16* WOUT = (bf16*)(ws + WS_WOUT); float* SS = (float*)(ws + WS_SS); float* XP = out + O_YP; float* XS = out + O_YS;
        pg8::MapHead<DM> mp{(const char*)S0, (const char*)WOUT}; pg8::StaticOrder S; S.init(NTILE, DM / 256, G, bx);
        { BRowPlain br{WOUT, DM, 2}; SEpiResid<1, 2> SE{nullptr, S1, SS + (size_t)MT * 16, nullptr}; sample_gemm<DM, 2, 8>(lds + RING_OFF, S0 + (size_t)MPR * DM, 32, vcu, G, br, SE, lane, wave); }
        pg8::EpiResid<1> E{nullptr, S1, SS, nullptr};
        pg8::gemm_phase<DM, pg8::EpiResid<1>, pg8::MapHead<DM>>(lds + RING_OFF, mp, S, E);
    }
    SEAM(3);
    }
    REP(4) {
    if (IN(4)) {
        PH_TID(); KP(kp); unsigned char* ws = kp->ws; bf16* S1 = (bf16*)(ws + WS_S1); bf16* W1 = (bf16*)(ws + WS_W1); bf16* H = (bf16*)(ws + WS_H); float* SS = (float*)(ws + WS_SS);
        { BRowPlain br{W1, DM, 4}; SEpiUp SE{H, SS + (size_t)MT * 16}; sample_gemm<DM, 4, 4>(lds + RING_OFF, S1 + (size_t)MPR * DM, 64, vcu, G, br, SE, lane, wave); }
        pg8::MapHeadAT<DM> mp{(const char*)S1, (const char*)W1}; pg8::StaticOrder S; S.init(NTILE, DFF / 256, G, bx);
        build_row_scales(lds, S, SS);
        pg8::EpiUp E{H, (const LAS float*)(lds + RVT_OFF), SS};
        pg8::gemm_phase<DM, pg8::EpiUp, pg8::MapHeadAT<DM>>(lds + RING_OFF, mp, S, E);
    }
    SEAM(4);
    }
    REP(5) {
    if (IN(5)) {
        PH_TID(); KP(kp); unsigned char* ws = kp->ws; float* out = kp->out; bf16* S1 = (bf16*)(ws + WS_S1); bf16* W2 = (bf16*)(ws + WS_W2); bf16* H = (bf16*)(ws + WS_H); float* SS = (float*)(ws + WS_SS); float* XP = out + O_YP; float* XS = out + O_YS;
        pg8::MapHeadAT<DFF> mp{(const char*)H, (const char*)W2}; pg8::StaticOrder S; S.init(NTILE, DM / 256, G, bx);
        { BRowPlain br{W2, DFF, 2}; SEpiResid<1, 2> SE{nullptr, S1, SS + (size_t)MT * 16, nullptr}; sample_gemm<DFF, 2, 8>(lds + RING_OFF, H + (size_t)MPR * DFF, 32, vcu, G, br, SE, lane, wave); }
        pg8::EpiResid<1> E{nullptr, S1, SS, nullptr};
        pg8::gemm_phase<DFF, pg8::EpiResid<1>, pg8::MapHeadAT<DFF>>(lds + RING_OFF, mp, S, E);
    }
    SEAM(5);
    }
    REP(6) {
    if (IN(6)) {
        PH_TID(); KP(kp); unsigned char* ws = kp->ws; float* out = kp->out; bf16* S1 = (bf16*)(ws + WS_S1); bf16* WCIN = (bf16*)(ws + WS_WCIN); bf16* BE = (bf16*)(ws + WS_H); float* SS = (float*)(ws + WS_SS);
        pg8::MapConvIn<DM> mp{(const char*)S1, (const char*)WCIN}; pg8::StaticOrder S; S.init(NTILE, CIN / 256, G, bx);
        { BRowConvIn br{WCIN}; SEpiConvIn SE{BE, SS + (size_t)MT * 16, out}; sample_gemm<DM, 3, 4>(lds + RING_OFF, S1 + (size_t)MPR * DM, 64, vcu, G, br, SE, lane, wave); }
        build_row_scales(lds, S, SS);
        pg8::EpiConvIn E{BE, (const LAS float*)(lds + RVT_OFF), SS, out};
        pg8::gemm_phase<DM, pg8::EpiConvIn, pg8::MapConvIn<DM>>(lds + RING_OFF, mp, S, E);
    }
    SEAM(6);
    }
    REP(7) {
    if (IN(7)) {
        PH_TID(); KP(kp); unsigned char* ws = kp->ws; const float* state_conv = kp->in[5]; const float* norm_ffn = kp->in[7]; const float* ffn_w1 = kp->in[8]; const float* ffn_w2 = kp->in[9]; const float* conv_w = kp->in[19];
        bf16* S0 = (bf16*)(ws + WS_S0); bf16* W1 = (bf16*)(ws + WS_W1); bf16* W2 = (bf16*)(ws + WS_W2); bf16* BE = (bf16*)(ws + WS_H);
        const int cg = tid & 127, seg = tid >> 7;
        f32x4 w0a = *(const f32x4*)(conv_w + 8 * cg), w0b = *(const f32x4*)(conv_w + 8 * cg + 4);
        f32x4 w1a = *(const f32x4*)(conv_w + DM + 8 * cg), w1b = *(const f32x4*)(conv_w + DM + 8 * cg + 4);
        f32x4 w2a = *(const f32x4*)(conv_w + 2 * DM + 8 * cg), w2b = *(const f32x4*)(conv_w + 2 * DM + 8 * cg + 4);
        for (int un = vcu; un < MPR / 64; un += G) {
            const size_t r0 = (size_t)un * 64 + seg * 16;
            f32x4 p2a, p2b, p1a, p1b;
            if (r0 >= (size_t)MPR) { const int b = (int)((r0 - MPR) >> 4); const float* sp = state_conv + (size_t)b * 2 * DM + 8 * cg;
                p2a = *(const f32x4*)sp; p2b = *(const f32x4*)(sp + 4); p1a = *(const f32x4*)(sp + DM); p1b = *(const f32x4*)(sp + DM + 4); }
            else if ((r0 & (SEQ - 1)) == 0) { p2a = (f32x4){0.f, 0.f, 0.f, 0.f}; p2b = p2a; p1a = p2a; p1b = p2a; }
            else { const u32x4 e2 = *(const u32x4*)(BE + be_off(r0 - 2, 1024 + 8 * cg)), e1 = *(const u32x4*)(BE + be_off(r0 - 1, 1024 + 8 * cg));
                p2a = (f32x4){bf_lo(e2.x), bf_hi(e2.x), bf_lo(e2.y), bf_hi(e2.y)}; p2b = (f32x4){bf_lo(e2.z), bf_hi(e2.z), bf_lo(e2.w), bf_hi(e2.w)};
                p1a = (f32x4){bf_lo(e1.x), bf_hi(e1.x), bf_lo(e1.y), bf_hi(e1.y)}; p1b = (f32x4){bf_lo(e1.z), bf_hi(e1.z), bf_lo(e1.w), bf_hi(e1.w)}; }
#pragma unroll 8
            for (int i = 0; i < 16; ++i) {
                const size_t r = r0 + i;
                const u32x4 bw = *(const u32x4*)(BE + be_off(r, 8 * cg)), ew = *(const u32x4*)(BE + be_off(r, 1024 + 8 * cg));
                const f32x4 ea = {bf_lo(ew.x), bf_hi(ew.x), bf_lo(ew.y), bf_hi(ew.y)}, eb = {bf_lo(ew.z), bf_hi(ew.z), bf_lo(ew.w), bf_hi(ew.w)};
                const f32x4 ba = {bf_lo(bw.x), bf_hi(bw.x), bf_lo(bw.y), bf_hi(bw.y)}, bb = {bf_lo(bw.z), bf_hi(bw.z), bf_lo(bw.w), bf_hi(bw.w)};
                const f32x4 ya = w0a * p2a + w1a * p1a + w2a * ea, yb = w0b * p2b + w1b * p1b + w2b * eb;
                *(u32x4*)(S0 + r * DM + 8 * cg) = pk8(ba * ya, bb * yb);
                p2a = p1a; p2b = p1b; p1a = ea; p1b = eb;
            }
        }
        for (int b = (G >= 8) ? vcu - (G - 8) : vcu; b >= 0 && b < 8; b += G) {
            const size_t r0 = (size_t)MPR + 16 * b + 4 * seg;
            f32x4 p2a, p2b, p1a, p1b;
            if (seg == 0) { const float* sp = state_conv + (size_t)b * 2 * DM + 8 * cg;
                p2a = *(const f32x4*)sp; p2b = *(const f32x4*)(sp + 4); p1a = *(const f32x4*)(sp + DM); p1b = *(const f32x4*)(sp + DM + 4); }
            else { const u32x4 e2 = *(const u32x4*)(BE + (r0 - 2) * 2048 + 1024 + 8 * cg), e1 = *(const u32x4*)(BE + (r0 - 1) * 2048 + 1024 + 8 * cg);
                p2a = (f32x4){bf_lo(e2.x), bf_hi(e2.x), bf_lo(e2.y), bf_hi(e2.y)}; p2b = (f32x4){bf_lo(e2.z), bf_hi(e2.z), bf_lo(e2.w), bf_hi(e2.w)};
                p1a = (f32x4){bf_lo(e1.x), bf_hi(e1.x), bf_lo(e1.y), bf_hi(e1.y)}; p1b = (f32x4){bf_lo(e1.z), bf_hi(e1.z), bf_lo(e1.w), bf_hi(e1.w)}; }
#pragma unroll
            for (int i = 0; i < 4; ++i) {
                const size_t r = r0 + i;
                const u32x4 bw = *(const u32x4*)(BE + r * 2048 + 8 * cg), ew = *(const u32x4*)(BE + r * 2048 + 1024 + 8 * cg);
                const f32x4 ea = {bf_lo(ew.x), bf_hi(ew.x), bf_lo(ew.y), bf_hi(ew.y)}, eb = {bf_lo(ew.z), bf_hi(ew.z), bf_lo(ew.w), bf_hi(ew.w)};
                const f32x4 ba = {bf_lo(bw.x), bf_hi(bw.x), bf_lo(bw.y), bf_hi(bw.y)}, bb = {bf_lo(bw.z), bf_hi(bw.z), bf_lo(bw.w), bf_hi(bw.w)};
                const f32x4 ya = w0a * p2a + w1a * p1a + w2a * ea, yb = w0b * p2b + w1b * p1b + w2b * eb;
                *(u32x4*)(S0 + r * DM + 8 * cg) = pk8(ba * ya, bb * yb);
                p2a = p1a; p2b = p1b; p1a = ea; p1b = eb;
            }
        }
    }
    SEAM(7);
    }
    REP(8) {
    if (IN(8)) {
        PH_TID(); KP(kp); unsigned char* ws = kp->ws; float* out = kp->out; bf16* S0 = (bf16*)(ws + WS_S0); bf16* S1 = (bf16*)(ws + WS_S1); bf16* WCOUT = (bf16*)(ws + WS_WCOUT); float* SS = (float*)(ws + WS_SS); float* XP = out + O_YP; float* XS = out + O_YS;
        pg8::MapHead<DM> mp{(const char*)S0, (const char*)WCOUT}; pg8::StaticOrder S; S.init(NTILE, DM / 256, G, bx);
        { BRowPlain br{WCOUT, DM, 2}; SEpiResid<1, 2> SE{nullptr, S1, SS + (size_t)MT * 16, nullptr}; sample_gemm<DM, 2, 8>(lds + RING_OFF, S0 + (size_t)MPR * DM, 32, vcu, G, br, SE, lane, wave); }
        pg8::EpiResid<1> E{nullptr, S1, SS, nullptr};
        pg8::gemm_phase<DM, pg8::EpiResid<1>, pg8::MapHead<DM>>(lds + RING_OFF, mp, S, E);
    }
    SEAM(8);
    }
    REP(9) {
    if (IN(9)) {
        PH_TID(); KP(kp); unsigned char* ws = kp->ws; bf16* S1 = (bf16*)(ws + WS_S1); bf16* W1 = (bf16*)(kp->out + O_YP); bf16* H = (bf16*)(ws + WS_H); float* SS = (float*)(ws + WS_SS);
        { BRowPlain br{W1, DM, 4}; SEpiUp SE{H, SS + (size_t)MT * 16}; sample_gemm<DM, 4, 4>(lds + RING_OFF, S1 + (size_t)MPR * DM, 64, vcu, G, br, SE, lane, wave); }
        pg8::MapHeadAT<DM> mp{(const char*)S1, (const char*)W1}; pg8::StaticOrder S; S.init(NTILE, DFF / 256, G, bx);
        build_row_scales(lds, S, SS);
        pg8::EpiUp E{H, (const LAS float*)(lds + RVT_OFF), SS};
        pg8::gemm_phase<DM, pg8::EpiUp, pg8::MapHeadAT<DM>>(lds + RING_OFF, mp, S, E);
    }
    SEAM(9);
    }
    if (IN(10)) {
        PH_TID(); KP(kp); unsigned char* ws = kp->ws; float* out = kp->out; bf16* S1 = (bf16*)(ws + WS_S1); bf16* W2 = (bf16*)(ws + WS_W2B); bf16* H = (bf16*)(ws + WS_H); float* XP = out + O_YP; float* XS = out + O_YS;
        pg8::MapHeadAT<DFF> mp{(const char*)H, (const char*)W2}; pg8::StaticOrder S; S.init(NTILE, DM / 256, G, bx);
        { BRowPlain br{W2, DFF, 2}; SEpiResid<2, 2> SE{nullptr, S1, nullptr, XS}; sample_gemm<DFF, 2, 8>(lds + RING_OFF, H + (size_t)MPR * DFF, 32, vcu, G, br, SE, lane, wave); }
        pg8::EpiResid<2> E{nullptr, S1, nullptr, XP};
        pg8::gemm_phase<DFF, pg8::EpiResid<2>, pg8::MapHeadAT<DFF>>(lds + RING_OFF, mp, S, E);
    }
#undef IN
#undef SEAM
#undef KP
#undef WSP
}

extern "C" void kernel_launch(void* const* d_in, const int* in_sizes, int n_in, void* d_out, int out_size, void* d_ws, size_t ws_size, hipStream_t stream) {
    static int grid = 0;
    if (grid == 0) {
        if (n_in != 21 || in_sizes[0] != MPR * DM || (size_t)out_size != O_END || ws_size < WS_END) {
            fprintf(stderr, "kernel_launch: unexpected problem: n_in %d in0 %d out %d ws %zu (need %zu); nothing launched\n", n_in, n_in > 0 ? in_sizes[0] : -1, out_size, ws_size, (size_t)WS_END); grid = -1; return; }
        int dev = 0, cus = 0, per_cu = 0;
        if (hipGetDevice(&dev) != hipSuccess || hipDeviceGetAttribute(&cus, hipDeviceAttributeMultiprocessorCount, dev) != hipSuccess) { fprintf(stderr, "kernel_launch: device query failed\n"); grid = -1; return; }
        if (hipFuncSetAttribute((const void*)trunk_fwd, hipFuncAttributeMaxDynamicSharedMemorySize, LDS_BYTES) != hipSuccess) { fprintf(stderr, "kernel_launch: hipFuncSetAttribute failed\n"); grid = -1; return; }
        if (hipOccupancyMaxActiveBlocksPerMultiprocessor(&per_cu, (const void*)trunk_fwd, 512, LDS_BYTES) != hipSuccess || per_cu < 1) {
            fprintf(stderr, "kernel_launch: occupancy query reports %d workgroups per CU; nothing launched\n", per_cu); (void)hipGetLastError(); grid = -1; return; }
        grid = cus;
    }
    if (grid < 0) return;
    if (hipMemsetAsync((char*)d_ws + WS_CTL, 0, CTL_ZERO_BYTES, stream) != hipSuccess) { fprintf(stderr, "kernel_launch: memset failed\n"); return; }
    Args a{};
    for (int i = 0; i < 21; ++i) a.in[i] = (const float*)d_in[i];
    a.out = (float*)d_out; a.ws = (unsigned char*)d_ws;
    for (int li = 0; li < N_LAUNCHES; ++li) {
        a.ph_lo = (N_LAUNCHES == 1) ? 0 : li; a.ph_hi = (N_LAUNCHES == 1) ? NPH : li + 1;
        hipLaunchKernelGGL(trunk_fwd, dim3(grid), dim3(512), LDS_BYTES, stream, a);
        const hipError_t le = hipPeekAtLastError();
        if (le != hipSuccess) { fprintf(stderr, "kernel_launch: launch %d failed: %s\n", li, hipGetErrorName(le)); break; }
    }
}
```

```cpp
#include <hip/hip_runtime.h>
#include <cstdio>
#include <cstdint>

#define LAS __attribute__((address_space(3)))
#define GAS __attribute__((address_space(1)))
typedef unsigned short bf16;
typedef short bf16x8 __attribute__((ext_vector_type(8)));
typedef short s16x4 __attribute__((ext_vector_type(4)));
typedef float f32x2 __attribute__((ext_vector_type(2)));
typedef float f32x4 __attribute__((ext_vector_type(4)));
typedef float f32x16 __attribute__((ext_vector_type(16)));
typedef unsigned u32x2 __attribute__((ext_vector_type(2)));
typedef unsigned u32x4 __attribute__((ext_vector_type(4)));
typedef __bf16 bf16x2_t __attribute__((ext_vector_type(2)));

#ifndef MK_N_LAUNCHES
#define MK_N_LAUNCHES 1
#endif
constexpr int NPH = 11;
constexpr int N_LAUNCHES = MK_N_LAUNCHES;
static_assert(N_LAUNCHES == 1 || N_LAUNCHES == NPH, "MK_N_LAUNCHES is 1 or 11");

constexpr int DM = 1024, SEQ = 16384, NBATCH = 2, MPR = NBATCH * SEQ, MSR = 128, MT = MPR + MSR, NTILE = 128;
constexpr int EVIN = 1280, DFF = 4096, CIN = 3072;
constexpr float EPS = 1e-6f, LOG2E = 1.4426950408889634f, QSCALE = 0.125f * 1.4426950408889634f;
constexpr size_t O_YP = 0, O_YS = 33554432, O_KP = 33685504, O_VP = 33718272, O_PP = 33751040, O_CP = 33766400, O_KS = 33770496, O_VS = 33901568, O_PS = 34032640, O_CS = 34094080, O_END = 34110464;
constexpr size_t KiB = 1024, MiB = 1024 * 1024;
constexpr size_t WS_CTL = 0, CTL_ZERO_BYTES = 256 * KiB;
constexpr size_t WS_RINV0 = 256 * KiB;
constexpr size_t WS_SS = 512 * KiB;
constexpr size_t WS_POOLW = 2816 * KiB;
constexpr size_t WS_WIN = 3 * MiB;
constexpr size_t WS_WOUT = WS_WIN + 2560 * KiB;
constexpr size_t WS_W1 = WS_WOUT + 2 * MiB;
constexpr size_t WS_W2 = WS_W1 + 8 * MiB;
constexpr size_t WS_WCIN = WS_W2 + 8 * MiB;
constexpr size_t WS_WCOUT = WS_WCIN + 6 * MiB;
constexpr size_t WS_S0 = 32 * MiB;
constexpr size_t WS_S1 = WS_S0 + 65 * MiB;
constexpr size_t WS_QKVU = WS_S1 + 65 * MiB;
constexpr size_t WS_H = WS_QKVU + 81 * MiB;
constexpr size_t WS_W2B = WS_H + 257 * MiB;
constexpr size_t WS_END = WS_W2B + 8 * MiB;
static_assert(WS_WCOUT + 2 * MiB <= WS_S0 && (size_t)MT * 2048 <= 65 * MiB && (size_t)MT * 2560 <= 81 * MiB && (size_t)MT * 8192 <= 257 * MiB && WS_END <= 512 * MiB, "ws map");
static_assert(WS_SS + (size_t)MT * 64 + 128 * 32 * 4 <= WS_POOLW, "ws map ss (+ the sample rows' 32-slot table behind it)");
constexpr int CW_BAR = 4096;

__device__ __forceinline__ unsigned pk2(float lo, float hi) { f32x2 v = {lo, hi}; bf16x2_t b = __builtin_convertvector(v, bf16x2_t); return __builtin_bit_cast(unsigned, b); }
__device__ __forceinline__ u32x4 pk8(f32x4 a, f32x4 b) { u32x4 w; w.x = pk2(a[0], a[1]); w.y = pk2(a[2], a[3]); w.z = pk2(b[0], b[1]); w.w = pk2(b[2], b[3]); return w; }
__device__ __forceinline__ float bf_lo(unsigned w) { return __uint_as_float(w << 16); }
__device__ __forceinline__ float bf_hi(unsigned w) { return __uint_as_float(w & 0xffff0000u); }
__device__ __forceinline__ float sq4(f32x4 v) { return (v[0] * v[0] + v[1] * v[1]) + (v[2] * v[2] + v[3] * v[3]); }
__device__ __forceinline__ float wave_sum(float v) {
#pragma unroll
    for (int o = 1; o < 64; o <<= 1) v += __shfl_xor(v, o);
    return v;
}
__device__ __forceinline__ size_t be_off(size_t r, int c) { return (r >> 8) * (size_t)(256 * 2048) + (size_t)(c >> 5) * 8192 + (r & 255) * 32 + (c & 31); }
#define LDS_WAIT() asm volatile("s_waitcnt lgkmcnt(0)" ::: "memory")
#define VM_WAIT() asm volatile("s_waitcnt vmcnt(0)" ::: "memory")

namespace pg8 {
constexpr int RVT_UNITS_ = 12;
constexpr int BM = 256, BK = 64, HALF = 128, HTB = HALF * BK * 2, STAGE_BYTES = 8 * HTB, NXCD = 8, WGM = 8;
__host__ __device__ __forceinline__ int lds_byte(int r, int c) { const int st = (r >> 4) * 2 + (c >> 5), rr = r & 15, cc = c & 31, ob = rr * 64 + cc * 2; return st * 1024 + (ob ^ (((ob >> 9) & 1) << 5)); }
__host__ __device__ __forceinline__ void stage_rc(int b, int& R, int& C) { const int st = b / 1024, sb = b % 1024, swz = sb ^ (((sb >> 9) & 1) << 5); R = (st >> 1) * 16 + swz / 64; C = (st & 1) * 32 + (swz % 64) / 2; }
__host__ __device__ __forceinline__ int perm32(int rho) { const int n = rho >> 4, i = rho & 15; return 8 * (i >> 2) + 4 * n + (i & 3); }
struct Unit { int pm, pn, idx; };
struct StaticOrder {
    int nM, nN, nwg, G, c;
    __device__ void init(int nM_, int nN_, int G_, int c_) { nM = nM_; nN = nN_; nwg = nM * nN; G = G_; c = c_; }
    __device__ bool next(int i, Unit& u) const {
        const long L = (long)i * G + c; if (L >= nwg) return false;
        int wgid = (int)L; { const int q = nwg / NXCD, r = nwg % NXCD, xcd = wgid % NXCD, off = wgid / NXCD; wgid = (xcd < r ? xcd * (q + 1) : r * (q + 1) + (xcd - r) * q) + off; }
        const int nig = WGM * nN, gid = wgid / nig, fm = gid * WGM, gsz = (nM - fm) < WGM ? (nM - fm) : WGM;
        u.pm = fm + ((wgid % nig) % gsz); u.pn = (wgid % nig) / gsz; return true;
    }
};
template <int K> struct MapPlain {
    static constexpr int BMODE = 0; static constexpr bool ATILE = false;
    const char* A; const char* Bt;
    __device__ __forceinline__ void ptrs(const Unit& u, const char*& a, size_t& aH, const char*& b, size_t& bH) const {
        a = A + (size_t)u.pm * 256 * K * 2; aH = (size_t)128 * K * 2;
        b = Bt + (size_t)u.pn * 256 * K * 2; bH = (size_t)128 * K * 2; }
};
template <int K> struct MapHead {
    static constexpr int BMODE = 1; static constexpr bool ATILE = false;
    const char* A; const char* Bt;
    __device__ __forceinline__ void ptrs(const Unit& u, const char*& a, size_t& aH, const char*& b, size_t& bH) const {
        a = A + (size_t)u.pm * 256 * K * 2; aH = (size_t)128 * K * 2;
        b = Bt + (size_t)u.pn * 256 * K * 2; bH = (size_t)32 * K * 2; }
};
template <int K> struct MapHeadAT {
    static constexpr int BMODE = 1; static constexpr bool ATILE = true;
    const char* A; const char* Bt;
    __device__ __forceinline__ void ptrs(const Unit& u, const char*& a, size_t& aH, const char*& b, size_t& bH) const {
        a = A + (size_t)u.pm * 256 * K * 2; aH = (size_t)128 * 32 * 2;
        b = Bt + (size_t)u.pn * 256 * K * 2; bH = (size_t)32 * K * 2; }
};
template <int K> struct MapConvIn {
    static constexpr int BMODE = 0; static constexpr bool ATILE = false;
    const char* A; const char* Bt;
    __device__ __forceinline__ void ptrs(const Unit& u, const char*& a, size_t& aH, const char*& b, size_t& bH) const {
        a = A + (size_t)u.pm * 256 * K * 2; aH = (size_t)128 * K * 2;
        if (u.pn < 4) { b = Bt + (size_t)u.pn * 256 * K * 2; bH = (size_t)128 * K * 2; }
        else { b = Bt + (size_t)(1024 + 128 * (u.pn - 4)) * K * 2; bH = (size_t)1024 * K * 2; } }
};

template <int K, class Epi, class Map>
__device__ __forceinline__ void gemm_phase(LAS unsigned char* lds, const Map& MPp, const StaticOrder& S, const Epi& E) {
    int tid = threadIdx.x; asm volatile("" : "+v"(tid));
    const int wid = __builtin_amdgcn_readfirstlane(tid >> 6), lane = tid & 63, wr = wid >> 2, wc = wid & 3, fr = lane & 15, fq = lane >> 4;
    constexpr int nt = K / BK;
    unsigned voffA[2], voffB[2];
#pragma unroll
    for (int i = 0; i < 2; ++i) { int R, C; stage_rc(tid * 16 + i * 8192, R, C);
        const int Rb = (Map::BMODE == 1) ? (64 * (R >> 5) + perm32(R & 31)) : ((R & ~31) + perm32(R & 31));
        voffA[i] = Map::ATILE ? (unsigned)((C >> 5) * 8192 + R * 32 + (C & 31)) * 2u : (unsigned)(R * K + C) * 2u; voffB[i] = (unsigned)(Rb * K + C) * 2u; }
    const size_t kstep = (size_t)(BK * 2), kstepA = Map::ATILE ? (size_t)(256 * 64 * 2) : (size_t)(BK * 2);
    const unsigned ldsw = (unsigned)wid * 1024u;
    const int aoff = lds_byte(wr * 64 + fr, fq * 8), boff = lds_byte(wc * 32 + fr, fq * 8);
#define PG8_SA(b, h) (((b) * 2 + (h)) * HTB)
#define PG8_SB(b, h) ((4 + (b) * 2 + (h)) * HTB)
#define PG8_STAGE(bufoff, gbase, voff) do { _Pragma("unroll") for (int _i = 0; _i < 2; ++_i) \
        __builtin_amdgcn_global_load_lds((const unsigned*)((const char*)(gbase) + (voff)[_i]), (LAS unsigned*)(lds + (bufoff) + ldsw + _i * 8192), 16, 0, 0); } while (0)
#define PG8_LDA(dst, b, h) do { _Pragma("unroll") for (int m = 0; m < 4; ++m) _Pragma("unroll") for (int k = 0; k < 2; ++k) dst[m][k] = *(const LAS bf16x8*)(lds + PG8_SA(b, h) + aoff + m * 2048 + k * 1024); } while (0)
#define PG8_LDB(dst, b, h) do { _Pragma("unroll") for (int n = 0; n < 2; ++n) _Pragma("unroll") for (int k = 0; k < 2; ++k) dst[n][k] = *(const LAS bf16x8*)(lds + PG8_SB(b, h) + boff + n * 2048 + k * 1024); } while (0)
#define PG8_MMA(ai, bj, At, Bt) do { __builtin_amdgcn_s_setprio(1); _Pragma("unroll") for (int m = 0; m < 4; ++m) _Pragma("unroll") for (int n = 0; n < 2; ++n) _Pragma("unroll") for (int k = 0; k < 2; ++k) \
        acc[ai][bj][m][n] = __builtin_amdgcn_mfma_f32_16x16x32_bf16(Bt[n][k], At[m][k], acc[ai][bj][m][n], 0, 0, 0); __builtin_amdgcn_s_setprio(0); } while (0)
#define PG8_WAIT_V(n) asm volatile("s_waitcnt vmcnt(" #n ")" ::: "memory")
#define PG8_WAIT_L(n) asm volatile("s_waitcnt lgkmcnt(" #n ")" ::: "memory")
#define PG8_BAR __builtin_amdgcn_s_barrier()
#define PG8_SCHED __builtin_amdgcn_sched_barrier(0)
    Unit cur, nxt; int ui = 0; cur.idx = 0;
    if (!S.next(0, cur)) return;
    f32x4 acc[2][2][4][2];
#pragma unroll
    for (int a = 0; a < 2; ++a)
#pragma unroll
        for (int b = 0; b < 2; ++b)
#pragma unroll
            for (int m = 0; m < 4; ++m)
#pragma unroll
                for (int n = 0; n < 2; ++n) acc[a][b][m][n] = (f32x4){0.f, 0.f, 0.f, 0.f};
    bf16x8 At[4][2], B0[2][2], B1[2][2];
    const char* cA; const char* cB; size_t cAH, cBH;
    MPp.ptrs(cur, cA, cAH, cB, cBH);
    PG8_STAGE(PG8_SB(0, 0), cB, voffB); PG8_STAGE(PG8_SB(0, 1), cB + cBH, voffB); PG8_STAGE(PG8_SA(0, 0), cA, voffA); PG8_STAGE(PG8_SA(0, 1), cA + cAH, voffA);
    if (wr == 1) PG8_BAR;
    PG8_WAIT_V(2); PG8_BAR;
    PG8_STAGE(PG8_SB(1, 0), cB + kstep, voffB); PG8_STAGE(PG8_SA(1, 0), cA + kstepA, voffA); PG8_STAGE(PG8_SB(1, 1), cB + cBH + kstep, voffB);
    PG8_WAIT_V(6); PG8_BAR;
    for (;;) {
        const bool has_next = S.next(ui + 1, nxt); nxt.idx = ui + 1;
        const char* nA = cA; const char* nB = cB; size_t nAH = cAH, nBH = cBH;
        if (has_next) MPp.ptrs(nxt, nA, nAH, nB, nBH);
        for (int t = 0; t < nt; t += 2) {
            const bool last = (t == nt - 2);
            const char* a1 = cA + (size_t)(t + 1) * kstepA;
            const char* a2 = last ? nA : cA + (size_t)(t + 2) * kstepA; const char* b2 = last ? nB : cB + (size_t)(t + 2) * kstep;
            const size_t a2H = last ? nAH : cAH, b2H = last ? nBH : cBH;
            const char* a3 = a2 + kstepA; const char* b3 = b2 + kstep;
            PG8_LDB(B0, 0, 0); PG8_LDB(B1, 0, 1); PG8_SCHED; PG8_LDA(At, 0, 0); PG8_STAGE(PG8_SA(1, 1), a1 + cAH, voffA);
            PG8_WAIT_V(8); PG8_WAIT_L(0); PG8_BAR; PG8_MMA(0, 0, At, B0); PG8_MMA(0, 1, At, B1); PG8_BAR; PG8_SCHED;
            PG8_LDA(At, 0, 1); PG8_STAGE(PG8_SB(0, 0), b2, voffB); PG8_STAGE(PG8_SB(0, 1), b2 + b2H, voffB); PG8_STAGE(PG8_SA(0, 0), a2, voffA);
            PG8_WAIT_V(8); PG8_WAIT_L(0); PG8_BAR; PG8_MMA(1, 0, At, B0); PG8_MMA(1, 1, At, B1); PG8_BAR; PG8_SCHED;
            PG8_LDB(B0, 1, 0); PG8_LDB(B1, 1, 1); PG8_SCHED; PG8_LDA(At, 1, 0); PG8_STAGE(PG8_SA(0, 1), a2 + a2H, voffA);
            PG8_WAIT_V(8); PG8_WAIT_L(0); PG8_BAR; PG8_MMA(0, 0, At, B0); PG8_MMA(0, 1, At, B1); PG8_BAR; PG8_SCHED;
            PG8_LDA(At, 1, 1); PG8_STAGE(PG8_SB(1, 0), b3, voffB); PG8_STAGE(PG8_SB(1, 1), b3 + b2H, voffB); PG8_STAGE(PG8_SA(1, 0), a3, voffA);
            PG8_WAIT_V(8); PG8_WAIT_L(0); PG8_BAR; PG8_MMA(1, 0, At, B0); PG8_MMA(1, 1, At, B1); PG8_BAR; PG8_SCHED;
        }
        if (wr == 0) PG8_BAR;
        E(acc, cur, wr, wc, fr, fq);
        if (!has_next) break;
#pragma unroll
        for (int a = 0; a < 2; ++a)
#pragma unroll
            for (int b = 0; b < 2; ++b)
#pragma unroll
                for (int m = 0; m < 4; ++m)
#pragma unroll
                    for (int n = 0; n < 2; ++n) acc[a][b][m][n] = (f32x4){0.f, 0.f, 0.f, 0.f};
        cur = nxt; cA = nA; cB = nB; cAH = nAH; cBH = nBH; ++ui;
        if (wr == 1) PG8_BAR;
    }
    PG8_WAIT_V(0);
    PG8_BAR;
#undef PG8_SA
#undef PG8_SB
#undef PG8_STAGE
#undef PG8_LDA
#undef PG8_LDB
#undef PG8_MMA
#undef PG8_WAIT_V
#undef PG8_WAIT_L
#undef PG8_BAR
#undef PG8_SCHED
}

typedef const f32x4 (&AccRef)[2][2][4][2];
struct EpiInProj {
    bf16* QKVU; const float* rinv0; const float* qn; const float* kn; float* out;
    __device__ __forceinline__ void operator()(AccRef acc, const Unit& u, int wr, int wc, int fr, int fq) const {
        asm volatile("" : "+v"(fr), "+v"(fq));
        const int pn = u.pn;
        const int cb = 256 * pn + 64 * wc;
        const int kind = pn < 2 ? 0 : (pn == 2 ? (wc < 2 ? 1 : 2) : 3);
        const int g = wc & 1;
        f32x4 gv[2][2];
#pragma unroll
        for (int bj = 0; bj < 2; ++bj)
#pragma unroll
            for (int n = 0; n < 2; ++n) gv[bj][n] = (f32x4){1.f, 1.f, 1.f, 1.f};
        if (kind <= 1) { const float* gp = kind == 0 ? qn : kn; const float sc = kind == 0 ? QSCALE : 1.f;
#pragma unroll
            for (int bj = 0; bj < 2; ++bj)
#pragma unroll
                for (int n = 0; n < 2; ++n) gv[bj][n] = *(const f32x4*)(gp + 32 * bj + 8 * fq + 4 * n) * sc; }
        float rvs[2][4];
#pragma unroll
        for (int ai = 0; ai < 2; ++ai)
#pragma unroll
            for (int m = 0; m < 4; ++m) rvs[ai][m] = rinv0[256 * u.pm + 128 * ai + 64 * wr + 16 * m + fr];
#pragma unroll
        for (int ai = 0; ai < 2; ++ai) {
#pragma unroll
            for (int m = 0; m < 4; ++m) {
                const int rt = 128 * ai + 64 * wr + 16 * m + fr; const int r = 256 * u.pm + rt;
                const float rv = rvs[ai][m];
                f32x4 v[2][2];
#pragma unroll
                for (int bj = 0; bj < 2; ++bj)
#pragma unroll
                    for (int n = 0; n < 2; ++n) v[bj][n] = acc[ai][bj][m][n] * rv;
                if (kind <= 1) {
                    float ss = (sq4(v[0][0]) + sq4(v[0][1])) + (sq4(v[1][0]) + sq4(v[1][1]));
                    ss += __shfl_xor(ss, 16); ss += __shfl_xor(ss, 32);
                    const float rn = rsqrtf(ss * (1.0f / 64.0f) + EPS);
#pragma unroll
                    for (int bj = 0; bj < 2; ++bj)
#pragma unroll
                        for (int n = 0; n < 2; ++n) v[bj][n] = v[bj][n] * rn * gv[bj][n];
                }
                bf16* rowp = QKVU + (size_t)r * EVIN + cb + 8 * fq;
#pragma unroll
                for (int bj = 0; bj < 2; ++bj) *(u32x4*)(rowp + 32 * bj) = pk8(v[bj][0], v[bj][1]);
                if (kind == 1 || kind == 2) {
                    float* dst = nullptr;
                    if (ai == 1 && (u.pm & 63) == 63) { const int bb = u.pm >> 6, j = rt - 128; dst = out + (kind == 1 ? O_KP : O_VP) + ((size_t)(bb * 128 + j) * 2 + g) * 64; }
                    if (dst) {
#pragma unroll
                        for (int bj = 0; bj < 2; ++bj)
#pragma unroll
                            for (int n = 0; n < 2; ++n) *(f32x4*)(dst + 32 * bj + 8 * fq + 4 * n) = v[bj][n]; }
                } else if (kind == 3) {
                    const int ucol = 256 * (pn - 3) + 64 * wc + 8 * fq;
                    float* dst = nullptr;
                    if (ai == 1 && (u.pm & 63) == 63 && rt >= 241) { const int bb = u.pm >> 6; dst = out + O_PP + (size_t)(bb * 15 + rt - 241) * 512 + ucol; }
                    if (dst) {
#pragma unroll
                        for (int bj = 0; bj < 2; ++bj)
#pragma unroll
                            for (int n = 0; n < 2; ++n) *(f32x4*)(dst + 32 * bj + 4 * n) = v[bj][n]; }
                }
            }
        }
    }
};
__device__ __forceinline__ f32x4 bf4_lo(u32x4 w) { return (f32x4){bf_lo(w.x), bf_hi(w.x), bf_lo(w.y), bf_hi(w.y)}; }
__device__ __forceinline__ f32x4 bf4_hi(u32x4 w) { return (f32x4){bf_lo(w.z), bf_hi(w.z), bf_lo(w.w), bf_hi(w.w)}; }
template <int MODE> struct EpiResid {
    const float* xin_f; bf16* XR; float* SS; float* yout;
    __device__ __forceinline__ void operator()(AccRef acc, const Unit& u, int wr, int wc, int fr, int fq) const {
        asm volatile("" : "+v"(fr), "+v"(fq));
        const int c0 = 256 * u.pn + 64 * wc + 8 * fq;
        const size_t rbase = (size_t)256 * u.pm + 64 * wr + fr;
        if (MODE == 0) {
#pragma unroll
            for (int ai = 0; ai < 2; ++ai) {
                f32x4 xr[4][2][2];
#pragma unroll
                for (int m = 0; m < 4; ++m)
#pragma unroll
                    for (int bj = 0; bj < 2; ++bj) { const float* p = xin_f + (rbase + 128 * ai + 16 * m) * DM + c0 + 32 * bj; xr[m][bj][0] = *(const f32x4*)p; xr[m][bj][1] = *(const f32x4*)(p + 4); }
#pragma unroll
                for (int m = 0; m < 4; ++m) { const size_t r = rbase + 128 * ai + 16 * m; float ss = 0.f;
#pragma unroll
                    for (int bj = 0; bj < 2; ++bj) { const f32x4 v0 = acc[ai][bj][m][0] + xr[m][bj][0], v1 = acc[ai][bj][m][1] + xr[m][bj][1]; ss += sq4(v0) + sq4(v1);
                        *(u32x4*)(XR + r * DM + c0 + 32 * bj) = pk8(v0, v1); }
                    ss += __shfl_xor(ss, 16); ss += __shfl_xor(ss, 32); if (fq == 0) SS[r * 16 + 4 * u.pn + wc] = ss; }
            }
        } else {
            u32x4 xr[2][4][2];
#pragma unroll
            for (int ai = 0; ai < 2; ++ai)
#pragma unroll
                for (int m = 0; m < 4; ++m)
#pragma unroll
                    for (int bj = 0; bj < 2; ++bj) xr[ai][m][bj] = *(const u32x4*)(XR + (rbase + 128 * ai + 16 * m) * DM + c0 + 32 * bj);
#pragma unroll
            for (int ai = 0; ai < 2; ++ai)
#pragma unroll
                for (int m = 0; m < 4; ++m) { const size_t r = rbase + 128 * ai + 16 * m; float ss = 0.f;
#pragma unroll
                    for (int bj = 0; bj < 2; ++bj) { const f32x4 v0 = acc[ai][bj][m][0] + bf4_lo(xr[ai][m][bj]), v1 = acc[ai][bj][m][1] + bf4_hi(xr[ai][m][bj]);
                        if (MODE == 1) { ss += sq4(v0) + sq4(v1); *(u32x4*)(XR + r * DM + c0 + 32 * bj) = pk8(v0, v1); }
                        else { float* yp = yout + r * DM + c0 + 32 * bj; *(f32x4*)yp = v0; *(f32x4*)(yp + 4) = v1; } }
                    if (MODE == 1) { ss += __shfl_xor(ss, 16); ss += __shfl_xor(ss, 32); if (fq == 0) SS[r * 16 + 4 * u.pn + wc] = ss; } }
        }
    }
};
__device__ __forceinline__ float row_rinv(const float* SS, size_t r, int fq) {
    const f32x4 s4 = *(const f32x4*)(SS + r * 16 + 4 * fq); float s = (s4[0] + s4[1]) + (s4[2] + s4[3]);
    s += __shfl_xor(s, 16); s += __shfl_xor(s, 32);
    return rsqrtf(s * (1.0f / 1024.0f) + EPS);
}
__device__ __forceinline__ void rows_rinv(const float* SS, size_t rbase, int fq, float (&rv)[2][4]) {
    f32x4 s4[2][4];
#pragma unroll
    for (int ai = 0; ai < 2; ++ai)
#pragma unroll
        for (int m = 0; m < 4; ++m) s4[ai][m] = *(const f32x4*)(SS + (rbase + 128 * ai + 16 * m) * 16 + 4 * fq);
#pragma unroll
    for (int ai = 0; ai < 2; ++ai)
#pragma unroll
        for (int m = 0; m < 4; ++m) { float t = (s4[ai][m][0] + s4[ai][m][1]) + (s4[ai][m][2] + s4[ai][m][3]); t += __shfl_xor(t, 16); t += __shfl_xor(t, 32); rv[ai][m] = rsqrtf(t * (1.0f / 1024.0f) + EPS); }
}
struct EpiUp {
    bf16* H; const LAS float* rvt; const float* SS;
    __device__ __forceinline__ void operator()(AccRef acc, const Unit& u, int wr, int wc, int fr, int fq) const {
        asm volatile("" : "+v"(fr), "+v"(fq));
        const int c0 = 256 * u.pn + 64 * wc + 8 * fq;
        float rvs[2][4];
        if (u.idx < RVT_UNITS_) {
#pragma unroll
            for (int ai = 0; ai < 2; ++ai)
#pragma unroll
                for (int m = 0; m < 4; ++m) rvs[ai][m] = rvt[u.idx * 256 + 128 * ai + 64 * wr + 16 * m + fr];
        } else rows_rinv(SS, (size_t)256 * u.pm + 64 * wr + fr, fq, rvs);
#pragma unroll
        for (int ai = 0; ai < 2; ++ai) {
#pragma unroll
            for (int m = 0; m < 4; ++m) {
                const size_t r = (size_t)256 * u.pm + 128 * ai + 64 * wr + 16 * m + fr;
                const float rv = rvs[ai][m];
#pragma unroll
                for (int bj = 0; bj < 2; ++bj) {
                    f32x4 v0 = acc[ai][bj][m][0] * rv, v1 = acc[ai][bj][m][1] * rv;
#pragma unroll
                    for (int i = 0; i < 4; ++i) { const float a = fmaxf(v0[i], 0.f), b = fmaxf(v1[i], 0.f); v0[i] = a * a; v1[i] = b * b; }
                    __builtin_nontemporal_store(pk8(v0, v1), (u32x4*)(H + (size_t)u.pm * 256 * DFF + (size_t)(8 * u.pn + 2 * wc + bj) * 8192 + (size_t)(128 * ai + 64 * wr + 16 * m + fr) * 32 + 8 * fq));
                }
            }
        }
    }
};
struct EpiConvIn {
    bf16* BE; const LAS float* rvt; const float* SS; float* out;
    __device__ __forceinline__ void operator()(AccRef acc, const Unit& u, int wr, int wc, int fr, int fq) const {
        asm volatile("" : "+v"(fr), "+v"(fq));
        const int pn = u.pn;
        float rvs[2][4];
        if (u.idx < RVT_UNITS_) {
#pragma unroll
            for (int ai = 0; ai < 2; ++ai)
#pragma unroll
                for (int m = 0; m < 4; ++m) rvs[ai][m] = rvt[u.idx * 256 + 128 * ai + 64 * wr + 16 * m + fr];
        } else rows_rinv(SS, (size_t)256 * u.pm + 64 * wr + fr, fq, rvs);
#pragma unroll
        for (int ai = 0; ai < 2; ++ai) {
#pragma unroll
            for (int m = 0; m < 4; ++m) {
                const int rt = 128 * ai + 64 * wr + 16 * m + fr; const size_t r = (size_t)256 * u.pm + rt;
                const float rv = rvs[ai][m];
                if (pn < 4) {
#pragma unroll
                    for (int bj = 0; bj < 2; ++bj) *(u32x4*)(BE + be_off(r, 256 * pn + 128 * bj + 32 * wc + 8 * fq)) = pk8(acc[ai][bj][m][0] * rv, acc[ai][bj][m][1] * rv);
                } else {
                    const int ch0 = 128 * (pn - 4) + 32 * wc + 8 * fq;
                    const f32x4 e0 = (acc[ai][0][m][0] * rv) * (acc[ai][1][m][0] * rv), e1 = (acc[ai][0][m][1] * rv) * (acc[ai][1][m][1] * rv);
                    *(u32x4*)(BE + be_off(r, 1024 + ch0)) = pk8(e0, e1);
                    float* dst = nullptr;
                    if (ai == 1 && (u.pm & 63) == 63 && rt >= 254) { const int bb = u.pm >> 6; dst = out + O_CP + (size_t)(bb * 2 + rt - 254) * 1024 + ch0; }
                    if (dst) { *(f32x4*)dst = e0; *(f32x4*)(dst + 4) = e1; }
                }
            }
        }
    }
};
}


template <int K, int NF, int KS, class BRow, class Epi>
__device__ __forceinline__ void sample_gemm(LAS unsigned char* lds, const bf16* As, const int n_items, const int first, const int stride, const BRow& brow, const Epi& E, int lane, const int wave) {
    asm volatile("" : "+v"(lane));
    const int fr = lane & 15, fq = lane >> 4;
    constexpr int KQ = K / KS, UPI = (KS == 4) ? 4 : 8;
    for (int un = first; un < n_items * UPI; un += stride) {
        const int item = (KS == 4) ? (un >> 2) : (un >> 3), rg = (KS == 4) ? (un & 3) : ((un >> 1) & 3), mf = (KS == 4) ? (wave & 1) : (un & 1), kq = (KS == 4) ? (wave >> 1) : wave, mfs = (KS == 4) ? mf : 0;
        const int row = 32 * rg + 16 * mf + fr;
        const bf16* ap = As + (size_t)row * K + kq * KQ + 8 * fq;
        const bf16* bp[NF];
#pragma unroll
        for (int nf = 0; nf < NF; ++nf) bp[nf] = brow(item, nf) + (size_t)fr * K + kq * KQ + 8 * fq;
        f32x4 acc[NF];
#pragma unroll
        for (int nf = 0; nf < NF; ++nf) acc[nf] = (f32x4){0.f, 0.f, 0.f, 0.f};
        typename Epi::Pre pre = {};
        if (kq == 0) pre = E.pre(item, row, fr, fq);
#pragma unroll 8
        for (int ks = 0; ks < KQ / 32; ++ks) {
            const bf16x8 a = *(const bf16x8*)(ap + 32 * ks);
#pragma unroll
            for (int nf = 0; nf < NF; ++nf) { const bf16x8 b = *(const bf16x8*)(bp[nf] + 32 * ks); acc[nf] = __builtin_amdgcn_mfma_f32_16x16x32_bf16(b, a, acc[nf], 0, 0, 0); }
        }
        LAS f32x4* red = (LAS f32x4*)lds;
        if (kq > 0) {
#pragma unroll
            for (int nf = 0; nf < NF; ++nf) red[(((kq - 1) * 2 + mfs) * 64 + lane) * NF + nf] = acc[nf]; }
        __syncthreads();
        if (kq == 0) {
#pragma unroll
            for (int q = 0; q < KS - 1; ++q)
#pragma unroll
                for (int nf = 0; nf < NF; ++nf) acc[nf] += red[((q * 2 + mfs) * 64 + lane) * NF + nf];
            E(item, row, fr, fq, acc, pre);
        }
        __syncthreads();
    }
}
struct BRowPlain { const bf16* Bt; int K, NF; __device__ __forceinline__ const bf16* operator()(int item, int nf) const { return Bt + (size_t)(item * NF + nf) * 16 * K; } };
struct BRowConvIn { const bf16* Bt; __device__ __forceinline__ const bf16* operator()(int item, int nf) const { return Bt + (size_t)(1024 * nf + 16 * item) * DM; } };
struct SEpiInProj {
    bf16* QKVU; const float* rinv0; const float* qn; const float* kn; float* out;
    struct Pre { float rv; };
    __device__ __forceinline__ Pre pre(int item, int row, int fr, int fq) const { Pre p; p.rv = rinv0[(size_t)MPR + row]; return p; }
    __device__ __forceinline__ void operator()(int item, int row, int fr, int fq, f32x4 (&acc)[4], const Pre& pr) const {
        const int kind = item < 8 ? 0 : (item < 10 ? 1 : (item < 12 ? 2 : 3)), g = item & 1;
        const size_t r = (size_t)MPR + row; const float rv = pr.rv;
        f32x4 v[4];
#pragma unroll
        for (int nf = 0; nf < 4; ++nf) v[nf] = acc[nf] * rv;
        if (kind <= 1) {
            float ss = (sq4(v[0]) + sq4(v[1])) + (sq4(v[2]) + sq4(v[3]));
            ss += __shfl_xor(ss, 16); ss += __shfl_xor(ss, 32);
            const float rn = rsqrtf(ss * (1.0f / 64.0f) + EPS) * (kind == 0 ? QSCALE : 1.f); const float* gp = (kind == 0 ? qn : kn) + 4 * fq;
#pragma unroll
            for (int nf = 0; nf < 4; ++nf) v[nf] = v[nf] * rn * *(const f32x4*)(gp + 16 * nf);
        }
        bf16* rowp = QKVU + r * EVIN + 64 * item + 4 * fq;
#pragma unroll
        for (int nf = 0; nf < 4; ++nf) { u32x2 w; w.x = pk2(v[nf][0], v[nf][1]); w.y = pk2(v[nf][2], v[nf][3]); *(u32x2*)(rowp + 16 * nf) = w; }
        const int b = row >> 4, i16 = row & 15;
        float* dst = nullptr;
        if (kind == 1 || kind == 2) dst = out + (kind == 1 ? O_KS : O_VS) + ((size_t)(b * 128 + 112 + i16) * 2 + g) * 64 + 4 * fq;
        else if (kind == 3 && i16 >= 1) dst = out + O_PS + (size_t)(b * 15 + i16 - 1) * 512 + 64 * (item - 12) + 4 * fq;
        if (dst) {
#pragma unroll
            for (int nf = 0; nf < 4; ++nf) *(f32x4*)(dst + 16 * nf) = v[nf]; }
    }
};
template <int MODE, int NF> struct SEpiResid {
    const float* xin_f; bf16* XR; float* SSS; float* yout;
    struct Pre { u32x2 w[NF]; };
    __device__ __forceinline__ Pre pre(int item, int row, int fr, int fq) const { Pre p;
#pragma unroll
        for (int nf = 0; nf < NF; ++nf) p.w[nf] = *(const u32x2*)(XR + ((size_t)MPR + row) * DM + 16 * NF * item + 4 * fq + 16 * nf);
        return p; }
    __device__ __forceinline__ void operator()(int item, int row, int fr, int fq, f32x4 (&acc)[NF], const Pre& pr) const {
        const size_t r = (size_t)MPR + row; const int c = 16 * NF * item + 4 * fq;
        float ss = 0.f;
#pragma unroll
        for (int nf = 0; nf < NF; ++nf) {
            f32x4 x;
            if (MODE == 0) x = *(const f32x4*)(xin_f + (size_t)row * DM + c + 16 * nf);
            else { const u32x2 w = pr.w[nf]; x[0] = bf_lo(w.x); x[1] = bf_hi(w.x); x[2] = bf_lo(w.y); x[3] = bf_hi(w.y); }
            const f32x4 v = acc[nf] + x;
            if (MODE == 2) *(f32x4*)(yout + (size_t)row * DM + c + 16 * nf) = v;
            else { ss += sq4(v); u32x2 w; w.x = pk2(v[0], v[1]); w.y = pk2(v[2], v[3]); *(u32x2*)(XR + r * DM + c + 16 * nf) = w; }
        }
        if (MODE != 2) { static_assert(MODE == 2 || NF == 2, "32-slot layout"); ss += __shfl_xor(ss, 16); ss += __shfl_xor(ss, 32); if (fq == 0) SSS[row * 32 + item] = ss; }
    }
};
struct SRowPre { f32x4 a, b; };
__device__ __forceinline__ SRowPre srow_pre(const float* SSS, int row, int fq) { SRowPre p; p.a = *(const f32x4*)(SSS + row * 32 + 8 * fq); p.b = *(const f32x4*)(SSS + row * 32 + 8 * fq + 4); return p; }
__device__ __forceinline__ float srow_rinv(const SRowPre& p) {
    float s = ((p.a[0] + p.a[1]) + (p.a[2] + p.a[3])) + ((p.b[0] + p.b[1]) + (p.b[2] + p.b[3]));
    s += __shfl_xor(s, 16); s += __shfl_xor(s, 32);
    return rsqrtf(s * (1.0f / 1024.0f) + EPS);
}
struct SEpiUp {
    bf16* H; const float* SS;
    typedef SRowPre Pre;
    __device__ __forceinline__ Pre pre(int item, int row, int fr, int fq) const { return srow_pre(SS, row, fq); }
    __device__ __forceinline__ void operator()(int item, int row, int fr, int fq, f32x4 (&acc)[4], const Pre& pr) const {
        const size_t r = (size_t)MPR + row; const float rv = srow_rinv(pr);
#pragma unroll
        for (int nf = 0; nf < 4; ++nf) { f32x4 v = acc[nf] * rv;
#pragma unroll
            for (int i = 0; i < 4; ++i) { const float a = fmaxf(v[i], 0.f); v[i] = a * a; }
            u32x2 w; w.x = pk2(v[0], v[1]); w.y = pk2(v[2], v[3]); *(u32x2*)(H + r * DFF + 64 * item + 16 * nf + 4 * fq) = w; }
    }
};
struct SEpiConvIn {
    bf16* BE; const float* SS; float* out;
    typedef SRowPre Pre;
    __device__ __forceinline__ Pre pre(int item, int row, int fr, int fq) const { return srow_pre(SS, row, fq); }
    __device__ __forceinline__ void operator()(int item, int row, int fr, int fq, f32x4 (&acc)[3], const Pre& pr) const {
        const size_t r = (size_t)MPR + row; const float rv = srow_rinv(pr);
        const int ch0 = 16 * item + 4 * fq;
        { const f32x4 v = acc[0] * rv; u32x2 w; w.x = pk2(v[0], v[1]); w.y = pk2(v[2], v[3]); *(u32x2*)(BE + r * 2048 + ch0) = w; }
        const f32x4 e = (acc[1] * rv) * (acc[2] * rv);
        u32x2 w; w.x = pk2(e[0], e[1]); w.y = pk2(e[2], e[3]); *(u32x2*)(BE + r * 2048 + 1024 + ch0) = w;
        const int b = row >> 4, i16 = row & 15;
        if (i16 >= 14) *(f32x4*)(out + O_CS + (size_t)(b * 2 + i16 - 14) * 1024 + ch0) = e;
    }
};

#define XB_TMO      128
#define XB_XCNT(j)  (256  + 64 * (j))
#define XB_XSUB(j)  (1280 + 64 * (j))
#define XB_XGEN(j)  (2304 + 64 * (j))
#define XB_TOP      3328
#define XB_TOPGEN   3392
#define XCD_BAR_WORDS 3456
#define XB_SPIN_CAP (1u << 18)
__device__ __forceinline__ unsigned xb_ld(unsigned* p)              { return __hip_atomic_load(p, __ATOMIC_RELAXED, __HIP_MEMORY_SCOPE_AGENT); }
__device__ __forceinline__ unsigned xb_add(unsigned* p, unsigned v) { return __hip_atomic_fetch_add(p, v, __ATOMIC_RELAXED, __HIP_MEMORY_SCOPE_AGENT); }
__device__ __forceinline__ unsigned xb_xcc_id() { return (unsigned)__builtin_amdgcn_s_getreg((3 << 11) | 20) & 0xFu; }
#define XB_SPIN(cond, bar) do { unsigned _sp = 0; while (cond) { __builtin_amdgcn_s_sleep(1); \
    if ((++_sp & 255u) == 0u) { if (xb_ld(&(bar)[XB_TMO])) break; if (_sp > XB_SPIN_CAP) { atomicAdd(&(bar)[XB_TMO], 1u); break; } } } } while (0)
struct XcdBarrier { unsigned* bar; unsigned x; volatile LAS unsigned* st; };
__device__ __forceinline__ XcdBarrier xcd_barrier_post(unsigned* bar, volatile LAS unsigned* st) {
    XcdBarrier b; b.bar = bar; b.x = xb_xcc_id(); b.st = st;
    if (threadIdx.x == 0) (void)xb_add(&bar[XB_XCNT(b.x)], 1u);
    return b;
}
__device__ __forceinline__ void xcd_barrier_complete(unsigned* bar, unsigned x, unsigned& nloc, unsigned& nx) {
    const unsigned G = gridDim.x * gridDim.y * gridDim.z;
    unsigned sum, cnt, mine, sp = 0u;
    for (;;) {
        sum = 0u; cnt = 0u; mine = 0u;
#pragma unroll
        for (unsigned j = 0; j < 16; ++j) { const unsigned c = xb_ld(&bar[XB_XCNT(j)]); sum += c; cnt += (c > 0u) ? 1u : 0u; mine = (j == x) ? c : mine; }
        if (sum == G) break;
        __builtin_amdgcn_s_sleep(1);
        if ((++sp & 255u) == 0u) { if (xb_ld(&bar[XB_TMO])) break; if (sp > XB_SPIN_CAP) { atomicAdd(&bar[XB_TMO], 1u); break; } }
    }
    nloc = mine > 0u ? mine : 1u; nx = cnt > 0u ? cnt : 1u;
}
__device__ __forceinline__ void xcd_barrier(const XcdBarrier& b) {
    asm volatile("s_waitcnt vmcnt(0)" ::: "memory");
    __syncthreads();
    if (threadIdx.x == 0) {
        unsigned* bar = b.bar; asm volatile("" : "+s"(bar));
        __builtin_amdgcn_s_waitcnt(0);
        unsigned nloc = b.st[0], nx = b.st[1];
        if (nloc == 0u) { xcd_barrier_complete(bar, b.x, nloc, nx); b.st[0] = nloc; b.st[1] = nx; }
        const unsigned old = xb_add(&bar[XB_XSUB(b.x)], 1u);
        const unsigned gen = old / nloc;
        if (old + 1u == (gen + 1u) * nloc) {
            __builtin_amdgcn_fence(__ATOMIC_RELEASE, "agent");
            asm volatile("s_waitcnt vmcnt(0)" ::: "memory");
            const unsigned og = xb_add(&bar[XB_TOP], 1u);
            const unsigned tg = og / nx;
            __builtin_amdgcn_fence(__ATOMIC_ACQUIRE, "agent");
            if (og + 1u == (tg + 1u) * nx) xb_add(&bar[XB_TOPGEN], 1u);
            else XB_SPIN(xb_ld(&bar[XB_TOPGEN]) == tg, bar);
            xb_add(&bar[XB_XGEN(b.x)], 1u);
            asm volatile("s_waitcnt vmcnt(0)" ::: "memory");
        } else {
            __builtin_amdgcn_fence(__ATOMIC_ACQUIRE, "agent");
            XB_SPIN(xb_ld(&bar[XB_XGEN(b.x)]) == gen, bar);
            asm volatile("s_waitcnt vmcnt(0)" ::: "memory");
        }
    }
    __syncthreads();
}

constexpr int RING_OFF = 0, RING_BYTES = 131072;
constexpr int LDSCTL_OFF = RING_BYTES, MISC_OFF = LDSCTL_OFF + 320;
constexpr int RVT_OFF = LDSCTL_OFF + 512, RVT_UNITS = pg8::RVT_UNITS_;
constexpr int LDS_BYTES = 147456;
constexpr int AT_KL = 0, AT_VL = 24576, AT_BIAS = 49152, AT_WSF = 57344, AT_OST = 59392;
constexpr int PL_D = 0, PL_W = 32768;

__device__ __forceinline__ void build_row_scales(LAS unsigned char* lds, const pg8::StaticOrder& S, const float* SS) {
    int tid = threadIdx.x; asm volatile("" : "+v"(tid));
    LAS float* tab = (LAS float*)(lds + RVT_OFF);
    const int half = tid >> 8, t = tid & 255;
    for (int i0 = 0; i0 < RVT_UNITS; i0 += 4) {
        f32x4 p[2][4]; bool ok[2];
#pragma unroll
        for (int j = 0; j < 2; ++j) { pg8::Unit u; ok[j] = S.next(i0 + 2 * j + half, u); const size_t r = ok[j] ? (size_t)256 * u.pm + t : 0;
#pragma unroll
            for (int q = 0; q < 4; ++q) p[j][q] = *(const f32x4*)(SS + r * 16 + 4 * q); }
#pragma unroll
        for (int j = 0; j < 2; ++j) if (ok[j]) { const f32x4 a = (p[j][0] + p[j][1]) + (p[j][2] + p[j][3]); tab[(i0 + 2 * j + half) * 256 + t] = rsqrtf(((a[0] + a[1]) + (a[2] + a[3])) * (1.0f / 1024.0f) + EPS); }
        pg8::Unit u2; if (!S.next(i0 + 4, u2)) break;
    }
    __syncthreads();
}

template <bool GAIN>
__device__ __forceinline__ void transpose_item(const float* W, int K, int N, bf16* WT, const float* gain, LAS float* scr, int item, int lane) {
    const int nblk = N / 32, kb = item / nblk, nb = item % nblk, k0 = 64 * kb, n0 = 32 * nb;
    float wv[32];
    const float* wp = W + (size_t)(k0 + (lane >> 5)) * N + n0 + (lane & 31);
#pragma unroll
    for (int i = 0; i < 32; ++i) wv[i] = wp[(size_t)(2 * i) * N];
    float gl = 1.f; if (GAIN) gl = gain[k0 + lane];
#pragma unroll
    for (int i = 0; i < 32; ++i) { const int kk = 2 * i + (lane >> 5); const float gk = GAIN ? __shfl(gl, kk) : 1.f; scr[kk * 33 + (lane & 31)] = wv[i] * gk; }
    LDS_WAIT(); asm volatile("" ::: "memory");
    const int c = lane & 7;
#pragma unroll
    for (int j = 0; j < 4; ++j) { const int n = (lane >> 3) + 8 * j; const LAS float* s = scr + (8 * c) * 33 + n;
        u32x4 o; o.x = pk2(s[0 * 33], s[1 * 33]); o.y = pk2(s[2 * 33], s[3 * 33]); o.z = pk2(s[4 * 33], s[5 * 33]); o.w = pk2(s[6 * 33], s[7 * 33]);
        *(u32x4*)(WT + (size_t)(n0 + n) * K + k0 + 8 * c) = o; }
    LDS_WAIT(); asm volatile("" ::: "memory");
}

__device__ __forceinline__ int crow(int r, int hi) { return (r & 3) + 8 * (r >> 2) + 4 * hi; }
__device__ __forceinline__ void pv64(f32x16* o, int vb, bf16x8 pa0, bf16x8 pa1, bf16x8 pa2, bf16x8 pa3) {
#pragma unroll
    for (int d0 = 0; d0 < 2; ++d0) { s16x4 lo[4], hi[4];
#pragma unroll
        for (int ks = 0; ks < 4; ++ks) {
            asm volatile("ds_read_b64_tr_b16 %0,%1 offset:%c2" : "=&v"(lo[ks]) : "v"(vb), "i"(d0 * 4096 + ks * 1024) : "memory");
            asm volatile("ds_read_b64_tr_b16 %0,%1 offset:%c2" : "=&v"(hi[ks]) : "v"(vb), "i"(d0 * 4096 + ks * 1024 + 512) : "memory"); }
        asm volatile("s_waitcnt lgkmcnt(0)" ::: "memory"); __builtin_amdgcn_sched_barrier(0);
#define PK(k) (bf16x8){lo[k][0], lo[k][1], lo[k][2], lo[k][3], hi[k][0], hi[k][1], hi[k][2], hi[k][3]}
        o[d0] = __builtin_amdgcn_mfma_f32_32x32x16_bf16(pa0, PK(0), o[d0], 0, 0, 0);
        o[d0] = __builtin_amdgcn_mfma_f32_32x32x16_bf16(pa1, PK(1), o[d0], 0, 0, 0);
        o[d0] = __builtin_amdgcn_mfma_f32_32x32x16_bf16(pa2, PK(2), o[d0], 0, 0, 0);
        o[d0] = __builtin_amdgcn_mfma_f32_32x32x16_bf16(pa3, PK(3), o[d0], 0, 0, 0);
#undef PK
    }
}
__device__ __forceinline__ void attn_unit(LAS unsigned char* lds, const bf16* QKVU, bf16* MIX, const float* cache_k, const float* cache_v, const float* sinks,
                                          const int samp, const int b, const int c, const int g, const int wid) {
    int tid = threadIdx.x; asm volatile("" : "+v"(tid)); const int lane = tid & 63;
    LAS unsigned char* kl = lds + AT_KL; LAS unsigned char* vl = lds + AT_VL;
    u32x4 kvr[3], vvr[3];
    if (!samp) {
#pragma unroll
        for (int i = 0; i < 3; ++i) {
            const int p = tid + 512 * i, key = p >> 3, ch = p & 7;
            long t = 64 * (c - 2) + key; if (t < 0) t = 0;
            const bf16* rowp = QKVU + ((size_t)b * SEQ + (size_t)t) * EVIN;
            kvr[i] = *(const u32x4*)(rowp + 512 + 64 * g + 8 * ch); vvr[i] = *(const u32x4*)(rowp + 640 + 64 * g + 8 * ch);
        }
    } else {
        f32x4 ck[2][2], cv[2][2];
#pragma unroll
        for (int i = 0; i < 2; ++i) { const int p = tid + 512 * i, key = p >> 3, ch = p & 7; const size_t o = ((size_t)(b * 128 + key) * 2 + g) * 64 + 8 * ch;
            ck[i][0] = *(const f32x4*)(cache_k + o); ck[i][1] = *(const f32x4*)(cache_k + o + 4); cv[i][0] = *(const f32x4*)(cache_v + o); cv[i][1] = *(const f32x4*)(cache_v + o + 4); }
        { const int p = tid + 1024, key = p >> 3, ch = p & 7; const int kk = key < 144 ? key - 128 : 0;
          const bf16* rowp = QKVU + (size_t)(MPR + 16 * b + kk) * EVIN;
          kvr[2] = *(const u32x4*)(rowp + 512 + 64 * g + 8 * ch); vvr[2] = *(const u32x4*)(rowp + 640 + 64 * g + 8 * ch);
          if (key >= 144) { kvr[2] = (u32x4){0u, 0u, 0u, 0u}; vvr[2] = kvr[2]; } }
#pragma unroll
        for (int i = 0; i < 2; ++i) { kvr[i] = pk8(ck[i][0], ck[i][1]); vvr[i] = pk8(cv[i][0], cv[i][1]); }
    }
#pragma unroll
    for (int i = 0; i < 3; ++i) {
        const int p = tid + 512 * i, key = p >> 3, ch = p & 7;
        *(LAS u32x4*)(kl + (key >> 6) * 8192 + ch * 1024 + (key & 63) * 16) = kvr[i];
        *(LAS u32x4*)(vl + (key >> 6) * 8192 + (ch >> 2) * 4096 + ((key & 63) >> 4) * 1024 + (key & 15) * 64 + (ch & 3) * 16) = vvr[i];
    }
    const int hl = wid >> 1, qh = wid & 1, r32 = lane & 31, hi = lane >> 5, head = 4 * g + hl;
    const int q = samp ? (r32 & 15) : (32 * qh + r32);
    const size_t qrow = samp ? (size_t)(MPR + 16 * b + (r32 & 15)) : ((size_t)b * SEQ + 64 * c + q);
    const bf16* qp = QKVU + qrow * EVIN + 64 * head + 8 * hi;
    bf16x8 qr[4];
#pragma unroll
    for (int d0 = 0; d0 < 4; ++d0) qr[d0] = *(const bf16x8*)(qp + 16 * d0);
    __syncthreads();
    const LAS float* bt = (const LAS float*)(lds + AT_BIAS) + head * 256 + 63 - q;
    f32x16 p[6];
#pragma unroll
    for (int kt = 0; kt < 6; ++kt)
#pragma unroll
        for (int r = 0; r < 16; ++r) p[kt][r] = bt[32 * kt + crow(r, hi)];
#pragma unroll
    for (int kt = 0; kt < 6; ++kt) {
        const LAS unsigned char* kb = kl + (kt >> 1) * 8192 + hi * 1024 + ((kt & 1) * 32 + r32) * 16;
#pragma unroll
        for (int d0 = 0; d0 < 4; ++d0) { const bf16x8 kf = *(const LAS bf16x8*)(kb + d0 * 2048); p[kt] = __builtin_amdgcn_mfma_f32_32x32x16_bf16(kf, qr[d0], p[kt], 0, 0, 0); }
    }
    const int j0 = samp ? 0 : (c >= 2 ? 0 : 128 - 64 * c), j1 = samp ? 144 : 192;
    if (j0 > 0 || j1 < 192) {
#pragma unroll
        for (int kt = 0; kt < 6; ++kt)
#pragma unroll
            for (int r = 0; r < 16; ++r) { const int j = 32 * kt + crow(r, hi); if (j < j0 || j >= j1) p[kt][r] = -1e30f; }
    }
    const float sk = sinks[head] * LOG2E;
    float mx = sk;
#pragma unroll
    for (int kt = 0; kt < 6; ++kt)
#pragma unroll
        for (int r = 0; r < 16; ++r) mx = fmaxf(mx, p[kt][r]);
    mx = fmaxf(mx, __shfl_xor(mx, 32));
    float sum = 0.f;
#pragma unroll
    for (int kt = 0; kt < 6; ++kt)
#pragma unroll
        for (int r = 0; r < 16; ++r) { const float e = __builtin_amdgcn_exp2f(p[kt][r] - mx); p[kt][r] = e; sum += e; }
    sum += __shfl_xor(sum, 32);
    const float inv = 1.0f / (sum + __builtin_amdgcn_exp2f(sk - mx));
    f32x16 o[2]; o[0] = f32x16{}; o[1] = f32x16{};
    const int vb0 = (int)(unsigned)(uintptr_t)vl + ((lane >> 4) & 1) * 32 + (lane & 3) * 8 + (4 * hi + ((lane & 15) >> 2)) * 64;
#pragma unroll
    for (int t = 0; t < 3; ++t) {
        const f32x16& pa = p[2 * t]; const f32x16& pb = p[2 * t + 1];
        const u32x4 w0 = {pk2(pa[0], pa[1]), pk2(pa[2], pa[3]), pk2(pa[4], pa[5]), pk2(pa[6], pa[7])}, w1 = {pk2(pa[8], pa[9]), pk2(pa[10], pa[11]), pk2(pa[12], pa[13]), pk2(pa[14], pa[15])};
        const u32x4 w2 = {pk2(pb[0], pb[1]), pk2(pb[2], pb[3]), pk2(pb[4], pb[5]), pk2(pb[6], pb[7])}, w3 = {pk2(pb[8], pb[9]), pk2(pb[10], pb[11]), pk2(pb[12], pb[13]), pk2(pb[14], pb[15])};
        pv64(o, vb0 + t * 8192, __builtin_bit_cast(bf16x8, w0), __builtin_bit_cast(bf16x8, w1), __builtin_bit_cast(bf16x8, w2), __builtin_bit_cast(bf16x8, w3));
    }
    int lane2 = threadIdx.x & 63; asm volatile("" : "+v"(lane2));
    const int r32b = lane2 & 31, hib = lane2 >> 5;
    LAS float* wsf = (LAS float*)(lds + AT_WSF) + wid * 64;
    if (hib == 0) wsf[r32b] = inv;
    LDS_WAIT(); __builtin_amdgcn_wave_barrier();
    float rli[16];
#pragma unroll
    for (int r = 0; r < 16; ++r) rli[r] = wsf[crow(r, hib)];
    LAS bf16* stg = (LAS bf16*)(lds + AT_OST) + wid * 2048;
#pragma unroll
    for (int r = 0; r < 16; ++r) { const int orow = crow(r, hib);
#pragma unroll
        for (int d0 = 0; d0 < 2; ++d0) stg[orow * 64 + d0 * 32 + r32b] = (bf16)(pk2(o[d0][r] * rli[r], 0.f) & 0xffffu); }
    LDS_WAIT(); __builtin_amdgcn_wave_barrier();
#pragma unroll
    for (int i = 0; i < 4; ++i) { const int row = i * 8 + (lane2 >> 3), ch = lane2 & 7; const u32x4 v = *(const LAS u32x4*)(stg + row * 64 + ch * 8);
        if (!samp) *(u32x4*)(MIX + ((size_t)b * SEQ + 64 * c + 32 * qh + row) * DM + 64 * head + ch * 8) = v;
        else if (qh == 0 && row < 16) *(u32x4*)(MIX + (size_t)(MPR + 16 * b + row) * DM + 64 * head + ch * 8) = v; }
    __syncthreads();
}

template <int W> __device__ __forceinline__ void pool_group(LAS unsigned char* dt, const float (&x0)[31], const float (&x1)[31], const int pos0, const bool fixed_cnt, const int lane) {
    float s0 = 0.f, s1 = 0.f;
#pragma unroll
    for (int k = 1; k < W; ++k) { s0 += x0[15 - k]; s1 += x1[15 - k]; }
#pragma unroll
    for (int i = 0; i < 16; ++i) {
        s0 += x0[15 + i]; s1 += x1[15 + i];
        const int pos = pos0 + i; const float cnt = fixed_cnt ? (float)W : (float)((pos + 1) < W ? (pos + 1) : W);
        const float ic = 1.0f / cnt;
        const float d0 = s0 * ic - x0[15 + i], d1 = s1 * ic - x1[15 + i];
        *(LAS unsigned*)(dt + i * 256 + ((((lane >> 2) ^ i) & 15) << 4) + (lane & 3) * 4) = pk2(d0, d1);
        s0 -= x0[15 + i - (W - 1)]; s1 -= x1[15 + i - (W - 1)];
    }
}
template <bool WLDS>
__device__ __forceinline__ void pool_item(LAS unsigned char* lds, const bf16* QKVU, bf16* MIX, const float* state_pool, const bf16* POOLW, const float* pool_scale,
                                          const int samp, const size_t row0  , const int sb  , const int g, const int wid) {
    int lane = threadIdx.x & 63; asm volatile("" : "+v"(lane));
    LAS unsigned char* dt = lds + PL_D + wid * 4096;
    const int fr = lane & 15, fq = lane >> 4;
    const int t0 = samp ? 1024 : (int)(row0 & (SEQ - 1));
    {
        float x0[31], x1[31];
        const int col = 768 + 128 * g + 2 * lane;
        unsigned wseg[16];
#pragma unroll
        for (int e = 0; e < 16; ++e) wseg[e] = *(const unsigned*)(QKVU + (row0 + e) * EVIN + col);
        if (samp) {
            const float* sp = state_pool + (size_t)sb * 15 * 512 + 128 * g + 2 * lane;
            f32x2 hv[15];
#pragma unroll
            for (int e = 0; e < 15; ++e) hv[e] = *(const f32x2*)(sp + (size_t)e * 512);
#pragma unroll
            for (int e = 0; e < 15; ++e) { x0[e] = hv[e][0]; x1[e] = hv[e][1]; }
        } else if (t0 == 0) {
#pragma unroll
            for (int e = 0; e < 15; ++e) { x0[e] = 0.f; x1[e] = 0.f; }
        } else {
            unsigned wh[15];
#pragma unroll
            for (int e = 0; e < 15; ++e) wh[e] = *(const unsigned*)(QKVU + (row0 - 15 + e) * EVIN + col);
#pragma unroll
            for (int e = 0; e < 15; ++e) { x0[e] = bf_lo(wh[e]); x1[e] = bf_hi(wh[e]); }
        }
#pragma unroll
        for (int e = 0; e < 16; ++e) { x0[15 + e] = bf_lo(wseg[e]); x1[15 + e] = bf_hi(wseg[e]); }
        if (g == 0) pool_group<2>(dt, x0, x1, t0, samp != 0, lane);
        else if (g == 1) pool_group<4>(dt, x0, x1, t0, samp != 0, lane);
        else if (g == 2) pool_group<8>(dt, x0, x1, t0, samp != 0, lane);
        else pool_group<16>(dt, x0, x1, t0, samp != 0, lane);
    }
    LDS_WAIT(); __builtin_amdgcn_wave_barrier();
    bf16x8 wf[8][4];
    if (WLDS) {
        const LAS unsigned char* pw = lds + PL_W + (g & 1) * 32768 + fr * 256;
#pragma unroll
        for (int nf = 0; nf < 8; ++nf)
#pragma unroll
            for (int ks = 0; ks < 4; ++ks) wf[nf][ks] = *(const LAS bf16x8*)(pw + nf * 4096 + ((((4 * ks + fq) ^ fr) & 15) << 4));
    } else {
        const bf16* wp = POOLW + (size_t)g * 16384 + (size_t)fr * 128 + 8 * fq;
#pragma unroll
        for (int nf = 0; nf < 8; ++nf)
#pragma unroll
            for (int ks = 0; ks < 4; ++ks) wf[nf][ks] = *(const bf16x8*)(wp + (size_t)nf * 16 * 128 + 32 * ks);
    }
    bf16x8 af[4];
#pragma unroll
    for (int ks = 0; ks < 4; ++ks) af[ks] = *(const LAS bf16x8*)(dt + fr * 256 + ((((4 * ks + fq) ^ fr) & 15) << 4));
    const float* scp = pool_scale + 128 * g + 4 * fq;
    bf16* orow = MIX + (row0 + fr) * DM + 512 + 128 * g + 4 * fq;
#pragma unroll
    for (int nf = 0; nf < 8; ++nf) {
        f32x4 acc = {0.f, 0.f, 0.f, 0.f};
#pragma unroll
        for (int ks = 0; ks < 4; ++ks) acc = __builtin_amdgcn_mfma_f32_16x16x32_bf16(wf[nf][ks], af[ks], acc, 0, 0, 0);
        const f32x4 sc = *(const f32x4*)(scp + 16 * nf);
        acc = acc * sc;
        u32x2 w; w.x = pk2(acc[0], acc[1]); w.y = pk2(acc[2], acc[3]);
        *(u32x2*)(orow + 16 * nf) = w;
    }
    LDS_WAIT(); __builtin_amdgcn_wave_barrier();
}

template <int W> __device__ __forceinline__ void pool_seg_loads(const bf16* QKVU, const size_t row0, const int g, const int lane, unsigned (&raw)[W + 15]) {
    const bf16* p = QKVU + row0 * EVIN + 768 + 128 * g + 2 * lane;
#pragma unroll
    for (int e = 0; e < 16; ++e) raw[W - 1 + e] = *(const unsigned*)(p + (size_t)e * EVIN);
}
template <int W> __device__ __forceinline__ void pool_halo_loads(const bf16* QKVU, const size_t row0, const int g, const int lane, unsigned (&raw)[W + 15]) {
    const bf16* p = QKVU + row0 * EVIN + 768 + 128 * g + 2 * lane;
#pragma unroll
    for (int e = 0; e < W - 1; ++e) raw[e] = *(const unsigned*)(p - (size_t)(W - 1 - e) * EVIN);
}
template <int W> __device__ __forceinline__ void pool_halo_zero(unsigned (&raw)[W + 15]) {
#pragma unroll
    for (int e = 0; e < W - 1; ++e) raw[e] = 0u;
}
template <int W> __device__ __forceinline__ void pool_compute(LAS unsigned char* lds, bf16* MIX, const float* pool_scale, const unsigned (&raw)[W + 15], const size_t row0, const int t0, const int g, const int wid, const int lane) {
    LAS unsigned char* dt = lds + PL_D + wid * 4096;
    const int fr = lane & 15, fq = lane >> 4;
    float s0 = 0.f, s1 = 0.f;
#pragma unroll
    for (int e = 0; e < W - 1; ++e) { s0 += bf_lo(raw[e]); s1 += bf_hi(raw[e]); }
#pragma unroll
    for (int i = 0; i < 16; ++i) {
        const float u0 = bf_lo(raw[W - 1 + i]), u1 = bf_hi(raw[W - 1 + i]);
        s0 += u0; s1 += u1;
        const int pos = t0 + i; const float ic = 1.0f / (float)((pos + 1) < W ? (pos + 1) : W);
        *(LAS unsigned*)(dt + i * 256 + ((((lane >> 2) ^ i) & 15) << 4) + (lane & 3) * 4) = pk2(s0 * ic - u0, s1 * ic - u1);
        s0 -= bf_lo(raw[i]); s1 -= bf_hi(raw[i]);
    }
    LDS_WAIT(); __builtin_amdgcn_wave_barrier();
    bf16x8 wf[8][4];
    const LAS unsigned char* pw = lds + PL_W + (g & 1) * 32768 + fr * 256;
#pragma unroll
    for (int nf = 0; nf < 8; ++nf)
#pragma unroll
        for (int ks = 0; ks < 4; ++ks) wf[nf][ks] = *(const LAS bf16x8*)(pw + nf * 4096 + ((((4 * ks + fq) ^ fr) & 15) << 4));
    bf16x8 af[4];
#pragma unroll
    for (int ks = 0; ks < 4; ++ks) af[ks] = *(const LAS bf16x8*)(dt + fr * 256 + ((((4 * ks + fq) ^ fr) & 15) << 4));
    const float* scp = pool_scale + 128 * g + 4 * fq;
    bf16* orow = MIX + (row0 + fr) * DM + 512 + 128 * g + 4 * fq;
#pragma unroll
    for (int nf = 0; nf < 8; ++nf) {
        f32x4 acc = {0.f, 0.f, 0.f, 0.f};
#pragma unroll
        for (int ks = 0; ks < 4; ++ks) acc = __builtin_amdgcn_mfma_f32_16x16x32_bf16(wf[nf][ks], af[ks], acc, 0, 0, 0);
        const f32x4 sc = *(const f32x4*)(scp + 16 * nf);
        acc = acc * sc;
        u32x2 w; w.x = pk2(acc[0], acc[1]); w.y = pk2(acc[2], acc[3]);
        *(u32x2*)(orow + 16 * nf) = w;
    }
    LDS_WAIT(); __builtin_amdgcn_wave_barrier();
}
__device__ __forceinline__ void pool_stage_weights(LAS unsigned char* lds, const u32x4 (&wv)[8], const int t2) {
#pragma unroll
    for (int i = 0; i < 8; ++i) { const int chunk = t2 + 512 * i, row = chunk >> 4, c16 = chunk & 15; *(LAS u32x4*)(lds + PL_W + row * 256 + (((c16 ^ row) & 15) << 4)) = wv[i]; }
}
__device__ __forceinline__ void pool_unit_prompt(LAS unsigned char* lds, const bf16* QKVU, bf16* MIX, const bf16* POOLW, const float* pool_scale, const size_t row0, const int wid) {
    int t2 = threadIdx.x; asm volatile("" : "+v"(t2)); const int lane = t2 & 63;
    const int t0 = (int)(row0 & (SEQ - 1));
    u32x4 wv0[8], wv1[8];
#pragma unroll
    for (int i = 0; i < 8; ++i) wv0[i] = *(const u32x4*)(POOLW + (size_t)(t2 + 512 * i) * 8);
    unsigned r0[17], r1[19], r2[23], r3[31];
    pool_seg_loads<2>(QKVU, row0, 0, lane, r0); pool_seg_loads<4>(QKVU, row0, 1, lane, r1); pool_seg_loads<8>(QKVU, row0, 2, lane, r2); pool_seg_loads<16>(QKVU, row0, 3, lane, r3);
    if (t0 != 0) { pool_halo_loads<2>(QKVU, row0, 0, lane, r0); pool_halo_loads<4>(QKVU, row0, 1, lane, r1); pool_halo_loads<8>(QKVU, row0, 2, lane, r2); pool_halo_loads<16>(QKVU, row0, 3, lane, r3); }
    else { pool_halo_zero<2>(r0); pool_halo_zero<4>(r1); pool_halo_zero<8>(r2); pool_halo_zero<16>(r3); }
#pragma unroll
    for (int i = 0; i < 8; ++i) wv1[i] = *(const u32x4*)(POOLW + 32768 + (size_t)(t2 + 512 * i) * 8);
    pool_stage_weights(lds, wv0, t2);
    __syncthreads();
    pool_compute<2>(lds, MIX, pool_scale, r0, row0, t0, 0, wid, lane);
    pool_compute<4>(lds, MIX, pool_scale, r1, row0, t0, 1, wid, lane);
    __syncthreads();
    pool_stage_weights(lds, wv1, t2);
    __syncthreads();
    pool_compute<8>(lds, MIX, pool_scale, r2, row0, t0, 2, wid, lane);
    pool_compute<16>(lds, MIX, pool_scale, r3, row0, t0, 3, wid, lane);
    __syncthreads();
}

struct Args { const float* in[21]; float* out; unsigned char* ws; int ph_lo, ph_hi; };
static_assert(sizeof(Args) == 21 * 8 + 8 + 8 + 8, "Args has no padding");
static_assert(RVT_OFF + RVT_UNITS * 1024 <= LDS_BYTES, "row-scale table fits");

#define CAS __attribute__((address_space(4)))
__global__ void __launch_bounds__(512, 2) trunk_fwd(Args args_unused) {
    extern __shared__ __attribute__((aligned(16))) unsigned char lds_raw[];
    LAS unsigned char* lds = (LAS unsigned char*)lds_raw;
    volatile LAS unsigned* MISC = (volatile LAS unsigned*)(lds + MISC_OFF);
    const int wave = __builtin_amdgcn_readfirstlane(threadIdx.x >> 6);
    const int G = gridDim.x; const int bx = blockIdx.x; const int vcu = (G % 8 == 0) ? (bx % 8) * (G / 8) + bx / 8 : bx;
    const CAS Args* kp0 = (const CAS Args*)__builtin_amdgcn_kernarg_segment_ptr();
#define KP(name) const CAS Args* name = kp0; asm volatile("" : "+s"(name))
#define WSP(kp, off) ((kp)->ws + (off))
    for (int u = threadIdx.x; u < (LDS_BYTES - LDSCTL_OFF) / 4; u += 512) ((LAS unsigned*)(lds + LDSCTL_OFF))[u] = 0u;
    __syncthreads();
    XcdBarrier bar;
    { KP(kp); unsigned* ctl = (unsigned*)WSP(kp, WS_CTL); bar.bar = ctl + CW_BAR; bar.x = 0; bar.st = nullptr;
      if (N_LAUNCHES == 1) bar = xcd_barrier_post(ctl + CW_BAR, MISC + 8); }
    const int lo = kp0->ph_lo, hi = kp0->ph_hi;
#ifndef PROBE_DUP
#define PROBE_DUP (-1)
#endif
#define REP(k) for (int rep_ = 0; rep_ < ((PROBE_DUP == (k)) ? 2 : 1); ++rep_)
#define IN(k) (lo <= (k) && (k) < hi)
#define PH_TID() int tid = threadIdx.x; asm volatile("" : "+v"(tid)); const int lane = tid & 63
#define SEAM(k) do { if (IN(k) && IN((k) + 1)) xcd_barrier(bar); } while (0)
    const int gw = vcu * 8 + wave, NGW = G * 8;

    REP(0) {
    if (IN(0)) {
        PH_TID(); KP(kp); unsigned char* ws = kp->ws; float* out = kp->out;
        const float* x_prompt = kp->in[0]; const float* x_sample = kp->in[1]; const float* cache_k = kp->in[2]; const float* cache_v = kp->in[3];
        const float* norm_mix = kp->in[6]; const float* norm_ffn = kp->in[7]; const float* ffn_w1 = kp->in[8]; const float* ffn_w2 = kp->in[9]; const float* ev_w_in = kp->in[10]; const float* ev_w_out = kp->in[11];
        const float* pool_w = kp->in[16]; const float* conv_w_in = kp->in[18]; const float* conv_w_out = kp->in[20];
        float* RINV0 = (float*)(ws + WS_RINV0); bf16* POOLW = (bf16*)(ws + WS_POOLW); bf16* WIN = (bf16*)(ws + WS_WIN); bf16* WOUT = (bf16*)(ws + WS_WOUT); bf16* W1 = (bf16*)(ws + WS_W1); bf16* W2 = (bf16*)(ws + WS_W2);
        bf16* WCIN = (bf16*)(ws + WS_WCIN); bf16* WCOUT = (bf16*)(ws + WS_WCOUT); bf16* S1 = (bf16*)(ws + WS_S1);
        LAS float* scr = (LAS float*)(lds + RING_OFF + wave * 16384);
        constexpr int I_IN = 16 * 40, I_OUT = 16 * 32, I_W1 = 16 * 128, I_W2 = 64 * 32, I_CIN = 16 * 96, I_COUT = 16 * 32, I_PW = 4 * 8;
        constexpr int NITEMS = I_IN + I_OUT + I_W1 + I_W2 + I_CIN + I_COUT + I_PW;
        for (int it = gw; it < NITEMS; it += NGW) {
            int r = it;
            if (r < I_IN) { transpose_item<true>(ev_w_in, DM, EVIN, WIN, norm_mix, scr, r, lane); continue; } r -= I_IN;
            if (r < I_OUT) { transpose_item<false>(ev_w_out, DM, DM, WOUT, nullptr, scr, r, lane); continue; } r -= I_OUT;
            if (r < I_W1) { transpose_item<true>(ffn_w1, DM, DFF, W1, norm_ffn, scr, r, lane); continue; } r -= I_W1;
            if (r < I_W2) { transpose_item<false>(ffn_w2, DFF, DM, W2, nullptr, scr, r, lane); continue; } r -= I_W2;
            if (r < I_CIN) { transpose_item<true>(conv_w_in, DM, CIN, WCIN, norm_mix + DM, scr, r, lane); continue; } r -= I_CIN;
            if (r < I_COUT) { transpose_item<false>(conv_w_out, DM, DM, WCOUT, nullptr, scr, r, lane); continue; } r -= I_COUT;
            { const int g = r >> 3; transpose_item<false>(pool_w + (size_t)g * 16384, 128, 128, POOLW + (size_t)g * 16384, nullptr, scr, r & 7, lane); }
        }
        for (int m = gw * 4; m < MT; m += NGW * 4) {
            const float* xr = (m < MPR) ? x_prompt + (size_t)m * DM : x_sample + (size_t)(m - MPR) * DM;
            const f32x4* x4 = (const f32x4*)xr + lane;
            f32x4 v[4][4]; float sr[4];
#pragma unroll
            for (int q = 0; q < 4; ++q)
#pragma unroll
                for (int j = 0; j < 4; ++j) v[q][j] = x4[256 * q + 64 * j];
#pragma unroll
            for (int q = 0; q < 4; ++q) { sr[q] = (sq4(v[q][0]) + sq4(v[q][1])) + (sq4(v[q][2]) + sq4(v[q][3])); }
#pragma unroll
            for (int o = 1; o < 64; o <<= 1) {
#pragma unroll
                for (int q = 0; q < 4; ++q) sr[q] += __shfl_xor(sr[q], o); }
            if (lane < 4) { const float sv = lane == 0 ? sr[0] : (lane == 1 ? sr[1] : (lane == 2 ? sr[2] : sr[3])); RINV0[m + lane] = rsqrtf(sv * (1.0f / 1024.0f) + EPS); }
#pragma unroll
            for (int q = 0; q < 4; ++q) { u32x2* o8 = (u32x2*)(S1 + (size_t)(m + q) * DM) + lane;
#pragma unroll
                for (int j = 0; j < 4; ++j) { u32x2 w; w.x = pk2(v[q][j][0], v[q][j][1]); w.y = pk2(v[q][j][2], v[q][j][3]); o8[64 * j] = w; } }
        }
        { const f32x4* ck = (const f32x4*)cache_k; const f32x4* cv = (const f32x4*)cache_v; f32x4* ok = (f32x4*)(out + O_KS); f32x4* ov = (f32x4*)(out + O_VS);
          for (int e = vcu * 512 + tid; e < 2 * 8 * 3584; e += G * 512) { const int which = e / 28672, rem = e % 28672, b = rem / 3584, i = rem % 3584;
              if (which == 0) ok[b * 4096 + i] = ck[b * 4096 + 512 + i]; else ov[b * 4096 + i] = cv[b * 4096 + 512 + i]; } }
    }
    SEAM(0);
    }

    REP(1) {
    if (IN(1)) {
        PH_TID(); KP(kp); unsigned char* ws = kp->ws; float* out = kp->out; const float* q_norm = kp->in[12]; const float* k_norm = kp->in[13];
        bf16* S1 = (bf16*)(ws + WS_S1); bf16* WIN = (bf16*)(ws + WS_WIN); bf16* QKVU = (bf16*)(ws + WS_QKVU); float* RINV0 = (float*)(ws + WS_RINV0);
        { BRowPlain br{WIN, DM, 4}; SEpiInProj SE{QKVU, RINV0, q_norm, k_norm, out};
          sample_gemm<DM, 4, 4>(lds + RING_OFF, S1 + (size_t)MPR * DM, 20, (bx + G / 2) % G, G, br, SE, lane, wave); }
        pg8::MapHead<DM> mp{(const char*)S1, (const char*)WIN}; pg8::StaticOrder S; S.init(NTILE, EVIN / 256, G, bx);
        pg8::EpiInProj E{QKVU, RINV0, q_norm, k_norm, out};
        pg8::gemm_phase<DM, pg8::EpiInProj, pg8::MapHead<DM>>(lds + RING_OFF, mp, S, E);
        { const int nun = NTILE * (EVIN / 256), rem = nun % G, nlate = (rem == 0) ? G : G - rem;
          if (rem == 0 || bx >= rem) {
              const float* norm_ffn = kp->in[7]; const float* ffn_w1 = kp->in[8]; const float* ffn_w2 = kp->in[9];
              bf16* W1B = (bf16*)(out + O_YP); bf16* W2B = (bf16*)(ws + WS_W2B);
              LAS float* scr = (LAS float*)(lds + RING_OFF + wave * 16384);
              constexpr int I_W1 = 16 * 128, I_W2 = 64 * 32;
              for (int it = ((rem == 0) ? bx : bx - rem) * 8 + wave; it < I_W1 + I_W2; it += nlate * 8) {
                  if (it < I_W1) transpose_item<true>(ffn_w1 + (size_t)DM * DFF, DM, DFF, W1B, norm_ffn + DM, scr, it, lane);
                  else transpose_item<false>(ffn_w2 + (size_t)DFF * DM, DFF, DM, W2B, nullptr, scr, it - I_W1, lane); } } }
    }
    SEAM(1);
    }

    REP(2) {
    if (IN(2)) {
        PH_TID(); KP(kp); unsigned char* ws = kp->ws; const float* cache_k = kp->in[2]; const float* cache_v = kp->in[3]; const float* state_pool = kp->in[4];
        const float* attn_sinks = kp->in[14]; const float* rel_bias = kp->in[15]; const float* pool_scale = kp->in[17];
        bf16* QKVU = (bf16*)(ws + WS_QKVU); bf16* POOLW = (bf16*)(ws + WS_POOLW);
        bf16* MIX = (bf16*)(ws + WS_S0);
        { LAS float* bt = (LAS float*)(lds + AT_BIAS);
          for (int e = tid; e < 8 * 256; e += 512) { const int h = e >> 8, idx = e & 255; float v = 0.f;
              if (idx < 255) { const int rel = idx - 191, n = rel < 0 ? -rel : rel; int bk = n < 8 ? n : (33 - __builtin_clz((unsigned)(n * n))); if (bk > 15) bk = 15; if (rel > 0) bk += 16; v = rel_bias[bk * 8 + h] * LOG2E; }
              bt[e] = v; } }
        __syncthreads();
        for (int un = vcu * 4, cnt = 0; un < 1040; ) {
            const int samp = un >= 1024 ? 1 : 0, sidx = un - 1024;
            const int ub = samp ? (sidx >> 1) : (un >> 9), ug = samp ? (sidx & 1) : ((un >> 8) & 1), uc = samp ? 0 : (un & 255);
            attn_unit(lds, QKVU, MIX, cache_k, cache_v, attn_sinks, samp, ub, uc, ug, wave);
            ++cnt;
            if (cnt < 4) ++un;
            else if (cnt == 4) un = (4 * G >= 1024) ? 1024 + vcu : 4 * G + vcu;
            else un += G;
        }
        for (int pu = vcu; pu < 256; pu += G) pool_unit_prompt(lds, QKVU, MIX, POOLW, pool_scale, (size_t)pu * 128 + wave * 16, wave);
        if (wave == 0) for (int it = (G >= 64) ? vcu - G / 2 : vcu; it >= 0 && it < 32; it += G) pool_item<false>(lds, QKVU, MIX, state_pool, POOLW, pool_scale, 1, (size_t)MPR + (it >> 2) * 16, it >> 2, it & 3, wave);
    }
    SEAM(2);
    }

    REP(3) {
    if (IN(3)) {
        PH_TID(); KP(kp); unsigned char* ws = kp->ws; float* out = kp->out; const float* x_prompt = kp->in[0]; const float* x_sample = kp->in[1];
        bf16* S0 = (bf16*)(ws + WS_S0); bf16* S1 = (bf16*)(ws + WS_S1); bf16* WOUT = (bf16*)(ws + WS_WOUT); float* SS = (float*)(ws + WS_SS); float* XP = out + O_YP; float* XS = out + O_YS;
        pg8::MapHead<DM> mp{(const char*)S0, (const char*)WOUT}; pg8::StaticOrder S; S.init(NTILE, DM / 256, G, bx);
        { BRowPlain br{WOUT, DM, 2}; SEpiResid<1, 2> SE{nullptr, S1, SS + (size_t)MT * 16, nullptr}; sample_gemm<DM, 2, 8>(lds + RING_OFF, S0 + (size_t)MPR * DM, 32, vcu, G, br, SE, lane, wave); }
        pg8::EpiResid<1> E{nullptr, S1, SS, nullptr};
        pg8::gemm_phase<DM, pg8::EpiResid<1>, pg8::MapHead<DM>>(lds + RING_OFF, mp, S, E);
    }
    SEAM(3);
    }
    REP(4) {
    if (IN(4)) {
        PH_TID(); KP(kp); unsigned char* ws = kp->ws; bf16* S1 = (bf16*)(ws + WS_S1); bf16* W1 = (bf16*)(ws + WS_W1); bf16* H = (bf16*)(ws + WS_H); float* SS = (float*)(ws + WS_SS);
        { BRowPlain br{W1, DM, 4}; SEpiUp SE{H, SS + (size_t)MT * 16}; sample_gemm<DM, 4, 4>(lds + RING_OFF, S1 + (size_t)MPR * DM, 64, vcu, G, br, SE, lane, wave); }
        pg8::MapHead<DM> mp{(const char*)S1, (const char*)W1}; pg8::StaticOrder S; S.init(NTILE, DFF / 256, G, bx);
        build_row_scales(lds, S, SS);
        pg8::EpiUp E{H, (const LAS float*)(lds + RVT_OFF), SS};
        pg8::gemm_phase<DM, pg8::EpiUp, pg8::MapHead<DM>>(lds + RING_OFF, mp, S, E);
    }
    SEAM(4);
    }
    REP(5) {
    if (IN(5)) {
        PH_TID(); KP(kp); unsigned char* ws = kp->ws; float* out = kp->out; bf16* S1 = (bf16*)(ws + WS_S1); bf16* W2 = (bf16*)(ws + WS_W2); bf16* H = (bf16*)(ws + WS_H); float* SS = (float*)(ws + WS_SS); float* XP = out + O_YP; float* XS = out + O_YS;
        pg8::MapHeadAT<DFF> mp{(const char*)H, (const char*)W2}; pg8::StaticOrder S; S.init(NTILE, DM / 256, G, bx);
        { BRowPlain br{W2, DFF, 2}; SEpiResid<1, 2> SE{nullptr, S1, SS + (size_t)MT * 16, nullptr}; sample_gemm<DFF, 2, 8>(lds + RING_OFF, H + (size_t)MPR * DFF, 32, vcu, G, br, SE, lane, wave); }
        pg8::EpiResid<1> E{nullptr, S1, SS, nullptr};
        pg8::gemm_phase<DFF, pg8::EpiResid<1>, pg8::MapHeadAT<DFF>>(lds + RING_OFF, mp, S, E);
    }
    SEAM(5);
    }
    REP(6) {
    if (IN(6)) {
        PH_TID(); KP(kp); unsigned char* ws = kp->ws; float* out = kp->out; bf16* S1 = (bf16*)(ws + WS_S1); bf16* WCIN = (bf16*)(ws + WS_WCIN); bf16* BE = (bf16*)(ws + WS_H); float* SS = (float*)(ws + WS_SS);
        pg8::MapConvIn<DM> mp{(const char*)S1, (const char*)WCIN}; pg8::StaticOrder S; S.init(NTILE, CIN / 256, G, bx);
        { BRowConvIn br{WCIN}; SEpiConvIn SE{BE, SS + (size_t)MT * 16, out}; sample_gemm<DM, 3, 4>(lds + RING_OFF, S1 + (size_t)MPR * DM, 64, vcu, G, br, SE, lane, wave); }
        build_row_scales(lds, S, SS);
        pg8::EpiConvIn E{BE, (const LAS float*)(lds + RVT_OFF), SS, out};
        pg8::gemm_phase<DM, pg8::EpiConvIn, pg8::MapConvIn<DM>>(lds + RING_OFF, mp, S, E);
    }
    SEAM(6);
    }
    REP(7) {
    if (IN(7)) {
        PH_TID(); KP(kp); unsigned char* ws = kp->ws; const float* state_conv = kp->in[5]; const float* norm_ffn = kp->in[7]; const float* ffn_w1 = kp->in[8]; const float* ffn_w2 = kp->in[9]; const float* conv_w = kp->in[19];
        bf16* S0 = (bf16*)(ws + WS_S0); bf16* W1 = (bf16*)(ws + WS_W1); bf16* W2 = (bf16*)(ws + WS_W2); bf16* BE = (bf16*)(ws + WS_H);
        const int cg = tid & 127, seg = tid >> 7;
        f32x4 w0a = *(const f32x4*)(conv_w + 8 * cg), w0b = *(const f32x4*)(conv_w + 8 * cg + 4);
        f32x4 w1a = *(const f32x4*)(conv_w + DM + 8 * cg), w1b = *(const f32x4*)(conv_w + DM + 8 * cg + 4);
        f32x4 w2a = *(const f32x4*)(conv_w + 2 * DM + 8 * cg), w2b = *(const f32x4*)(conv_w + 2 * DM + 8 * cg + 4);
        for (int un = vcu; un < MPR / 64; un += G) {
            const size_t r0 = (size_t)un * 64 + seg * 16;
            f32x4 p2a, p2b, p1a, p1b;
            if (r0 >= (size_t)MPR) { const int b = (int)((r0 - MPR) >> 4); const float* sp = state_conv + (size_t)b * 2 * DM + 8 * cg;
                p2a = *(const f32x4*)sp; p2b = *(const f32x4*)(sp + 4); p1a = *(const f32x4*)(sp + DM); p1b = *(const f32x4*)(sp + DM + 4); }
            else if ((r0 & (SEQ - 1)) == 0) { p2a = (f32x4){0.f, 0.f, 0.f, 0.f}; p2b = p2a; p1a = p2a; p1b = p2a; }
            else { const u32x4 e2 = *(const u32x4*)(BE + be_off(r0 - 2, 1024 + 8 * cg)), e1 = *(const u32x4*)(BE + be_off(r0 - 1, 1024 + 8 * cg));
                p2a = (f32x4){bf_lo(e2.x), bf_hi(e2.x), bf_lo(e2.y), bf_hi(e2.y)}; p2b = (f32x4){bf_lo(e2.z), bf_hi(e2.z), bf_lo(e2.w), bf_hi(e2.w)};
                p1a = (f32x4){bf_lo(e1.x), bf_hi(e1.x), bf_lo(e1.y), bf_hi(e1.y)}; p1b = (f32x4){bf_lo(e1.z), bf_hi(e1.z), bf_lo(e1.w), bf_hi(e1.w)}; }
#pragma unroll 8
            for (int i = 0; i < 16; ++i) {
                const size_t r = r0 + i;
                const u32x4 bw = *(const u32x4*)(BE + be_off(r, 8 * cg)), ew = *(const u32x4*)(BE + be_off(r, 1024 + 8 * cg));
                const f32x4 ea = {bf_lo(ew.x), bf_hi(ew.x), bf_lo(ew.y), bf_hi(ew.y)}, eb = {bf_lo(ew.z), bf_hi(ew.z), bf_lo(ew.w), bf_hi(ew.w)};
                const f32x4 ba = {bf_lo(bw.x), bf_hi(bw.x), bf_lo(bw.y), bf_hi(bw.y)}, bb = {bf_lo(bw.z), bf_hi(bw.z), bf_lo(bw.w), bf_hi(bw.w)};
                const f32x4 ya = w0a * p2a + w1a * p1a + w2a * ea, yb = w0b * p2b + w1b * p1b + w2b * eb;
                *(u32x4*)(S0 + r * DM + 8 * cg) = pk8(ba * ya, bb * yb);
                p2a = p1a; p2b = p1b; p1a = ea; p1b = eb;
            }
        }
        for (int b = (G >= 8) ? vcu - (G - 8) : vcu; b >= 0 && b < 8; b += G) {
            const size_t r0 = (size_t)MPR + 16 * b + 4 * seg;
            f32x4 p2a, p2b, p1a, p1b;
            if (seg == 0) { const float* sp = state_conv + (size_t)b * 2 * DM + 8 * cg;
                p2a = *(const f32x4*)sp; p2b = *(const f32x4*)(sp + 4); p1a = *(const f32x4*)(sp + DM); p1b = *(const f32x4*)(sp + DM + 4); }
            else { const u32x4 e2 = *(const u32x4*)(BE + (r0 - 2) * 2048 + 1024 + 8 * cg), e1 = *(const u32x4*)(BE + (r0 - 1) * 2048 + 1024 + 8 * cg);
                p2a = (f32x4){bf_lo(e2.x), bf_hi(e2.x), bf_lo(e2.y), bf_hi(e2.y)}; p2b = (f32x4){bf_lo(e2.z), bf_hi(e2.z), bf_lo(e2.w), bf_hi(e2.w)};
                p1a = (f32x4){bf_lo(e1.x), bf_hi(e1.x), bf_lo(e1.y), bf_hi(e1.y)}; p1b = (f32x4){bf_lo(e1.z), bf_hi(e1.z), bf_lo(e1.w), bf_hi(e1.w)}; }
#pragma unroll
            for (int i = 0; i < 4; ++i) {
                const size_t r = r0 + i;
                const u32x4 bw = *(const u32x4*)(BE + r * 2048 + 8 * cg), ew = *(const u32x4*)(BE + r * 2048 + 1024 + 8 * cg);
                const f32x4 ea = {bf_lo(ew.x), bf_hi(ew.x), bf_lo(ew.y), bf_hi(ew.y)}, eb = {bf_lo(ew.z), bf_hi(ew.z), bf_lo(ew.w), bf_hi(ew.w)};
                const f32x4 ba = {bf_lo(bw.x), bf_hi(bw.x), bf_lo(bw.y), bf_hi(bw.y)}, bb = {bf_lo(bw.z), bf_hi(bw.z), bf_lo(bw.w), bf_hi(bw.w)};
                const f32x4 ya = w0a * p2a + w1a * p1a + w2a * ea, yb = w0b * p2b + w1b * p1b + w2b * eb;
                *(u32x4*)(S0 + r * DM + 8 * cg) = pk8(ba * ya, bb * yb);
                p2a = p1a; p2b = p1b; p1a = ea; p1b = eb;
            }
        }
    }
    SEAM(7);
    }
    REP(8) {
    if (IN(8)) {
        PH_TID(); KP(kp); unsigned char* ws = kp->ws; float* out = kp->out; bf16* S0 = (bf16*)(ws + WS_S0); bf16* S1 = (bf16*)(ws + WS_S1); bf16* WCOUT = (bf16*)(ws + WS_WCOUT); float* SS = (float*)(ws + WS_SS); float* XP = out + O_YP; float* XS = out + O_YS;
        pg8::MapHead<DM> mp{(const char*)S0, (const char*)WCOUT}; pg8::StaticOrder S; S.init(NTILE, DM / 256, G, bx);
        { BRowPlain br{WCOUT, DM, 2}; SEpiResid<1, 2> SE{nullptr, S1, SS + (size_t)MT * 16, nullptr}; sample_gemm<DM, 2, 8>(lds + RING_OFF, S0 + (size_t)MPR * DM, 32, vcu, G, br, SE, lane, wave); }
        pg8::EpiResid<1> E{nullptr, S1, SS, nullptr};
        pg8::gemm_phase<DM, pg8::EpiResid<1>, pg8::MapHead<DM>>(lds + RING_OFF, mp, S, E);
    }
    SEAM(8);
    }
    REP(9) {
    if (IN(9)) {
        PH_TID(); KP(kp); unsigned char* ws = kp->ws; bf16* S1 = (bf16*)(ws + WS_S1); bf16* W1 = (bf16*)(kp->out + O_YP); bf16* H = (bf16*)(ws + WS_H); float* SS = (float*)(ws + WS_SS);
        { BRowPlain br{W1, DM, 4}; SEpiUp SE{H, SS + (size_t)MT * 16}; sample_gemm<DM, 4, 4>(lds + RING_OFF, S1 + (size_t)MPR * DM, 64, vcu, G, br, SE, lane, wave); }
        pg8::MapHead<DM> mp{(const char*)S1, (const char*)W1}; pg8::StaticOrder S; S.init(NTILE, DFF / 256, G, bx);
        build_row_scales(lds, S, SS);
        pg8::EpiUp E{H, (const LAS float*)(lds + RVT_OFF), SS};
        pg8::gemm_phase<DM, pg8::EpiUp, pg8::MapHead<DM>>(lds + RING_OFF, mp, S, E);
    }
    SEAM(9);
    }
    if (IN(10)) {
        PH_TID(); KP(kp); unsigned char* ws = kp->ws; float* out = kp->out; bf16* S1 = (bf16*)(ws + WS_S1); bf16* W2 = (bf16*)(ws + WS_W2B); bf16* H = (bf16*)(ws + WS_H); float* XP = out + O_YP; float* XS = out + O_YS;
        pg8::MapHeadAT<DFF> mp{(const char*)H, (const char*)W2}; pg8::StaticOrder S; S.init(NTILE, DM / 256, G, bx);
        { BRowPlain br{W2, DFF, 2}; SEpiResid<2, 2> SE{nullptr, S1, nullptr, XS}; sample_gemm<DFF, 2, 8>(lds + RING_OFF, H + (size_t)MPR * DFF, 32, vcu, G, br, SE, lane, wave); }
        pg8::EpiResid<2> E{nullptr, S1, nullptr, XP};
        pg8::gemm_phase<DFF, pg8::EpiResid<2>, pg8::MapHeadAT<DFF>>(lds + RING_OFF, mp, S, E);
    }
#undef IN
#undef SEAM
#undef KP
#undef WSP
}

extern "C" void kernel_launch(void* const* d_in, const int* in_sizes, int n_in, void* d_out, int out_size, void* d_ws, size_t ws_size, hipStream_t stream) {
    static int grid = 0;
    if (grid == 0) {
        if (n_in != 21 || in_sizes[0] != MPR * DM || (size_t)out_size != O_END || ws_size < WS_END) {
            fprintf(stderr, "kernel_launch: unexpected problem: n_in %d in0 %d out %d ws %zu (need %zu); nothing launched\n", n_in, n_in > 0 ? in_sizes[0] : -1, out_size, ws_size, (size_t)WS_END); grid = -1; return; }
        int dev = 0, cus = 0, per_cu = 0;
        if (hipGetDevice(&dev) != hipSuccess || hipDeviceGetAttribute(&cus, hipDeviceAttributeMultiprocessorCount, dev) != hipSuccess) { fprintf(stderr, "kernel_launch: device query failed\n"); grid = -1; return; }
        if (hipFuncSetAttribute((const void*)trunk_fwd, hipFuncAttributeMaxDynamicSharedMemorySize, LDS_BYTES) != hipSuccess) { fprintf(stderr, "kernel_launch: hipFuncSetAttribute failed\n"); grid = -1; return; }
        if (hipOccupancyMaxActiveBlocksPerMultiprocessor(&per_cu, (const void*)trunk_fwd, 512, LDS_BYTES) != hipSuccess || per_cu < 1) {
            fprintf(stderr, "kernel_launch: occupancy query reports %d workgroups per CU; nothing launched\n", per_cu); (void)hipGetLastError(); grid = -1; return; }
        grid = cus;
    }
    if (grid < 0) return;
    if (hipMemsetAsync((char*)d_ws + WS_CTL, 0, CTL_ZERO_BYTES, stream) != hipSuccess) { fprintf(stderr, "kernel_launch: memset failed\n"); return; }
    Args a{};
    for (int i = 0; i < 21; ++i) a.in[i] = (const float*)d_in[i];
    a.out = (float*)d_out; a.ws = (unsigned char*)d_ws;
    for (int li = 0; li < N_LAUNCHES; ++li) {
        a.ph_lo = (N_LAUNCHES == 1) ? 0 : li; a.ph_hi = (N_LAUNCHES == 1) ? NPH : li + 1;
        hipLaunchKernelGGL(trunk_fwd, dim3(grid), dim3(512), LDS_BYTES, stream, a);
        const hipError_t le = hipPeekAtLastError();
        if (le != hipSuccess) { fprintf(stderr, "kernel_launch: launch %d failed: %s\n", li, hipGetErrorName(le)); break; }
    }
}
```

```cpp
#include <hip/hip_runtime.h>
#include <cstdio>
#include <cstdint>

#define LAS __attribute__((address_space(3)))
#define GAS __attribute__((address_space(1)))
typedef unsigned short bf16;
typedef short bf16x8 __attribute__((ext_vector_type(8)));
typedef short s16x4 __attribute__((ext_vector_type(4)));
typedef float f32x2 __attribute__((ext_vector_type(2)));
typedef float f32x4 __attribute__((ext_vector_type(4)));
typedef float f32x16 __attribute__((ext_vector_type(16)));
typedef unsigned u32x2 __attribute__((ext_vector_type(2)));
typedef unsigned u32x4 __attribute__((ext_vector_type(4)));
typedef __bf16 bf16x2_t __attribute__((ext_vector_type(2)));

#ifndef MK_N_LAUNCHES
#define MK_N_LAUNCHES 1
#endif
constexpr int NPH = 11;
constexpr int N_LAUNCHES = MK_N_LAUNCHES;
static_assert(N_LAUNCHES == 1 || N_LAUNCHES == NPH, "MK_N_LAUNCHES is 1 or 11");

constexpr int DM = 1024, SEQ = 16384, NBATCH = 2, MPR = NBATCH * SEQ, MSR = 128, MT = MPR + MSR, NTILE = 128;
constexpr int EVIN = 1280, DFF = 4096, CIN = 3072;
constexpr float EPS = 1e-6f, LOG2E = 1.4426950408889634f, QSCALE = 0.125f * 1.4426950408889634f;
constexpr size_t O_YP = 0, O_YS = 33554432, O_KP = 33685504, O_VP = 33718272, O_PP = 33751040, O_CP = 33766400, O_KS = 33770496, O_VS = 33901568, O_PS = 34032640, O_CS = 34094080, O_END = 34110464;
constexpr size_t KiB = 1024, MiB = 1024 * 1024;
constexpr size_t WS_CTL = 0, CTL_ZERO_BYTES = 256 * KiB;
constexpr size_t WS_RINV0 = 256 * KiB;
constexpr size_t WS_SS = 512 * KiB;
constexpr size_t WS_POOLW = 2816 * KiB;
constexpr size_t WS_WIN = 3 * MiB;
constexpr size_t WS_WOUT = WS_WIN + 2560 * KiB;
constexpr size_t WS_W1 = WS_WOUT + 2 * MiB;
constexpr size_t WS_W2 = WS_W1 + 8 * MiB;
constexpr size_t WS_WCIN = WS_W2 + 8 * MiB;
constexpr size_t WS_WCOUT = WS_WCIN + 6 * MiB;
constexpr size_t WS_S0 = 32 * MiB;
constexpr size_t WS_S1 = WS_S0 + 65 * MiB;
constexpr size_t WS_QKVU = WS_S1 + 65 * MiB;
constexpr size_t WS_H = WS_QKVU + 81 * MiB;
constexpr size_t WS_W2B = WS_H + 257 * MiB;
constexpr size_t WS_END = WS_W2B + 8 * MiB;
static_assert(WS_WCOUT + 2 * MiB <= WS_S0 && (size_t)MT * 2048 <= 65 * MiB && (size_t)MT * 2560 <= 81 * MiB && (size_t)MT * 8192 <= 257 * MiB && WS_END <= 512 * MiB, "ws map");
static_assert(WS_SS + (size_t)MT * 64 + 128 * 32 * 4 <= WS_POOLW, "ws map ss (+ the sample rows' 32-slot table behind it)");
constexpr int CW_BAR = 4096;

__device__ __forceinline__ unsigned pk2(float lo, float hi) { f32x2 v = {lo, hi}; bf16x2_t b = __builtin_convertvector(v, bf16x2_t); return __builtin_bit_cast(unsigned, b); }
__device__ __forceinline__ u32x4 pk8(f32x4 a, f32x4 b) { u32x4 w; w.x = pk2(a[0], a[1]); w.y = pk2(a[2], a[3]); w.z = pk2(b[0], b[1]); w.w = pk2(b[2], b[3]); return w; }
__device__ __forceinline__ float bf_lo(unsigned w) { return __uint_as_float(w << 16); }
__device__ __forceinline__ float bf_hi(unsigned w) { return __uint_as_float(w & 0xffff0000u); }
__device__ __forceinline__ float sq4(f32x4 v) { return (v[0] * v[0] + v[1] * v[1]) + (v[2] * v[2] + v[3] * v[3]); }
__device__ __forceinline__ float wave_sum(float v) {
#pragma unroll
    for (int o = 1; o < 64; o <<= 1) v += __shfl_xor(v, o);
    return v;
}
__device__ __forceinline__ size_t be_off(size_t r, int c) { return (r >> 8) * (size_t)(256 * 2048) + (size_t)(c >> 5) * 8192 + (r & 255) * 32 + (c & 31); }
#define LDS_WAIT() asm volatile("s_waitcnt lgkmcnt(0)" ::: "memory")
#define VM_WAIT() asm volatile("s_waitcnt vmcnt(0)" ::: "memory")

namespace pg8 {
constexpr size_t WS_H_OFF = WS_H, WS_S0_OFF = WS_S0, WS_SS_OFF = WS_SS;
constexpr int RVT_UNITS_ = 12;
constexpr int BM = 256, BK = 64, HALF = 128, HTB = HALF * BK * 2, STAGE_BYTES = 8 * HTB, NXCD = 8, WGM = 8;
__host__ __device__ __forceinline__ int lds_byte(int r, int c) { const int st = (r >> 4) * 2 + (c >> 5), rr = r & 15, cc = c & 31, ob = rr * 64 + cc * 2; return st * 1024 + (ob ^ (((ob >> 9) & 1) << 5)); }
__host__ __device__ __forceinline__ void stage_rc(int b, int& R, int& C) { const int st = b / 1024, sb = b % 1024, swz = sb ^ (((sb >> 9) & 1) << 5); R = (st >> 1) * 16 + swz / 64; C = (st & 1) * 32 + (swz % 64) / 2; }
__host__ __device__ __forceinline__ int perm32(int rho) { const int n = rho >> 4, i = rho & 15; return 8 * (i >> 2) + 4 * n + (i & 3); }
struct Unit { int pm, pn, idx; };
struct StaticOrder {
    int nM, nN, nwg, G, c;
    __device__ void init(int nM_, int nN_, int G_, int c_) { nM = nM_; nN = nN_; nwg = nM * nN; G = G_; c = c_; }
    __device__ bool next(int i, Unit& u) const {
        const long L = (long)i * G + c; if (L >= nwg) return false;
        int wgid = (int)L; { const int q = nwg / NXCD, r = nwg % NXCD, xcd = wgid % NXCD, off = wgid / NXCD; wgid = (xcd < r ? xcd * (q + 1) : r * (q + 1) + (xcd - r) * q) + off; }
        const int nig = WGM * nN, gid = wgid / nig, fm = gid * WGM, gsz = (nM - fm) < WGM ? (nM - fm) : WGM;
        u.pm = fm + ((wgid % nig) % gsz); u.pn = (wgid % nig) / gsz; return true;
    }
};
template <int K> struct MapPlain {
    static constexpr int BMODE = 0; static constexpr bool ATILE = false;
    const char* A; const char* Bt;
    __device__ __forceinline__ void ptrs(const Unit& u, const char*& a, size_t& aH, const char*& b, size_t& bH) const {
        a = A + (size_t)u.pm * 256 * K * 2; aH = (size_t)128 * K * 2;
        b = Bt + (size_t)u.pn * 256 * K * 2; bH = (size_t)128 * K * 2; }
};
template <int K> struct MapHead {
    static constexpr int BMODE = 1; static constexpr bool ATILE = false;
    const char* A; const char* Bt;
    __device__ __forceinline__ void ptrs(const Unit& u, const char*& a, size_t& aH, const char*& b, size_t& bH) const {
        a = A + (size_t)u.pm * 256 * K * 2; aH = (size_t)128 * K * 2;
        b = Bt + (size_t)u.pn * 256 * K * 2; bH = (size_t)32 * K * 2; }
};
template <int K> struct MapHeadAT {
    static constexpr int BMODE = 1; static constexpr bool ATILE = true;
    const char* A; const char* Bt;
    __device__ __forceinline__ void ptrs(const Unit& u, const char*& a, size_t& aH, const char*& b, size_t& bH) const {
        a = A + (size_t)u.pm * 256 * K * 2; aH = (size_t)128 * 32 * 2;
        b = Bt + (size_t)u.pn * 256 * K * 2; bH = (size_t)32 * K * 2; }
};
template <int K> struct MapConvIn {
    static constexpr int BMODE = 0; static constexpr bool ATILE = false;
    const char* A; const char* Bt;
    __device__ __forceinline__ void ptrs(const Unit& u, const char*& a, size_t& aH, const char*& b, size_t& bH) const {
        a = A + (size_t)u.pm * 256 * K * 2; aH = (size_t)128 * K * 2;
        if (u.pn < 4) { b = Bt + (size_t)u.pn * 256 * K * 2; bH = (size_t)128 * K * 2; }
        else { b = Bt + (size_t)(1024 + 128 * (u.pn - 4)) * K * 2; bH = (size_t)1024 * K * 2; } }
};

template <int K> struct MapConvE {
    static constexpr int BMODE = 0; static constexpr bool ATILE = false;
    const char* A; const char* Bt;
    __device__ __forceinline__ void ptrs(const Unit& u, const char*& a, size_t& aH, const char*& b, size_t& bH) const {
        a = A + (size_t)u.pm * 256 * K * 2; aH = (size_t)128 * K * 2;
        b = Bt + (size_t)(1024 + 128 * u.pn) * K * 2; bH = (size_t)1024 * K * 2; }
};

template <int K, class Epi, class Map>
__device__ __forceinline__ void gemm_phase(LAS unsigned char* lds, const Map& MPp, const StaticOrder& S, const Epi& E) {
    int tid = threadIdx.x; asm volatile("" : "+v"(tid));
    const int wid = __builtin_amdgcn_readfirstlane(tid >> 6), lane = tid & 63, wr = wid >> 2, wc = wid & 3, fr = lane & 15, fq = lane >> 4;
    constexpr int nt = K / BK;
    unsigned voffA[2], voffB[2];
#pragma unroll
    for (int i = 0; i < 2; ++i) { int R, C; stage_rc(tid * 16 + i * 8192, R, C);
        const int Rb = (Map::BMODE == 1) ? (64 * (R >> 5) + perm32(R & 31)) : ((R & ~31) + perm32(R & 31));
        voffA[i] = Map::ATILE ? (unsigned)((C >> 5) * 8192 + R * 32 + (C & 31)) * 2u : (unsigned)(R * K + C) * 2u; voffB[i] = (unsigned)(Rb * K + C) * 2u; }
    const size_t kstep = (size_t)(BK * 2), kstepA = Map::ATILE ? (size_t)(256 * 64 * 2) : (size_t)(BK * 2);
    const unsigned ldsw = (unsigned)wid * 1024u;
    const int aoff = lds_byte(wr * 64 + fr, fq * 8), boff = lds_byte(wc * 32 + fr, fq * 8);
#define PG8_SA(b, h) (((b) * 2 + (h)) * HTB)
#define PG8_SB(b, h) ((4 + (b) * 2 + (h)) * HTB)
#define PG8_STAGE(bufoff, gbase, voff) do { _Pragma("unroll") for (int _i = 0; _i < 2; ++_i) \
        __builtin_amdgcn_global_load_lds((const unsigned*)((const char*)(gbase) + (voff)[_i]), (LAS unsigned*)(lds + (bufoff) + ldsw + _i * 8192), 16, 0, 0); } while (0)
#define PG8_LDA(dst, b, h) do { _Pragma("unroll") for (int m = 0; m < 4; ++m) _Pragma("unroll") for (int k = 0; k < 2; ++k) dst[m][k] = *(const LAS bf16x8*)(lds + PG8_SA(b, h) + aoff + m * 2048 + k * 1024); } while (0)
#define PG8_LDB(dst, b, h) do { _Pragma("unroll") for (int n = 0; n < 2; ++n) _Pragma("unroll") for (int k = 0; k < 2; ++k) dst[n][k] = *(const LAS bf16x8*)(lds + PG8_SB(b, h) + boff + n * 2048 + k * 1024); } while (0)
#define PG8_MMA(ai, bj, At, Bt) do { __builtin_amdgcn_s_setprio(1); _Pragma("unroll") for (int m = 0; m < 4; ++m) _Pragma("unroll") for (int n = 0; n < 2; ++n) _Pragma("unroll") for (int k = 0; k < 2; ++k) \
        acc[ai][bj][m][n] = __builtin_amdgcn_mfma_f32_16x16x32_bf16(Bt[n][k], At[m][k], acc[ai][bj][m][n], 0, 0, 0); __builtin_amdgcn_s_setprio(0); } while (0)
#define PG8_WAIT_V(n) asm volatile("s_waitcnt vmcnt(" #n ")" ::: "memory")
#define PG8_WAIT_L(n) asm volatile("s_waitcnt lgkmcnt(" #n ")" ::: "memory")
#define PG8_BAR __builtin_amdgcn_s_barrier()
#define PG8_SCHED __builtin_amdgcn_sched_barrier(0)
    Unit cur, nxt; int ui = 0; cur.idx = 0;
    if (!S.next(0, cur)) return;
    f32x4 acc[2][2][4][2];
#pragma unroll
    for (int a = 0; a < 2; ++a)
#pragma unroll
        for (int b = 0; b < 2; ++b)
#pragma unroll
            for (int m = 0; m < 4; ++m)
#pragma unroll
                for (int n = 0; n < 2; ++n) acc[a][b][m][n] = (f32x4){0.f, 0.f, 0.f, 0.f};
    bf16x8 At[4][2], B0[2][2], B1[2][2];
    const char* cA; const char* cB; size_t cAH, cBH;
    MPp.ptrs(cur, cA, cAH, cB, cBH);
    PG8_STAGE(PG8_SB(0, 0), cB, voffB); PG8_STAGE(PG8_SB(0, 1), cB + cBH, voffB); PG8_STAGE(PG8_SA(0, 0), cA, voffA); PG8_STAGE(PG8_SA(0, 1), cA + cAH, voffA);
    if (wr == 1) PG8_BAR;
    PG8_WAIT_V(2); PG8_BAR;
    PG8_STAGE(PG8_SB(1, 0), cB + kstep, voffB); PG8_STAGE(PG8_SA(1, 0), cA + kstepA, voffA); PG8_STAGE(PG8_SB(1, 1), cB + cBH + kstep, voffB);
    PG8_WAIT_V(6); PG8_BAR;
    for (;;) {
        const bool has_next = S.next(ui + 1, nxt); nxt.idx = ui + 1;
        const char* nA = cA; const char* nB = cB; size_t nAH = cAH, nBH = cBH;
        if (has_next) MPp.ptrs(nxt, nA, nAH, nB, nBH);
        for (int t = 0; t < nt; t += 2) {
            const bool last = (t == nt - 2);
            const char* a1 = cA + (size_t)(t + 1) * kstepA;
            const char* a2 = last ? nA : cA + (size_t)(t + 2) * kstepA; const char* b2 = last ? nB : cB + (size_t)(t + 2) * kstep;
            const size_t a2H = last ? nAH : cAH, b2H = last ? nBH : cBH;
            const char* a3 = a2 + kstepA; const char* b3 = b2 + kstep;
            PG8_LDB(B0, 0, 0); PG8_LDB(B1, 0, 1); PG8_SCHED; PG8_LDA(At, 0, 0); PG8_STAGE(PG8_SA(1, 1), a1 + cAH, voffA);
            PG8_WAIT_V(8); PG8_WAIT_L(0); PG8_BAR; PG8_MMA(0, 0, At, B0); PG8_MMA(0, 1, At, B1); PG8_BAR; PG8_SCHED;
            PG8_LDA(At, 0, 1); PG8_STAGE(PG8_SB(0, 0), b2, voffB); PG8_STAGE(PG8_SB(0, 1), b2 + b2H, voffB); PG8_STAGE(PG8_SA(0, 0), a2, voffA);
            PG8_WAIT_V(8); PG8_WAIT_L(0); PG8_BAR; PG8_MMA(1, 0, At, B0); PG8_MMA(1, 1, At, B1); PG8_BAR; PG8_SCHED;
            PG8_LDB(B0, 1, 0); PG8_LDB(B1, 1, 1); PG8_SCHED; PG8_LDA(At, 1, 0); PG8_STAGE(PG8_SA(0, 1), a2 + a2H, voffA);
            PG8_WAIT_V(8); PG8_WAIT_L(0); PG8_BAR; PG8_MMA(0, 0, At, B0); PG8_MMA(0, 1, At, B1); PG8_BAR; PG8_SCHED;
            PG8_LDA(At, 1, 1); PG8_STAGE(PG8_SB(1, 0), b3, voffB); PG8_STAGE(PG8_SB(1, 1), b3 + b2H, voffB); PG8_STAGE(PG8_SA(1, 0), a3, voffA);
            PG8_WAIT_V(8); PG8_WAIT_L(0); PG8_BAR; PG8_MMA(1, 0, At, B0); PG8_MMA(1, 1, At, B1); PG8_BAR; PG8_SCHED;
        }
        if (wr == 0) PG8_BAR;
        E(acc, cur, wr, wc, fr, fq);
        if (!has_next) break;
#pragma unroll
        for (int a = 0; a < 2; ++a)
#pragma unroll
            for (int b = 0; b < 2; ++b)
#pragma unroll
                for (int m = 0; m < 4; ++m)
#pragma unroll
                    for (int n = 0; n < 2; ++n) acc[a][b][m][n] = (f32x4){0.f, 0.f, 0.f, 0.f};
        cur = nxt; cA = nA; cB = nB; cAH = nAH; cBH = nBH; ++ui;
        if (wr == 1) PG8_BAR;
    }
    PG8_WAIT_V(0);
    PG8_BAR;
#undef PG8_SA
#undef PG8_SB
#undef PG8_STAGE
#undef PG8_LDA
#undef PG8_LDB
#undef PG8_MMA
#undef PG8_WAIT_V
#undef PG8_WAIT_L
#undef PG8_BAR
#undef PG8_SCHED
}

typedef const f32x4 (&AccRef)[2][2][4][2];
struct EpiInProj {
    bf16* QKVU; const float* rinv0; const float* qn; const float* kn; float* out;
    __device__ __forceinline__ void operator()(AccRef acc, const Unit& u, int wr, int wc, int fr, int fq) const {
        asm volatile("" : "+v"(fr), "+v"(fq));
        const int pn = u.pn;
        const int cb = 256 * pn + 64 * wc;
        const int kind = pn < 2 ? 0 : (pn == 2 ? (wc < 2 ? 1 : 2) : 3);
        const int g = wc & 1;
        f32x4 gv[2][2];
#pragma unroll
        for (int bj = 0; bj < 2; ++bj)
#pragma unroll
            for (int n = 0; n < 2; ++n) gv[bj][n] = (f32x4){1.f, 1.f, 1.f, 1.f};
        if (kind <= 1) { const float* gp = kind == 0 ? qn : kn; const float sc = kind == 0 ? QSCALE : 1.f;
#pragma unroll
            for (int bj = 0; bj < 2; ++bj)
#pragma unroll
                for (int n = 0; n < 2; ++n) gv[bj][n] = *(const f32x4*)(gp + 32 * bj + 8 * fq + 4 * n) * sc; }
        float rvs[2][4];
#pragma unroll
        for (int ai = 0; ai < 2; ++ai)
#pragma unroll
            for (int m = 0; m < 4; ++m) rvs[ai][m] = rinv0[256 * u.pm + 128 * ai + 64 * wr + 16 * m + fr];
#pragma unroll
        for (int ai = 0; ai < 2; ++ai) {
#pragma unroll
            for (int m = 0; m < 4; ++m) {
                const int rt = 128 * ai + 64 * wr + 16 * m + fr; const int r = 256 * u.pm + rt;
                const float rv = rvs[ai][m];
                f32x4 v[2][2];
#pragma unroll
                for (int bj = 0; bj < 2; ++bj)
#pragma unroll
                    for (int n = 0; n < 2; ++n) v[bj][n] = acc[ai][bj][m][n] * rv;
                if (kind <= 1) {
                    float ss = (sq4(v[0][0]) + sq4(v[0][1])) + (sq4(v[1][0]) + sq4(v[1][1]));
                    ss += __shfl_xor(ss, 16); ss += __shfl_xor(ss, 32);
                    const float rn = rsqrtf(ss * (1.0f / 64.0f) + EPS);
#pragma unroll
                    for (int bj = 0; bj < 2; ++bj)
#pragma unroll
                        for (int n = 0; n < 2; ++n) v[bj][n] = v[bj][n] * rn * gv[bj][n];
                }
                bf16* rowp = QKVU + (size_t)r * EVIN + cb + 8 * fq;
#pragma unroll
                for (int bj = 0; bj < 2; ++bj) *(u32x4*)(rowp + 32 * bj) = pk8(v[bj][0], v[bj][1]);
                if (kind == 1 || kind == 2) {
                    float* dst = nullptr;
                    if (ai == 1 && (u.pm & 63) == 63) { const int bb = u.pm >> 6, j = rt - 128; dst = out + (kind == 1 ? O_KP : O_VP) + ((size_t)(bb * 128 + j) * 2 + g) * 64; }
                    if (dst) {
#pragma unroll
                        for (int bj = 0; bj < 2; ++bj)
#pragma unroll
                            for (int n = 0; n < 2; ++n) *(f32x4*)(dst + 32 * bj + 8 * fq + 4 * n) = v[bj][n]; }
                } else if (kind == 3) {
                    const int ucol = 256 * (pn - 3) + 64 * wc + 8 * fq;
                    float* dst = nullptr;
                    if (ai == 1 && (u.pm & 63) == 63 && rt >= 241) { const int bb = u.pm >> 6; dst = out + O_PP + (size_t)(bb * 15 + rt - 241) * 512 + ucol; }
                    if (dst) {
#pragma unroll
                        for (int bj = 0; bj < 2; ++bj)
#pragma unroll
                            for (int n = 0; n < 2; ++n) *(f32x4*)(dst + 32 * bj + 4 * n) = v[bj][n]; }
                }
            }
        }
    }
};
__device__ __forceinline__ f32x4 bf4_lo(u32x4 w) { return (f32x4){bf_lo(w.x), bf_hi(w.x), bf_lo(w.y), bf_hi(w.y)}; }
__device__ __forceinline__ f32x4 bf4_hi(u32x4 w) { return (f32x4){bf_lo(w.z), bf_hi(w.z), bf_lo(w.w), bf_hi(w.w)}; }
template <int MODE> struct EpiResid {
    const float* xin_f; bf16* XR; float* SS; float* yout;
    __device__ __forceinline__ void operator()(AccRef acc, const Unit& u, int wr, int wc, int fr, int fq) const {
        asm volatile("" : "+v"(fr), "+v"(fq));
        const int c0 = 256 * u.pn + 64 * wc + 8 * fq;
        const size_t rbase = (size_t)256 * u.pm + 64 * wr + fr;
        if (MODE == 0) {
#pragma unroll
            for (int ai = 0; ai < 2; ++ai) {
                f32x4 xr[4][2][2];
#pragma unroll
                for (int m = 0; m < 4; ++m)
#pragma unroll
                    for (int bj = 0; bj < 2; ++bj) { const float* p = xin_f + (rbase + 128 * ai + 16 * m) * DM + c0 + 32 * bj; xr[m][bj][0] = *(const f32x4*)p; xr[m][bj][1] = *(const f32x4*)(p + 4); }
#pragma unroll
                for (int m = 0; m < 4; ++m) { const size_t r = rbase + 128 * ai + 16 * m; float ss = 0.f;
#pragma unroll
                    for (int bj = 0; bj < 2; ++bj) { const f32x4 v0 = acc[ai][bj][m][0] + xr[m][bj][0], v1 = acc[ai][bj][m][1] + xr[m][bj][1]; ss += sq4(v0) + sq4(v1);
                        *(u32x4*)(XR + r * DM + c0 + 32 * bj) = pk8(v0, v1); }
                    ss += __shfl_xor(ss, 16); ss += __shfl_xor(ss, 32); if (fq == 0) SS[r * 16 + 4 * u.pn + wc] = ss; }
            }
        } else {
            u32x4 xr[2][4][2];
#pragma unroll
            for (int ai = 0; ai < 2; ++ai)
#pragma unroll
                for (int m = 0; m < 4; ++m)
#pragma unroll
                    for (int bj = 0; bj < 2; ++bj) xr[ai][m][bj] = *(const u32x4*)(XR + (rbase + 128 * ai + 16 * m) * DM + c0 + 32 * bj);
#pragma unroll
            for (int ai = 0; ai < 2; ++ai)
#pragma unroll
                for (int m = 0; m < 4; ++m) { const size_t r = rbase + 128 * ai + 16 * m; float ss = 0.f;
#pragma unroll
                    for (int bj = 0; bj < 2; ++bj) { const f32x4 v0 = acc[ai][bj][m][0] + bf4_lo(xr[ai][m][bj]), v1 = acc[ai][bj][m][1] + bf4_hi(xr[ai][m][bj]);
                        if (MODE == 1) { ss += sq4(v0) + sq4(v1); *(u32x4*)(XR + r * DM + c0 + 32 * bj) = pk8(v0, v1); }
                        else { float* yp = yout + r * DM + c0 + 32 * bj; *(f32x4*)yp = v0; *(f32x4*)(yp + 4) = v1; } }
                    if (MODE == 1) { ss += __shfl_xor(ss, 16); ss += __shfl_xor(ss, 32); if (fq == 0) SS[r * 16 + 4 * u.pn + wc] = ss; } }
        }
    }
};
__device__ __forceinline__ float row_rinv(const float* SS, size_t r, int fq) {
    const f32x4 s4 = *(const f32x4*)(SS + r * 16 + 4 * fq); float s = (s4[0] + s4[1]) + (s4[2] + s4[3]);
    s += __shfl_xor(s, 16); s += __shfl_xor(s, 32);
    return rsqrtf(s * (1.0f / 1024.0f) + EPS);
}
__device__ __forceinline__ void rows_rinv(const float* SS, size_t rbase, int fq, float (&rv)[2][4]) {
    f32x4 s4[2][4];
#pragma unroll
    for (int ai = 0; ai < 2; ++ai)
#pragma unroll
        for (int m = 0; m < 4; ++m) s4[ai][m] = *(const f32x4*)(SS + (rbase + 128 * ai + 16 * m) * 16 + 4 * fq);
#pragma unroll
    for (int ai = 0; ai < 2; ++ai)
#pragma unroll
        for (int m = 0; m < 4; ++m) { float t = (s4[ai][m][0] + s4[ai][m][1]) + (s4[ai][m][2] + s4[ai][m][3]); t += __shfl_xor(t, 16); t += __shfl_xor(t, 32); rv[ai][m] = rsqrtf(t * (1.0f / 1024.0f) + EPS); }
}
struct EpiUp {
    bf16* H; const LAS float* rvt; const float* SS;
    __device__ __forceinline__ void operator()(AccRef acc, const Unit& u, int wr, int wc, int fr, int fq) const {
        asm volatile("" : "+v"(fr), "+v"(fq));
        const int c0 = 256 * u.pn + 64 * wc + 8 * fq;
        float rvs[2][4];
        if (u.idx < RVT_UNITS_) {
#pragma unroll
            for (int ai = 0; ai < 2; ++ai)
#pragma unroll
                for (int m = 0; m < 4; ++m) rvs[ai][m] = rvt[u.idx * 256 + 128 * ai + 64 * wr + 16 * m + fr];
        } else rows_rinv(SS, (size_t)256 * u.pm + 64 * wr + fr, fq, rvs);
#pragma unroll
        for (int ai = 0; ai < 2; ++ai) {
#pragma unroll
            for (int m = 0; m < 4; ++m) {
                const size_t r = (size_t)256 * u.pm + 128 * ai + 64 * wr + 16 * m + fr;
                const float rv = rvs[ai][m];
#pragma unroll
                for (int bj = 0; bj < 2; ++bj) {
                    f32x4 v0 = acc[ai][bj][m][0] * rv, v1 = acc[ai][bj][m][1] * rv;
#pragma unroll
                    for (int i = 0; i < 4; ++i) { const float a = fmaxf(v0[i], 0.f), b = fmaxf(v1[i], 0.f); v0[i] = a * a; v1[i] = b * b; }
                    __builtin_nontemporal_store(pk8(v0, v1), (u32x4*)(H + (size_t)u.pm * 256 * DFF + (size_t)(8 * u.pn + 2 * wc + bj) * 8192 + (size_t)(128 * ai + 64 * wr + 16 * m + fr) * 32 + 8 * fq));
                }
            }
        }
    }
};
struct EpiConvE {
    bf16* BE; const LAS float* rvt; const float* SS; float* out;
    __device__ __forceinline__ void operator()(AccRef acc, const Unit& u, int wr, int wc, int fr, int fq) const {
        asm volatile("" : "+v"(fr), "+v"(fq));
        float rvs[2][4];
        if (u.idx < RVT_UNITS_) {
#pragma unroll
            for (int ai = 0; ai < 2; ++ai)
#pragma unroll
                for (int m = 0; m < 4; ++m) rvs[ai][m] = rvt[u.idx * 256 + 128 * ai + 64 * wr + 16 * m + fr];
        } else rows_rinv(SS, (size_t)256 * u.pm + 64 * wr + fr, fq, rvs);
        const int ch0 = 128 * u.pn + 32 * wc + 8 * fq;
#pragma unroll
        for (int ai = 0; ai < 2; ++ai) {
#pragma unroll
            for (int m = 0; m < 4; ++m) {
                const int rt = 128 * ai + 64 * wr + 16 * m + fr; const size_t r = (size_t)256 * u.pm + rt;
                const float rv = rvs[ai][m];
                const f32x4 e0 = (acc[ai][0][m][0] * rv) * (acc[ai][1][m][0] * rv), e1 = (acc[ai][0][m][1] * rv) * (acc[ai][1][m][1] * rv);
                *(u32x4*)(BE + be_off(r, 1024 + ch0)) = pk8(e0, e1);
                float* dst = nullptr;
                if (ai == 1 && (u.pm & 63) == 63 && rt >= 254) { const int bb = u.pm >> 6; dst = out + O_CP + (size_t)(bb * 2 + rt - 254) * 1024 + ch0; }
                if (dst) { *(f32x4*)dst = e0; *(f32x4*)(dst + 4) = e1; }
            }
        }
    }
};
struct EpiConvB {
    unsigned char* ws; const float* cw; const LAS float* rvt;
    __device__ __forceinline__ void operator()(AccRef acc, const Unit& u, int wr, int wc, int fr, int fq) const {
        asm volatile("" : "+v"(fr), "+v"(fq));
        const bf16* BE = (const bf16*)(ws + WS_H_OFF); bf16* S0 = (bf16*)(ws + WS_S0_OFF);
        const LAS float* rvp = rvt + (u.idx < RVT_UNITS_ ? u.idx : 0) * 256 + 64 * wr + fr;
        const unsigned rb = 256u * (unsigned)u.pm + 64u * (unsigned)wr + (unsigned)fr;
#pragma unroll
        for (int bj = 0; bj < 2; ++bj) {
            const int ch0 = 256 * u.pn + 128 * bj + 32 * wc + 8 * fq;
            const u32x4 W0 = pk8(*(const f32x4*)(cw + ch0), *(const f32x4*)(cw + ch0 + 4)), W1 = pk8(*(const f32x4*)(cw + DM + ch0), *(const f32x4*)(cw + DM + ch0 + 4)),
                        W2 = pk8(*(const f32x4*)(cw + 2 * DM + ch0), *(const f32x4*)(cw + 2 * DM + ch0 + 4));
            u32x4 ec[3], en[3];
#define ECB_OFF(r_) ((((r_) >> 8) * (unsigned)(256 * 2048) + (unsigned)((1024 + ch0) >> 5) * 8192u + ((r_) & 255u) * 32u + (unsigned)(ch0 & 31)) * 2u)
#define ECB_LD(e_, k_) { const unsigned r_ = rb + 128u * ((k_) >> 2) + 16u * ((k_) & 3); const unsigned pos_ = r_ & (unsigned)(SEQ - 1); \
                e_[0] = *(const u32x4*)((const char*)BE + ECB_OFF(r_)); \
                { const unsigned r1_ = pos_ >= 1u ? r_ - 1u : r_; e_[1] = *(const u32x4*)((const char*)BE + ECB_OFF(r1_)); } \
                { const unsigned r2_ = pos_ >= 2u ? r_ - 2u : r_; e_[2] = *(const u32x4*)((const char*)BE + ECB_OFF(r2_)); } }
            ECB_LD(ec, 0)
#pragma unroll
            for (int k = 0; k < 8; ++k) {
                if (k + 1 < 8) ECB_LD(en, k + 1)
                const int ai = k >> 2, m = k & 3; const unsigned r = rb + 128u * ai + 16u * m; const unsigned pos = r & (unsigned)(SEQ - 1);
                const f32x4 z4 = {0.f, 0.f, 0.f, 0.f};
                const f32x4 e0a = bf4_lo(ec[0]), e0b = bf4_hi(ec[0]);
                const f32x4 e1a = pos >= 1u ? bf4_lo(ec[1]) : z4, e1b = pos >= 1u ? bf4_hi(ec[1]) : z4;
                const f32x4 e2a = pos >= 2u ? bf4_lo(ec[2]) : z4, e2b = pos >= 2u ? bf4_hi(ec[2]) : z4;
                const f32x4 ya = bf4_lo(W0) * e2a + bf4_lo(W1) * e1a + bf4_lo(W2) * e0a, yb = bf4_hi(W0) * e2b + bf4_hi(W1) * e1b + bf4_hi(W2) * e0b;
                const float rv = (u.idx < RVT_UNITS_) ? rvp[128 * ai + 16 * m] : row_rinv((const float*)(ws + WS_SS_OFF), (size_t)r, fq);
                *(u32x4*)((char*)S0 + (r * (unsigned)DM + (unsigned)ch0) * 2u) = pk8((acc[ai][bj][m][0] * rv) * ya, (acc[ai][bj][m][1] * rv) * yb);
#pragma unroll
                for (int q = 0; q < 3; ++q) ec[q] = en[q];
            }
#undef ECB_LD
#undef ECB_OFF
        }
    }
};
}


template <int K, int NF, int KS, class BRow, class Epi>
__device__ __forceinline__ void sample_gemm(LAS unsigned char* lds, const bf16* As, const int n_items, const int first, const int stride, const BRow& brow, const Epi& E, int lane, const int wave) {
    asm volatile("" : "+v"(lane));
    const int fr = lane & 15, fq = lane >> 4;
    constexpr int KQ = K / KS, UPI = (KS == 4) ? 4 : 8;
    for (int un = first; un < n_items * UPI; un += stride) {
        const int item = (KS == 4) ? (un >> 2) : (un >> 3), rg = (KS == 4) ? (un & 3) : ((un >> 1) & 3), mf = (KS == 4) ? (wave & 1) : (un & 1), kq = (KS == 4) ? (wave >> 1) : wave, mfs = (KS == 4) ? mf : 0;
        const int row = 32 * rg + 16 * mf + fr;
        const bf16* ap = As + (size_t)row * K + kq * KQ + 8 * fq;
        const bf16* bp[NF];
#pragma unroll
        for (int nf = 0; nf < NF; ++nf) bp[nf] = brow(item, nf) + (size_t)fr * K + kq * KQ + 8 * fq;
        f32x4 acc[NF];
#pragma unroll
        for (int nf = 0; nf < NF; ++nf) acc[nf] = (f32x4){0.f, 0.f, 0.f, 0.f};
        typename Epi::Pre pre = {};
        if (kq == 0) pre = E.pre(item, row, fr, fq);
#pragma unroll 8
        for (int ks = 0; ks < KQ / 32; ++ks) {
            const bf16x8 a = *(const bf16x8*)(ap + 32 * ks);
#pragma unroll
            for (int nf = 0; nf < NF; ++nf) { const bf16x8 b = *(const bf16x8*)(bp[nf] + 32 * ks); acc[nf] = __builtin_amdgcn_mfma_f32_16x16x32_bf16(b, a, acc[nf], 0, 0, 0); }
        }
        LAS f32x4* red = (LAS f32x4*)lds;
        if (kq > 0) {
#pragma unroll
            for (int nf = 0; nf < NF; ++nf) red[(((kq - 1) * 2 + mfs) * 64 + lane) * NF + nf] = acc[nf]; }
        __syncthreads();
        if (kq == 0) {
#pragma unroll
            for (int q = 0; q < KS - 1; ++q)
#pragma unroll
                for (int nf = 0; nf < NF; ++nf) acc[nf] += red[((q * 2 + mfs) * 64 + lane) * NF + nf];
            E(item, row, fr, fq, acc, pre);
        }
        __syncthreads();
    }
}
struct BRowPlain { const bf16* Bt; int K, NF; __device__ __forceinline__ const bf16* operator()(int item, int nf) const { return Bt + (size_t)(item * NF + nf) * 16 * K; } };
struct BRowConvIn { const bf16* Bt; __device__ __forceinline__ const bf16* operator()(int item, int nf) const { return Bt + (size_t)(1024 * nf + 16 * item) * DM; } };
struct SEpiInProj {
    bf16* QKVU; const float* rinv0; const float* qn; const float* kn; float* out;
    struct Pre { float rv; };
    __device__ __forceinline__ Pre pre(int item, int row, int fr, int fq) const { Pre p; p.rv = rinv0[(size_t)MPR + row]; return p; }
    __device__ __forceinline__ void operator()(int item, int row, int fr, int fq, f32x4 (&acc)[4], const Pre& pr) const {
        const int kind = item < 8 ? 0 : (item < 10 ? 1 : (item < 12 ? 2 : 3)), g = item & 1;
        const size_t r = (size_t)MPR + row; const float rv = pr.rv;
        f32x4 v[4];
#pragma unroll
        for (int nf = 0; nf < 4; ++nf) v[nf] = acc[nf] * rv;
        if (kind <= 1) {
            float ss = (sq4(v[0]) + sq4(v[1])) + (sq4(v[2]) + sq4(v[3]));
            ss += __shfl_xor(ss, 16); ss += __shfl_xor(ss, 32);
            const float rn = rsqrtf(ss * (1.0f / 64.0f) + EPS) * (kind == 0 ? QSCALE : 1.f); const float* gp = (kind == 0 ? qn : kn) + 4 * fq;
#pragma unroll
            for (int nf = 0; nf < 4; ++nf) v[nf] = v[nf] * rn * *(const f32x4*)(gp + 16 * nf);
        }
        bf16* rowp = QKVU + r * EVIN + 64 * item + 4 * fq;
#pragma unroll
        for (int nf = 0; nf < 4; ++nf) { u32x2 w; w.x = pk2(v[nf][0], v[nf][1]); w.y = pk2(v[nf][2], v[nf][3]); *(u32x2*)(rowp + 16 * nf) = w; }
        const int b = row >> 4, i16 = row & 15;
        float* dst = nullptr;
        if (kind == 1 || kind == 2) dst = out + (kind == 1 ? O_KS : O_VS) + ((size_t)(b * 128 + 112 + i16) * 2 + g) * 64 + 4 * fq;
        else if (kind == 3 && i16 >= 1) dst = out + O_PS + (size_t)(b * 15 + i16 - 1) * 512 + 64 * (item - 12) + 4 * fq;
        if (dst) {
#pragma unroll
            for (int nf = 0; nf < 4; ++nf) *(f32x4*)(dst + 16 * nf) = v[nf]; }
    }
};
template <int MODE, int NF> struct SEpiResid {
    const float* xin_f; bf16* XR; float* SSS; float* yout;
    struct Pre { u32x2 w[NF]; };
    __device__ __forceinline__ Pre pre(int item, int row, int fr, int fq) const { Pre p;
#pragma unroll
        for (int nf = 0; nf < NF; ++nf) p.w[nf] = *(const u32x2*)(XR + ((size_t)MPR + row) * DM + 16 * NF * item + 4 * fq + 16 * nf);
        return p; }
    __device__ __forceinline__ void operator()(int item, int row, int fr, int fq, f32x4 (&acc)[NF], const Pre& pr) const {
        const size_t r = (size_t)MPR + row; const int c = 16 * NF * item + 4 * fq;
        float ss = 0.f;
#pragma unroll
        for (int nf = 0; nf < NF; ++nf) {
            f32x4 x;
            if (MODE == 0) x = *(const f32x4*)(xin_f + (size_t)row * DM + c + 16 * nf);
            else { const u32x2 w = pr.w[nf]; x[0] = bf_lo(w.x); x[1] = bf_hi(w.x); x[2] = bf_lo(w.y); x[3] = bf_hi(w.y); }
            const f32x4 v = acc[nf] + x;
            if (MODE == 2) *(f32x4*)(yout + (size_t)row * DM + c + 16 * nf) = v;
            else { ss += sq4(v); u32x2 w; w.x = pk2(v[0], v[1]); w.y = pk2(v[2], v[3]); *(u32x2*)(XR + r * DM + c + 16 * nf) = w; }
        }
        if (MODE != 2) { static_assert(MODE == 2 || NF == 2, "32-slot layout"); ss += __shfl_xor(ss, 16); ss += __shfl_xor(ss, 32); if (fq == 0) SSS[row * 32 + item] = ss; }
    }
};
struct SRowPre { f32x4 a, b; };
__device__ __forceinline__ SRowPre srow_pre(const float* SSS, int row, int fq) { SRowPre p; p.a = *(const f32x4*)(SSS + row * 32 + 8 * fq); p.b = *(const f32x4*)(SSS + row * 32 + 8 * fq + 4); return p; }
__device__ __forceinline__ float srow_rinv(const SRowPre& p) {
    float s = ((p.a[0] + p.a[1]) + (p.a[2] + p.a[3])) + ((p.b[0] + p.b[1]) + (p.b[2] + p.b[3]));
    s += __shfl_xor(s, 16); s += __shfl_xor(s, 32);
    return rsqrtf(s * (1.0f / 1024.0f) + EPS);
}
struct SEpiUp {
    bf16* H; const float* SS;
    typedef SRowPre Pre;
    __device__ __forceinline__ Pre pre(int item, int row, int fr, int fq) const { return srow_pre(SS, row, fq); }
    __device__ __forceinline__ void operator()(int item, int row, int fr, int fq, f32x4 (&acc)[4], const Pre& pr) const {
        const size_t r = (size_t)MPR + row; const float rv = srow_rinv(pr);
#pragma unroll
        for (int nf = 0; nf < 4; ++nf) { f32x4 v = acc[nf] * rv;
#pragma unroll
            for (int i = 0; i < 4; ++i) { const float a = fmaxf(v[i], 0.f); v[i] = a * a; }
            u32x2 w; w.x = pk2(v[0], v[1]); w.y = pk2(v[2], v[3]); *(u32x2*)(H + r * DFF + 64 * item + 16 * nf + 4 * fq) = w; }
    }
};
struct SEpiConvIn {
    bf16* BE; const float* SS; float* out;
    typedef SRowPre Pre;
    __device__ __forceinline__ Pre pre(int item, int row, int fr, int fq) const { return srow_pre(SS, row, fq); }
    __device__ __forceinline__ void operator()(int item, int row, int fr, int fq, f32x4 (&acc)[3], const Pre& pr) const {
        const size_t r = (size_t)MPR + row; const float rv = srow_rinv(pr);
        const int ch0 = 16 * item + 4 * fq;
        { const f32x4 v = acc[0] * rv; u32x2 w; w.x = pk2(v[0], v[1]); w.y = pk2(v[2], v[3]); *(u32x2*)(BE + r * 2048 + ch0) = w; }
        const f32x4 e = (acc[1] * rv) * (acc[2] * rv);
        u32x2 w; w.x = pk2(e[0], e[1]); w.y = pk2(e[2], e[3]); *(u32x2*)(BE + r * 2048 + 1024 + ch0) = w;
        const int b = row >> 4, i16 = row & 15;
        if (i16 >= 14) *(f32x4*)(out + O_CS + (size_t)(b * 2 + i16 - 14) * 1024 + ch0) = e;
    }
};

#define XB_TMO      128
#define XB_XCNT(j)  (256  + 64 * (j))
#define XB_XSUB(j)  (1280 + 64 * (j))
#define XB_XGEN(j)  (2304 + 64 * (j))
#define XB_TOP      3328
#define XB_TOPGEN   3392
#define XCD_BAR_WORDS 3456
#define XB_SPIN_CAP (1u << 18)
__device__ __forceinline__ unsigned xb_ld(unsigned* p)              { return __hip_atomic_load(p, __ATOMIC_RELAXED, __HIP_MEMORY_SCOPE_AGENT); }
__device__ __forceinline__ unsigned xb_add(unsigned* p, unsigned v) { return __hip_atomic_fetch_add(p, v, __ATOMIC_RELAXED, __HIP_MEMORY_SCOPE_AGENT); }
__device__ __forceinline__ unsigned xb_xcc_id() { return (unsigned)__builtin_amdgcn_s_getreg((3 << 11) | 20) & 0xFu; }
#define XB_SPIN(cond, bar) do { unsigned _sp = 0; while (cond) { __builtin_amdgcn_s_sleep(1); \
    if ((++_sp & 255u) == 0u) { if (xb_ld(&(bar)[XB_TMO])) break; if (_sp > XB_SPIN_CAP) { atomicAdd(&(bar)[XB_TMO], 1u); break; } } } } while (0)
struct XcdBarrier { unsigned* bar; unsigned x; volatile LAS unsigned* st; };
__device__ __forceinline__ XcdBarrier xcd_barrier_post(unsigned* bar, volatile LAS unsigned* st) {
    XcdBarrier b; b.bar = bar; b.x = xb_xcc_id(); b.st = st;
    if (threadIdx.x == 0) (void)xb_add(&bar[XB_XCNT(b.x)], 1u);
    return b;
}
__device__ __forceinline__ void xcd_barrier_complete(unsigned* bar, unsigned x, unsigned& nloc, unsigned& nx) {
    const unsigned G = gridDim.x * gridDim.y * gridDim.z;
    unsigned sum, cnt, mine, sp = 0u;
    for (;;) {
        sum = 0u; cnt = 0u; mine = 0u;
#pragma unroll
        for (unsigned j = 0; j < 16; ++j) { const unsigned c = xb_ld(&bar[XB_XCNT(j)]); sum += c; cnt += (c > 0u) ? 1u : 0u; mine = (j == x) ? c : mine; }
        if (sum == G) break;
        __builtin_amdgcn_s_sleep(1);
        if ((++sp & 255u) == 0u) { if (xb_ld(&bar[XB_TMO])) break; if (sp > XB_SPIN_CAP) { atomicAdd(&bar[XB_TMO], 1u); break; } }
    }
    nloc = mine > 0u ? mine : 1u; nx = cnt > 0u ? cnt : 1u;
}
__device__ __forceinline__ void xcd_barrier(const XcdBarrier& b) {
    asm volatile("s_waitcnt vmcnt(0)" ::: "memory");
    __syncthreads();
    if (threadIdx.x == 0) {
        unsigned* bar = b.bar; asm volatile("" : "+s"(bar));
        __builtin_amdgcn_s_waitcnt(0);
        unsigned nloc = b.st[0], nx = b.st[1];
        if (nloc == 0u) { xcd_barrier_complete(bar, b.x, nloc, nx); b.st[0] = nloc; b.st[1] = nx; }
        const unsigned old = xb_add(&bar[XB_XSUB(b.x)], 1u);
        const unsigned gen = old / nloc;
        if (old + 1u == (gen + 1u) * nloc) {
            __builtin_amdgcn_fence(__ATOMIC_RELEASE, "agent");
            asm volatile("s_waitcnt vmcnt(0)" ::: "memory");
            const unsigned og = xb_add(&bar[XB_TOP], 1u);
            const unsigned tg = og / nx;
            __builtin_amdgcn_fence(__ATOMIC_ACQUIRE, "agent");
            if (og + 1u == (tg + 1u) * nx) xb_add(&bar[XB_TOPGEN], 1u);
            else XB_SPIN(xb_ld(&bar[XB_TOPGEN]) == tg, bar);
            xb_add(&bar[XB_XGEN(b.x)], 1u);
            asm volatile("s_waitcnt vmcnt(0)" ::: "memory");
        } else {
            __builtin_amdgcn_fence(__ATOMIC_ACQUIRE, "agent");
            XB_SPIN(xb_ld(&bar[XB_XGEN(b.x)]) == gen, bar);
            asm volatile("s_waitcnt vmcnt(0)" ::: "memory");
        }
    }
    __syncthreads();
}

constexpr int RING_OFF = 0, RING_BYTES = 131072;
constexpr int LDSCTL_OFF = RING_BYTES, MISC_OFF = LDSCTL_OFF + 320;
constexpr int RVT_OFF = LDSCTL_OFF + 512, RVT_UNITS = pg8::RVT_UNITS_;
constexpr int LDS_BYTES = 147456;
constexpr int AT_KL = 0, AT_VL = 24576, AT_BIAS = 49152, AT_WSF = 57344, AT_OST = 59392;
constexpr int PL_D = 0, PL_W = 32768;

__device__ __forceinline__ void build_row_scales(LAS unsigned char* lds, const pg8::StaticOrder& S, const float* SS) {
    int tid = threadIdx.x; asm volatile("" : "+v"(tid));
    LAS float* tab = (LAS float*)(lds + RVT_OFF);
    const int half = tid >> 8, t = tid & 255;
    for (int i0 = 0; i0 < RVT_UNITS; i0 += 4) {
        f32x4 p[2][4]; bool ok[2];
#pragma unroll
        for (int j = 0; j < 2; ++j) { pg8::Unit u; ok[j] = S.next(i0 + 2 * j + half, u); const size_t r = ok[j] ? (size_t)256 * u.pm + t : 0;
#pragma unroll
            for (int q = 0; q < 4; ++q) p[j][q] = *(const f32x4*)(SS + r * 16 + 4 * q); }
#pragma unroll
        for (int j = 0; j < 2; ++j) if (ok[j]) { const f32x4 a = (p[j][0] + p[j][1]) + (p[j][2] + p[j][3]); tab[(i0 + 2 * j + half) * 256 + t] = rsqrtf(((a[0] + a[1]) + (a[2] + a[3])) * (1.0f / 1024.0f) + EPS); }
        pg8::Unit u2; if (!S.next(i0 + 4, u2)) break;
    }
    __syncthreads();
}

template <bool GAIN>
__device__ __forceinline__ void transpose_item(const float* W, int K, int N, bf16* WT, const float* gain, LAS float* scr, int item, int lane) {
    const int nblk = N / 32, kb = item / nblk, nb = item % nblk, k0 = 64 * kb, n0 = 32 * nb;
    float wv[32];
    const float* wp = W + (size_t)(k0 + (lane >> 5)) * N + n0 + (lane & 31);
#pragma unroll
    for (int i = 0; i < 32; ++i) wv[i] = wp[(size_t)(2 * i) * N];
    float gl = 1.f; if (GAIN) gl = gain[k0 + lane];
#pragma unroll
    for (int i = 0; i < 32; ++i) { const int kk = 2 * i + (lane >> 5); const float gk = GAIN ? __shfl(gl, kk) : 1.f; scr[kk * 33 + (lane & 31)] = wv[i] * gk; }
    LDS_WAIT(); asm volatile("" ::: "memory");
    const int c = lane & 7;
#pragma unroll
    for (int j = 0; j < 4; ++j) { const int n = (lane >> 3) + 8 * j; const LAS float* s = scr + (8 * c) * 33 + n;
        u32x4 o; o.x = pk2(s[0 * 33], s[1 * 33]); o.y = pk2(s[2 * 33], s[3 * 33]); o.z = pk2(s[4 * 33], s[5 * 33]); o.w = pk2(s[6 * 33], s[7 * 33]);
        *(u32x4*)(WT + (size_t)(n0 + n) * K + k0 + 8 * c) = o; }
    LDS_WAIT(); asm volatile("" ::: "memory");
}

__device__ __forceinline__ int crow(int r, int hi) { return (r & 3) + 8 * (r >> 2) + 4 * hi; }
__device__ __forceinline__ void pv64(f32x16* o, int vb, bf16x8 pa0, bf16x8 pa1, bf16x8 pa2, bf16x8 pa3) {
#pragma unroll
    for (int d0 = 0; d0 < 2; ++d0) { s16x4 lo[4], hi[4];
#pragma unroll
        for (int ks = 0; ks < 4; ++ks) {
            asm volatile("ds_read_b64_tr_b16 %0,%1 offset:%c2" : "=&v"(lo[ks]) : "v"(vb), "i"(d0 * 4096 + ks * 1024) : "memory");
            asm volatile("ds_read_b64_tr_b16 %0,%1 offset:%c2" : "=&v"(hi[ks]) : "v"(vb), "i"(d0 * 4096 + ks * 1024 + 512) : "memory"); }
        asm volatile("s_waitcnt lgkmcnt(0)" ::: "memory"); __builtin_amdgcn_sched_barrier(0);
#define PK(k) (bf16x8){lo[k][0], lo[k][1], lo[k][2], lo[k][3], hi[k][0], hi[k][1], hi[k][2], hi[k][3]}
        o[d0] = __builtin_amdgcn_mfma_f32_32x32x16_bf16(pa0, PK(0), o[d0], 0, 0, 0);
        o[d0] = __builtin_amdgcn_mfma_f32_32x32x16_bf16(pa1, PK(1), o[d0], 0, 0, 0);
        o[d0] = __builtin_amdgcn_mfma_f32_32x32x16_bf16(pa2, PK(2), o[d0], 0, 0, 0);
        o[d0] = __builtin_amdgcn_mfma_f32_32x32x16_bf16(pa3, PK(3), o[d0], 0, 0, 0);
#undef PK
    }
}
__device__ __forceinline__ void attn_unit(LAS unsigned char* lds, const bf16* QKVU, bf16* MIX, const float* cache_k, const float* cache_v, const float* sinks,
                                          const int samp, const int b, const int c, const int g, const int wid) {
    int tid = threadIdx.x; asm volatile("" : "+v"(tid)); const int lane = tid & 63;
    LAS unsigned char* kl = lds + AT_KL; LAS unsigned char* vl = lds + AT_VL;
    u32x4 kvr[3], vvr[3];
    if (!samp) {
#pragma unroll
        for (int i = 0; i < 3; ++i) {
            const int p = tid + 512 * i, key = p >> 3, ch = p & 7;
            long t = 64 * (c - 2) + key; if (t < 0) t = 0;
            const bf16* rowp = QKVU + ((size_t)b * SEQ + (size_t)t) * EVIN;
            kvr[i] = *(const u32x4*)(rowp + 512 + 64 * g + 8 * ch); vvr[i] = *(const u32x4*)(rowp + 640 + 64 * g + 8 * ch);
        }
    } else {
        f32x4 ck[2][2], cv[2][2];
#pragma unroll
        for (int i = 0; i < 2; ++i) { const int p = tid + 512 * i, key = p >> 3, ch = p & 7; const size_t o = ((size_t)(b * 128 + key) * 2 + g) * 64 + 8 * ch;
            ck[i][0] = *(const f32x4*)(cache_k + o); ck[i][1] = *(const f32x4*)(cache_k + o + 4); cv[i][0] = *(const f32x4*)(cache_v + o); cv[i][1] = *(const f32x4*)(cache_v + o + 4); }
        { const int p = tid + 1024, key = p >> 3, ch = p & 7; const int kk = key < 144 ? key - 128 : 0;
          const bf16* rowp = QKVU + (size_t)(MPR + 16 * b + kk) * EVIN;
          kvr[2] = *(const u32x4*)(rowp + 512 + 64 * g + 8 * ch); vvr[2] = *(const u32x4*)(rowp + 640 + 64 * g + 8 * ch);
          if (key >= 144) { kvr[2] = (u32x4){0u, 0u, 0u, 0u}; vvr[2] = kvr[2]; } }
#pragma unroll
        for (int i = 0; i < 2; ++i) { kvr[i] = pk8(ck[i][0], ck[i][1]); vvr[i] = pk8(cv[i][0], cv[i][1]); }
    }
#pragma unroll
    for (int i = 0; i < 3; ++i) {
        const int p = tid + 512 * i, key = p >> 3, ch = p & 7;
        *(LAS u32x4*)(kl + (key >> 6) * 8192 + ch * 1024 + (key & 63) * 16) = kvr[i];
        *(LAS u32x4*)(vl + (key >> 6) * 8192 + (ch >> 2) * 4096 + ((key & 63) >> 4) * 1024 + (key & 15) * 64 + (ch & 3) * 16) = vvr[i];
    }
    const int hl = wid >> 1, qh = wid & 1, r32 = lane & 31, hi = lane >> 5, head = 4 * g + hl;
    const int q = samp ? (r32 & 15) : (32 * qh + r32);
    const size_t qrow = samp ? (size_t)(MPR + 16 * b + (r32 & 15)) : ((size_t)b * SEQ + 64 * c + q);
    const bf16* qp = QKVU + qrow * EVIN + 64 * head + 8 * hi;
    bf16x8 qr[4];
#pragma unroll
    for (int d0 = 0; d0 < 4; ++d0) qr[d0] = *(const bf16x8*)(qp + 16 * d0);
    __syncthreads();
    const LAS float* bt = (const LAS float*)(lds + AT_BIAS) + head * 256 + 63 - q;
    f32x16 p[6];
#pragma unroll
    for (int kt = 0; kt < 6; ++kt)
#pragma unroll
        for (int r = 0; r < 16; ++r) p[kt][r] = bt[32 * kt + crow(r, hi)];
#pragma unroll
    for (int kt = 0; kt < 6; ++kt) {
        const LAS unsigned char* kb = kl + (kt >> 1) * 8192 + hi * 1024 + ((kt & 1) * 32 + r32) * 16;
#pragma unroll
        for (int d0 = 0; d0 < 4; ++d0) { const bf16x8 kf = *(const LAS bf16x8*)(kb + d0 * 2048); p[kt] = __builtin_amdgcn_mfma_f32_32x32x16_bf16(kf, qr[d0], p[kt], 0, 0, 0); }
    }
    const int j0 = samp ? 0 : (c >= 2 ? 0 : 128 - 64 * c), j1 = samp ? 144 : 192;
    if (j0 > 0 || j1 < 192) {
#pragma unroll
        for (int kt = 0; kt < 6; ++kt)
#pragma unroll
            for (int r = 0; r < 16; ++r) { const int j = 32 * kt + crow(r, hi); if (j < j0 || j >= j1) p[kt][r] = -1e30f; }
    }
    const float sk = sinks[head] * LOG2E;
    float mx = sk;
#pragma unroll
    for (int kt = 0; kt < 6; ++kt)
#pragma unroll
        for (int r = 0; r < 16; ++r) mx = fmaxf(mx, p[kt][r]);
    mx = fmaxf(mx, __shfl_xor(mx, 32));
    float sum = 0.f;
#pragma unroll
    for (int kt = 0; kt < 6; ++kt)
#pragma unroll
        for (int r = 0; r < 16; ++r) { const float e = __builtin_amdgcn_exp2f(p[kt][r] - mx); p[kt][r] = e; sum += e; }
    sum += __shfl_xor(sum, 32);
    const float inv = 1.0f / (sum + __builtin_amdgcn_exp2f(sk - mx));
    f32x16 o[2]; o[0] = f32x16{}; o[1] = f32x16{};
    const int vb0 = (int)(unsigned)(uintptr_t)vl + ((lane >> 4) & 1) * 32 + (lane & 3) * 8 + (4 * hi + ((lane & 15) >> 2)) * 64;
#pragma unroll
    for (int t = 0; t < 3; ++t) {
        const f32x16& pa = p[2 * t]; const f32x16& pb = p[2 * t + 1];
        const u32x4 w0 = {pk2(pa[0], pa[1]), pk2(pa[2], pa[3]), pk2(pa[4], pa[5]), pk2(pa[6], pa[7])}, w1 = {pk2(pa[8], pa[9]), pk2(pa[10], pa[11]), pk2(pa[12], pa[13]), pk2(pa[14], pa[15])};
        const u32x4 w2 = {pk2(pb[0], pb[1]), pk2(pb[2], pb[3]), pk2(pb[4], pb[5]), pk2(pb[6], pb[7])}, w3 = {pk2(pb[8], pb[9]), pk2(pb[10], pb[11]), pk2(pb[12], pb[13]), pk2(pb[14], pb[15])};
        pv64(o, vb0 + t * 8192, __builtin_bit_cast(bf16x8, w0), __builtin_bit_cast(bf16x8, w1), __builtin_bit_cast(bf16x8, w2), __builtin_bit_cast(bf16x8, w3));
    }
    int lane2 = threadIdx.x & 63; asm volatile("" : "+v"(lane2));
    const int r32b = lane2 & 31, hib = lane2 >> 5;
    LAS float* wsf = (LAS float*)(lds + AT_WSF) + wid * 64;
    if (hib == 0) wsf[r32b] = inv;
    LDS_WAIT(); __builtin_amdgcn_wave_barrier();
    float rli[16];
#pragma unroll
    for (int r = 0; r < 16; ++r) rli[r] = wsf[crow(r, hib)];
    LAS bf16* stg = (LAS bf16*)(lds + AT_OST) + wid * 2048;
#pragma unroll
    for (int r = 0; r < 16; ++r) { const int orow = crow(r, hib);
#pragma unroll
        for (int d0 = 0; d0 < 2; ++d0) stg[orow * 64 + d0 * 32 + r32b] = (bf16)(pk2(o[d0][r] * rli[r], 0.f) & 0xffffu); }
    LDS_WAIT(); __builtin_amdgcn_wave_barrier();
#pragma unroll
    for (int i = 0; i < 4; ++i) { const int row = i * 8 + (lane2 >> 3), ch = lane2 & 7; const u32x4 v = *(const LAS u32x4*)(stg + row * 64 + ch * 8);
        if (!samp) *(u32x4*)(MIX + ((size_t)b * SEQ + 64 * c + 32 * qh + row) * DM + 64 * head + ch * 8) = v;
        else if (qh == 0 && row < 16) *(u32x4*)(MIX + (size_t)(MPR + 16 * b + row) * DM + 64 * head + ch * 8) = v; }
    __syncthreads();
}

template <int W> __device__ __forceinline__ void pool_group(LAS unsigned char* dt, const float (&x0)[31], const float (&x1)[31], const int pos0, const bool fixed_cnt, const int lane) {
    float s0 = 0.f, s1 = 0.f;
#pragma unroll
    for (int k = 1; k < W; ++k) { s0 += x0[15 - k]; s1 += x1[15 - k]; }
#pragma unroll
    for (int i = 0; i < 16; ++i) {
        s0 += x0[15 + i]; s1 += x1[15 + i];
        const int pos = pos0 + i; const float cnt = fixed_cnt ? (float)W : (float)((pos + 1) < W ? (pos + 1) : W);
        const float ic = 1.0f / cnt;
        const float d0 = s0 * ic - x0[15 + i], d1 = s1 * ic - x1[15 + i];
        *(LAS unsigned*)(dt + i * 256 + ((((lane >> 2) ^ i) & 15) << 4) + (lane & 3) * 4) = pk2(d0, d1);
        s0 -= x0[15 + i - (W - 1)]; s1 -= x1[15 + i - (W - 1)];
    }
}
template <bool WLDS>
__device__ __forceinline__ void pool_item(LAS unsigned char* lds, const bf16* QKVU, bf16* MIX, const float* state_pool, const bf16* POOLW, const float* pool_scale,
                                          const int samp, const size_t row0  , const int sb  , const int g, const int wid) {
    int lane = threadIdx.x & 63; asm volatile("" : "+v"(lane));
    LAS unsigned char* dt = lds + PL_D + wid * 4096;
    const int fr = lane & 15, fq = lane >> 4;
    const int t0 = samp ? 1024 : (int)(row0 & (SEQ - 1));
    {
        float x0[31], x1[31];
        const int col = 768 + 128 * g + 2 * lane;
        unsigned wseg[16];
#pragma unroll
        for (int e = 0; e < 16; ++e) wseg[e] = *(const unsigned*)(QKVU + (row0 + e) * EVIN + col);
        if (samp) {
            const float* sp = state_pool + (size_t)sb * 15 * 512 + 128 * g + 2 * lane;
            f32x2 hv[15];
#pragma unroll
            for (int e = 0; e < 15; ++e) hv[e] = *(const f32x2*)(sp + (size_t)e * 512);
#pragma unroll
            for (int e = 0; e < 15; ++e) { x0[e] = hv[e][0]; x1[e] = hv[e][1]; }
        } else if (t0 == 0) {
#pragma unroll
            for (int e = 0; e < 15; ++e) { x0[e] = 0.f; x1[e] = 0.f; }
        } else {
            unsigned wh[15];
#pragma unroll
            for (int e = 0; e < 15; ++e) wh[e] = *(const unsigned*)(QKVU + (row0 - 15 + e) * EVIN + col);
#pragma unroll
            for (int e = 0; e < 15; ++e) { x0[e] = bf_lo(wh[e]); x1[e] = bf_hi(wh[e]); }
        }
#pragma unroll
        for (int e = 0; e < 16; ++e) { x0[15 + e] = bf_lo(wseg[e]); x1[15 + e] = bf_hi(wseg[e]); }
        if (g == 0) pool_group<2>(dt, x0, x1, t0, samp != 0, lane);
        else if (g == 1) pool_group<4>(dt, x0, x1, t0, samp != 0, lane);
        else if (g == 2) pool_group<8>(dt, x0, x1, t0, samp != 0, lane);
        else pool_group<16>(dt, x0, x1, t0, samp != 0, lane);
    }
    LDS_WAIT(); __builtin_amdgcn_wave_barrier();
    bf16x8 wf[8][4];
    if (WLDS) {
        const LAS unsigned char* pw = lds + PL_W + (g & 1) * 32768 + fr * 256;
#pragma unroll
        for (int nf = 0; nf < 8; ++nf)
#pragma unroll
            for (int ks = 0; ks < 4; ++ks) wf[nf][ks] = *(const LAS bf16x8*)(pw + nf * 4096 + ((((4 * ks + fq) ^ fr) & 15) << 4));
    } else {
        const bf16* wp = POOLW + (size_t)g * 16384 + (size_t)fr * 128 + 8 * fq;
#pragma unroll
        for (int nf = 0; nf < 8; ++nf)
#pragma unroll
            for (int ks = 0; ks < 4; ++ks) wf[nf][ks] = *(const bf16x8*)(wp + (size_t)nf * 16 * 128 + 32 * ks);
    }
    bf16x8 af[4];
#pragma unroll
    for (int ks = 0; ks < 4; ++ks) af[ks] = *(const LAS bf16x8*)(dt + fr * 256 + ((((4 * ks + fq) ^ fr) & 15) << 4));
    const float* scp = pool_scale + 128 * g + 4 * fq;
    bf16* orow = MIX + (row0 + fr) * DM + 512 + 128 * g + 4 * fq;
#pragma unroll
    for (int nf = 0; nf < 8; ++nf) {
        f32x4 acc = {0.f, 0.f, 0.f, 0.f};
#pragma unroll
        for (int ks = 0; ks < 4; ++ks) acc = __builtin_amdgcn_mfma_f32_16x16x32_bf16(wf[nf][ks], af[ks], acc, 0, 0, 0);
        const f32x4 sc = *(const f32x4*)(scp + 16 * nf);
        acc = acc * sc;
        u32x2 w; w.x = pk2(acc[0], acc[1]); w.y = pk2(acc[2], acc[3]);
        *(u32x2*)(orow + 16 * nf) = w;
    }
    LDS_WAIT(); __builtin_amdgcn_wave_barrier();
}

template <int W> __device__ __forceinline__ void pool_seg_loads(const bf16* QKVU, const size_t row0, const int g, const int lane, unsigned (&raw)[W + 15]) {
    const bf16* p = QKVU + row0 * EVIN + 768 + 128 * g + 2 * lane;
#pragma unroll
    for (int e = 0; e < 16; ++e) raw[W - 1 + e] = *(const unsigned*)(p + (size_t)e * EVIN);
}
template <int W> __device__ __forceinline__ void pool_halo_loads(const bf16* QKVU, const size_t row0, const int g, const int lane, unsigned (&raw)[W + 15]) {
    const bf16* p = QKVU + row0 * EVIN + 768 + 128 * g + 2 * lane;
#pragma unroll
    for (int e = 0; e < W - 1; ++e) raw[e] = *(const unsigned*)(p - (size_t)(W - 1 - e) * EVIN);
}
template <int W> __device__ __forceinline__ void pool_halo_zero(unsigned (&raw)[W + 15]) {
#pragma unroll
    for (int e = 0; e < W - 1; ++e) raw[e] = 0u;
}
template <int W> __device__ __forceinline__ void pool_compute(LAS unsigned char* lds, bf16* MIX, const float* pool_scale, const unsigned (&raw)[W + 15], const size_t row0, const int t0, const int g, const int wid, const int lane) {
    LAS unsigned char* dt = lds + PL_D + wid * 4096;
    const int fr = lane & 15, fq = lane >> 4;
    float s0 = 0.f, s1 = 0.f;
#pragma unroll
    for (int e = 0; e < W - 1; ++e) { s0 += bf_lo(raw[e]); s1 += bf_hi(raw[e]); }
#pragma unroll
    for (int i = 0; i < 16; ++i) {
        const float u0 = bf_lo(raw[W - 1 + i]), u1 = bf_hi(raw[W - 1 + i]);
        s0 += u0; s1 += u1;
        const int pos = t0 + i; const float ic = 1.0f / (float)((pos + 1) < W ? (pos + 1) : W);
        *(LAS unsigned*)(dt + i * 256 + ((((lane >> 2) ^ i) & 15) << 4) + (lane & 3) * 4) = pk2(s0 * ic - u0, s1 * ic - u1);
        s0 -= bf_lo(raw[i]); s1 -= bf_hi(raw[i]);
    }
    LDS_WAIT(); __builtin_amdgcn_wave_barrier();
    bf16x8 wf[8][4];
    const LAS unsigned char* pw = lds + PL_W + (g & 1) * 32768 + fr * 256;
#pragma unroll
    for (int nf = 0; nf < 8; ++nf)
#pragma unroll
        for (int ks = 0; ks < 4; ++ks) wf[nf][ks] = *(const LAS bf16x8*)(pw + nf * 4096 + ((((4 * ks + fq) ^ fr) & 15) << 4));
    bf16x8 af[4];
#pragma unroll
    for (int ks = 0; ks < 4; ++ks) af[ks] = *(const LAS bf16x8*)(dt + fr * 256 + ((((4 * ks + fq) ^ fr) & 15) << 4));
    const float* scp = pool_scale + 128 * g + 4 * fq;
    bf16* orow = MIX + (row0 + fr) * DM + 512 + 128 * g + 4 * fq;
#pragma unroll
    for (int nf = 0; nf < 8; ++nf) {
        f32x4 acc = {0.f, 0.f, 0.f, 0.f};
#pragma unroll
        for (int ks = 0; ks < 4; ++ks) acc = __builtin_amdgcn_mfma_f32_16x16x32_bf16(wf[nf][ks], af[ks], acc, 0, 0, 0);
        const f32x4 sc = *(const f32x4*)(scp + 16 * nf);
        acc = acc * sc;
        u32x2 w; w.x = pk2(acc[0], acc[1]); w.y = pk2(acc[2], acc[3]);
        *(u32x2*)(orow + 16 * nf) = w;
    }
    LDS_WAIT(); __builtin_amdgcn_wave_barrier();
}
__device__ __forceinline__ void pool_stage_weights(LAS unsigned char* lds, const u32x4 (&wv)[8], const int t2) {
#pragma unroll
    for (int i = 0; i < 8; ++i) { const int chunk = t2 + 512 * i, row = chunk >> 4, c16 = chunk & 15; *(LAS u32x4*)(lds + PL_W + row * 256 + (((c16 ^ row) & 15) << 4)) = wv[i]; }
}
__device__ __forceinline__ void pool_unit_prompt(LAS unsigned char* lds, const bf16* QKVU, bf16* MIX, const bf16* POOLW, const float* pool_scale, const size_t row0, const int wid) {
    int t2 = threadIdx.x; asm volatile("" : "+v"(t2)); const int lane = t2 & 63;
    const int t0 = (int)(row0 & (SEQ - 1));
    u32x4 wv0[8], wv1[8];
#pragma unroll
    for (int i = 0; i < 8; ++i) wv0[i] = *(const u32x4*)(POOLW + (size_t)(t2 + 512 * i) * 8);
    unsigned r0[17], r1[19], r2[23], r3[31];
    pool_seg_loads<2>(QKVU, row0, 0, lane, r0); pool_seg_loads<4>(QKVU, row0, 1, lane, r1); pool_seg_loads<8>(QKVU, row0, 2, lane, r2); pool_seg_loads<16>(QKVU, row0, 3, lane, r3);
    if (t0 != 0) { pool_halo_loads<2>(QKVU, row0, 0, lane, r0); pool_halo_loads<4>(QKVU, row0, 1, lane, r1); pool_halo_loads<8>(QKVU, row0, 2, lane, r2); pool_halo_loads<16>(QKVU, row0, 3, lane, r3); }
    else { pool_halo_zero<2>(r0); pool_halo_zero<4>(r1); pool_halo_zero<8>(r2); pool_halo_zero<16>(r3); }
#pragma unroll
    for (int i = 0; i < 8; ++i) wv1[i] = *(const u32x4*)(POOLW + 32768 + (size_t)(t2 + 512 * i) * 8);
    pool_stage_weights(lds, wv0, t2);
    __syncthreads();
    pool_compute<2>(lds, MIX, pool_scale, r0, row0, t0, 0, wid, lane);
    pool_compute<4>(lds, MIX, pool_scale, r1, row0, t0, 1, wid, lane);
    __syncthreads();
    pool_stage_weights(lds, wv1, t2);
    __syncthreads();
    pool_compute<8>(lds, MIX, pool_scale, r2, row0, t0, 2, wid, lane);
    pool_compute<16>(lds, MIX, pool_scale, r3, row0, t0, 3, wid, lane);
    __syncthreads();
}

struct Args { const float* in[21]; float* out; unsigned char* ws; int ph_lo, ph_hi; };
static_assert(sizeof(Args) == 21 * 8 + 8 + 8 + 8, "Args has no padding");
static_assert(RVT_OFF + RVT_UNITS * 1024 <= LDS_BYTES, "row-scale table fits");

#define CAS __attribute__((address_space(4)))
__global__ void __launch_bounds__(512, 2) trunk_fwd(Args args_unused) {
    extern __shared__ __attribute__((aligned(16))) unsigned char lds_raw[];
    LAS unsigned char* lds = (LAS unsigned char*)lds_raw;
    volatile LAS unsigned* MISC = (volatile LAS unsigned*)(lds + MISC_OFF);
    const int wave = __builtin_amdgcn_readfirstlane(threadIdx.x >> 6);
    const int G = gridDim.x; const int bx = blockIdx.x; const int vcu = (G % 8 == 0) ? (bx % 8) * (G / 8) + bx / 8 : bx;
    const CAS Args* kp0 = (const CAS Args*)__builtin_amdgcn_kernarg_segment_ptr();
#define KP(name) const CAS Args* name = kp0; asm volatile("" : "+s"(name))
#define WSP(kp, off) ((kp)->ws + (off))
    for (int u = threadIdx.x; u < (LDS_BYTES - LDSCTL_OFF) / 4; u += 512) ((LAS unsigned*)(lds + LDSCTL_OFF))[u] = 0u;
    __syncthreads();
    XcdBarrier bar;
    { KP(kp); unsigned* ctl = (unsigned*)WSP(kp, WS_CTL); bar.bar = ctl + CW_BAR; bar.x = 0; bar.st = nullptr;
      if (N_LAUNCHES == 1) bar = xcd_barrier_post(ctl + CW_BAR, MISC + 8); }
#ifndef PROBE_DUP
#define PROBE_DUP (-1)
#endif
#define REP(k) for (int rep_ = 0; rep_ < ((PROBE_DUP == (k)) ? 2 : 1); ++rep_)
#define IN(k) (true)
#define PH_TID() int tid = threadIdx.x; asm volatile("" : "+v"(tid)); const int lane = tid & 63
#define SEAM(k) do { if (IN(k) && IN((k) + 1)) xcd_barrier(bar); } while (0)
    const int gw = vcu * 8 + wave, NGW = G * 8;

    REP(0) {
    if (IN(0)) {
        PH_TID(); KP(kp); unsigned char* ws = kp->ws; float* out = kp->out;
        const float* x_prompt = kp->in[0]; const float* x_sample = kp->in[1]; const float* cache_k = kp->in[2]; const float* cache_v = kp->in[3];
        const float* norm_mix = kp->in[6]; const float* norm_ffn = kp->in[7]; const float* ffn_w1 = kp->in[8]; const float* ffn_w2 = kp->in[9]; const float* ev_w_in = kp->in[10]; const float* ev_w_out = kp->in[11];
        const float* pool_w = kp->in[16]; const float* conv_w_in = kp->in[18]; const float* conv_w_out = kp->in[20];
        float* RINV0 = (float*)(ws + WS_RINV0); bf16* POOLW = (bf16*)(ws + WS_POOLW); bf16* WIN = (bf16*)(ws + WS_WIN); bf16* WOUT = (bf16*)(ws + WS_WOUT); bf16* W1 = (bf16*)(ws + WS_W1); bf16* W2 = (bf16*)(ws + WS_W2);
        bf16* WCIN = (bf16*)(ws + WS_WCIN); bf16* WCOUT = (bf16*)(ws + WS_WCOUT); bf16* S1 = (bf16*)(ws + WS_S1);
        LAS float* scr = (LAS float*)(lds + RING_OFF + wave * 16384);
        constexpr int I_IN = 16 * 40, I_OUT = 16 * 32, I_W1 = 16 * 128, I_W2 = 64 * 32, I_CIN = 16 * 96, I_COUT = 16 * 32, I_PW = 4 * 8;
        constexpr int NITEMS = I_IN + I_OUT + I_W1 + I_W2 + I_CIN + I_COUT + I_PW;
        for (int it = gw; it < NITEMS; it += NGW) {
            int r = it;
            if (r < I_IN) { transpose_item<true>(ev_w_in, DM, EVIN, WIN, norm_mix, scr, r, lane); continue; } r -= I_IN;
            if (r < I_OUT) { transpose_item<false>(ev_w_out, DM, DM, WOUT, nullptr, scr, r, lane); continue; } r -= I_OUT;
            if (r < I_W1) { transpose_item<true>(ffn_w1, DM, DFF, W1, norm_ffn, scr, r, lane); continue; } r -= I_W1;
            if (r < I_W2) { transpose_item<false>(ffn_w2, DFF, DM, W2, nullptr, scr, r, lane); continue; } r -= I_W2;
            if (r < I_CIN) { transpose_item<true>(conv_w_in, DM, CIN, WCIN, norm_mix + DM, scr, r, lane); continue; } r -= I_CIN;
            if (r < I_COUT) { transpose_item<false>(conv_w_out, DM, DM, WCOUT, nullptr, scr, r, lane); continue; } r -= I_COUT;
            { const int g = r >> 3; transpose_item<false>(pool_w + (size_t)g * 16384, 128, 128, POOLW + (size_t)g * 16384, nullptr, scr, r & 7, lane); }
        }
        for (int m = gw * 4; m < MT; m += NGW * 4) {
            const float* xr = (m < MPR) ? x_prompt + (size_t)m * DM : x_sample + (size_t)(m - MPR) * DM;
            const f32x4* x4 = (const f32x4*)xr + lane;
            f32x4 v[4][4]; float sr[4];
#pragma unroll
            for (int q = 0; q < 4; ++q)
#pragma unroll
                for (int j = 0; j < 4; ++j) v[q][j] = x4[256 * q + 64 * j];
#pragma unroll
            for (int q = 0; q < 4; ++q) { sr[q] = (sq4(v[q][0]) + sq4(v[q][1])) + (sq4(v[q][2]) + sq4(v[q][3])); }
#pragma unroll
            for (int o = 1; o < 64; o <<= 1) {
#pragma unroll
                for (int q = 0; q < 4; ++q) sr[q] += __shfl_xor(sr[q], o); }
            if (lane < 4) { const float sv = lane == 0 ? sr[0] : (lane == 1 ? sr[1] : (lane == 2 ? sr[2] : sr[3])); RINV0[m + lane] = rsqrtf(sv * (1.0f / 1024.0f) + EPS); }
#pragma unroll
            for (int q = 0; q < 4; ++q) { u32x2* o8 = (u32x2*)(S1 + (size_t)(m + q) * DM) + lane;
#pragma unroll
                for (int j = 0; j < 4; ++j) { u32x2 w; w.x = pk2(v[q][j][0], v[q][j][1]); w.y = pk2(v[q][j][2], v[q][j][3]); o8[64 * j] = w; } }
        }
        { const f32x4* ck = (const f32x4*)cache_k; const f32x4* cv = (const f32x4*)cache_v; f32x4* ok = (f32x4*)(out + O_KS); f32x4* ov = (f32x4*)(out + O_VS);
          for (int e = vcu * 512 + tid; e < 2 * 8 * 3584; e += G * 512) { const int which = e / 28672, rem = e % 28672, b = rem / 3584, i = rem % 3584;
              if (which == 0) ok[b * 4096 + i] = ck[b * 4096 + 512 + i]; else ov[b * 4096 + i] = cv[b * 4096 + 512 + i]; } }
    }
    SEAM(0);
    }

    REP(1) {
    if (IN(1)) {
        PH_TID(); KP(kp); unsigned char* ws = kp->ws; float* out = kp->out; const float* q_norm = kp->in[12]; const float* k_norm = kp->in[13];
        bf16* S1 = (bf16*)(ws + WS_S1); bf16* WIN = (bf16*)(ws + WS_WIN); bf16* QKVU = (bf16*)(ws + WS_QKVU); float* RINV0 = (float*)(ws + WS_RINV0);
        { BRowPlain br{WIN, DM, 4}; SEpiInProj SE{QKVU, RINV0, q_norm, k_norm, out};
          sample_gemm<DM, 4, 4>(lds + RING_OFF, S1 + (size_t)MPR * DM, 20, (bx + G / 2) % G, G, br, SE, lane, wave); }
        pg8::MapHead<DM> mp{(const char*)S1, (const char*)WIN}; pg8::StaticOrder S; S.init(NTILE, EVIN / 256, G, bx);
        pg8::EpiInProj E{QKVU, RINV0, q_norm, k_norm, out};
        pg8::gemm_phase<DM, pg8::EpiInProj, pg8::MapHead<DM>>(lds + RING_OFF, mp, S, E);
        { const int nun = NTILE * (EVIN / 256), rem = nun % G, nlate = (rem == 0) ? G : G - rem;
          if (rem == 0 || bx >= rem) {
              const float* norm_ffn = kp->in[7]; const float* ffn_w1 = kp->in[8]; const float* ffn_w2 = kp->in[9];
              bf16* W1B = (bf16*)(out + O_YP); bf16* W2B = (bf16*)(ws + WS_W2B);
              LAS float* scr = (LAS float*)(lds + RING_OFF + wave * 16384);
              constexpr int I_W1 = 16 * 128, I_W2 = 64 * 32;
              for (int it = ((rem == 0) ? bx : bx - rem) * 8 + wave; it < I_W1 + I_W2; it += nlate * 8) {
                  if (it < I_W1) transpose_item<true>(ffn_w1 + (size_t)DM * DFF, DM, DFF, W1B, norm_ffn + DM, scr, it, lane);
                  else transpose_item<false>(ffn_w2 + (size_t)DFF * DM, DFF, DM, W2B, nullptr, scr, it - I_W1, lane); } } }
    }
    SEAM(1);
    }

    REP(2) {
    if (IN(2)) {
        PH_TID(); KP(kp); unsigned char* ws = kp->ws; const float* cache_k = kp->in[2]; const float* cache_v = kp->in[3]; const float* state_pool = kp->in[4];
        const float* attn_sinks = kp->in[14]; const float* rel_bias = kp->in[15]; const float* pool_scale = kp->in[17];
        bf16* QKVU = (bf16*)(ws + WS_QKVU); bf16* POOLW = (bf16*)(ws + WS_POOLW);
        bf16* MIX = (bf16*)(ws + WS_S0);
        { LAS float* bt = (LAS float*)(lds + AT_BIAS);
          for (int e = tid; e < 8 * 256; e += 512) { const int h = e >> 8, idx = e & 255; float v = 0.f;
              if (idx < 255) { const int rel = idx - 191, n = rel < 0 ? -rel : rel; int bk = n < 8 ? n : (33 - __builtin_clz((unsigned)(n * n))); if (bk > 15) bk = 15; if (rel > 0) bk += 16; v = rel_bias[bk * 8 + h] * LOG2E; }
              bt[e] = v; } }
        __syncthreads();
        for (int un = vcu * 4, cnt = 0; un < 1040; ) {
            const int samp = un >= 1024 ? 1 : 0, sidx = un - 1024;
            const int ub = samp ? (sidx >> 1) : (un >> 9), ug = samp ? (sidx & 1) : ((un >> 8) & 1), uc = samp ? 0 : (un & 255);
            attn_unit(lds, QKVU, MIX, cache_k, cache_v, attn_sinks, samp, ub, uc, ug, wave);
            ++cnt;
            if (cnt < 4) ++un;
            else if (cnt == 4) un = (4 * G >= 1024) ? 1024 + vcu : 4 * G + vcu;
            else un += G;
        }
        for (int pu = vcu; pu < 256; pu += G) pool_unit_prompt(lds, QKVU, MIX, POOLW, pool_scale, (size_t)pu * 128 + wave * 16, wave);
        if (wave == 0) for (int it = (G >= 64) ? vcu - G / 2 : vcu; it >= 0 && it < 32; it += G) pool_item<false>(lds, QKVU, MIX, state_pool, POOLW, pool_scale, 1, (size_t)MPR + (it >> 2) * 16, it >> 2, it & 3, wave);
    }
    SEAM(2);
    }

    REP(3) {
    if (IN(3)) {
        PH_TID(); KP(kp); unsigned char* ws = kp->ws; float* out = kp->out; const float* x_prompt = kp->in[0]; const float* x_sample = kp->in[1];
        bf16* S0 = (bf16*)(ws + WS_S0); bf16* S1 = (bf16*)(ws + WS_S1); bf16* WOUT = (bf16*)(ws + WS_WOUT); float* SS = (float*)(ws + WS_SS); float* XP = out + O_YP; float* XS = out + O_YS;
        pg8::MapHead<DM> mp{(const char*)S0, (const char*)WOUT}; pg8::StaticOrder S; S.init(NTILE, DM / 256, G, bx);
        { BRowPlain br{WOUT, DM, 2}; SEpiResid<1, 2> SE{nullptr, S1, SS + (size_t)MT * 16, nullptr}; sample_gemm<DM, 2, 8>(lds + RING_OFF, S0 + (size_t)MPR * DM, 32, vcu, G, br, SE, lane, wave); }
        pg8::EpiResid<1> E{nullptr, S1, SS, nullptr};
        pg8::gemm_phase<DM, pg8::EpiResid<1>, pg8::MapHead<DM>>(lds + RING_OFF, mp, S, E);
    }
    SEAM(3);
    }
    REP(4) {
    if (IN(4)) {
        PH_TID(); KP(kp); unsigned char* ws = kp->ws; bf16* S1 = (bf16*)(ws + WS_S1); bf16* W1 = (bf16*)(ws + WS_W1); bf16* H = (bf16*)(ws + WS_H); float* SS = (float*)(ws + WS_SS);
        { BRowPlain br{W1, DM, 4}; SEpiUp SE{H, SS + (size_t)MT * 16}; sample_gemm<DM, 4, 4>(lds + RING_OFF, S1 + (size_t)MPR * DM, 64, vcu, G, br, SE, lane, wave); }
        pg8::MapHead<DM> mp{(const char*)S1, (const char*)W1}; pg8::StaticOrder S; S.init(NTILE, DFF / 256, G, bx);
        build_row_scales(lds, S, SS);
        pg8::EpiUp E{H, (const LAS float*)(lds + RVT_OFF), SS};
        pg8::gemm_phase<DM, pg8::EpiUp, pg8::MapHead<DM>>(lds + RING_OFF, mp, S, E);
    }
    SEAM(4);
    }
    REP(5) {
    if (IN(5)) {
        PH_TID(); KP(kp); unsigned char* ws = kp->ws; float* out = kp->out; bf16* S1 = (bf16*)(ws + WS_S1); bf16* W2 = (bf16*)(ws + WS_W2); bf16* H = (bf16*)(ws + WS_H); float* SS = (float*)(ws + WS_SS); float* XP = out + O_YP; float* XS = out + O_YS;
        pg8::MapHeadAT<DFF> mp{(const char*)H, (const char*)W2}; pg8::StaticOrder S; S.init(NTILE, DM / 256, G, bx);
        { BRowPlain br{W2, DFF, 2}; SEpiResid<1, 2> SE{nullptr, S1, SS + (size_t)MT * 16, nullptr}; sample_gemm<DFF, 2, 8>(lds + RING_OFF, H + (size_t)MPR * DFF, 32, vcu, G, br, SE, lane, wave); }
        pg8::EpiResid<1> E{nullptr, S1, SS, nullptr};
        pg8::gemm_phase<DFF, pg8::EpiResid<1>, pg8::MapHeadAT<DFF>>(lds + RING_OFF, mp, S, E);
    }
    SEAM(5);
    }
    REP(6) {
    if (IN(6)) {
        PH_TID(); KP(kp); unsigned char* ws = kp->ws; float* out = kp->out; bf16* S1 = (bf16*)(ws + WS_S1); bf16* WCIN = (bf16*)(ws + WS_WCIN); bf16* BE = (bf16*)(ws + WS_H); float* SS = (float*)(ws + WS_SS);
        pg8::MapConvE<DM> mp{(const char*)S1, (const char*)WCIN}; pg8::StaticOrder S; S.init(NTILE, 8, G, bx);
        { BRowConvIn br{WCIN}; SEpiConvIn SE{BE, SS + (size_t)MT * 16, out}; sample_gemm<DM, 3, 4>(lds + RING_OFF, S1 + (size_t)MPR * DM, 64, vcu, G, br, SE, lane, wave); }
        build_row_scales(lds, S, SS);
        pg8::EpiConvE E{BE, (const LAS float*)(lds + RVT_OFF), SS, out};
        pg8::gemm_phase<DM, pg8::EpiConvE, pg8::MapConvE<DM>>(lds + RING_OFF, mp, S, E);
    }
    SEAM(6);
    }
    REP(7) {
    if (IN(7)) {
        PH_TID(); KP(kp); unsigned char* ws = kp->ws; const float* state_conv = kp->in[5]; const float* conv_w = kp->in[19];
        bf16* S0 = (bf16*)(ws + WS_S0); bf16* S1 = (bf16*)(ws + WS_S1); bf16* WCIN = (bf16*)(ws + WS_WCIN); bf16* BE = (bf16*)(ws + WS_H); float* SS = (float*)(ws + WS_SS);
        for (int b = (G >= 8) ? vcu - (G - 8) : vcu; b >= 0 && b < 8; b += G) {
            const int cg = tid & 127, seg = tid >> 7;
            const f32x4 w0a = *(const f32x4*)(conv_w + 8 * cg), w0b = *(const f32x4*)(conv_w + 8 * cg + 4);
            const f32x4 w1a = *(const f32x4*)(conv_w + DM + 8 * cg), w1b = *(const f32x4*)(conv_w + DM + 8 * cg + 4);
            const f32x4 w2a = *(const f32x4*)(conv_w + 2 * DM + 8 * cg), w2b = *(const f32x4*)(conv_w + 2 * DM + 8 * cg + 4);
            const size_t r0 = (size_t)MPR + 16 * b + 4 * seg;
            f32x4 p2a, p2b, p1a, p1b;
            if (seg == 0) { const float* sp = state_conv + (size_t)b * 2 * DM + 8 * cg;
                p2a = *(const f32x4*)sp; p2b = *(const f32x4*)(sp + 4); p1a = *(const f32x4*)(sp + DM); p1b = *(const f32x4*)(sp + DM + 4); }
            else { const u32x4 e2 = *(const u32x4*)(BE + (r0 - 2) * 2048 + 1024 + 8 * cg), e1 = *(const u32x4*)(BE + (r0 - 1) * 2048 + 1024 + 8 * cg);
                p2a = (f32x4){bf_lo(e2.x), bf_hi(e2.x), bf_lo(e2.y), bf_hi(e2.y)}; p2b = (f32x4){bf_lo(e2.z), bf_hi(e2.z), bf_lo(e2.w), bf_hi(e2.w)};
                p1a = (f32x4){bf_lo(e1.x), bf_hi(e1.x), bf_lo(e1.y), bf_hi(e1.y)}; p1b = (f32x4){bf_lo(e1.z), bf_hi(e1.z), bf_lo(e1.w), bf_hi(e1.w)}; }
#pragma unroll
            for (int i = 0; i < 4; ++i) {
                const size_t r = r0 + i;
                const u32x4 bw = *(const u32x4*)(BE + r * 2048 + 8 * cg), ew = *(const u32x4*)(BE + r * 2048 + 1024 + 8 * cg);
                const f32x4 ea = {bf_lo(ew.x), bf_hi(ew.x), bf_lo(ew.y), bf_hi(ew.y)}, eb = {bf_lo(ew.z), bf_hi(ew.z), bf_lo(ew.w), bf_hi(ew.w)};
                const f32x4 ba = {bf_lo(bw.x), bf_hi(bw.x), bf_lo(bw.y), bf_hi(bw.y)}, bb = {bf_lo(bw.z), bf_hi(bw.z), bf_lo(bw.w), bf_hi(bw.w)};
                const f32x4 ya = w0a * p2a + w1a * p1a + w2a * ea, yb = w0b * p2b + w1b * p1b + w2b * eb;
                *(u32x4*)(S0 + r * DM + 8 * cg) = pk8(ba * ya, bb * yb);
                p2a = p1a; p2b = p1b; p1a = ea; p1b = eb;
            }
        }
        pg8::MapPlain<DM> mp{(const char*)S1, (const char*)WCIN}; pg8::StaticOrder S; S.init(NTILE, 4, G, bx);
        build_row_scales(lds, S, SS);
        pg8::EpiConvB E{ws, conv_w, (const LAS float*)(lds + RVT_OFF)};
        pg8::gemm_phase<DM, pg8::EpiConvB, pg8::MapPlain<DM>>(lds + RING_OFF, mp, S, E);
    }
    SEAM(7);
    }
    REP(8) {
    if (IN(8)) {
        PH_TID(); KP(kp); unsigned char* ws = kp->ws; float* out = kp->out; bf16* S0 = (bf16*)(ws + WS_S0); bf16* S1 = (bf16*)(ws + WS_S1); bf16* WCOUT = (bf16*)(ws + WS_WCOUT); float* SS = (float*)(ws + WS_SS); float* XP = out + O_YP; float* XS = out + O_YS;
        pg8::MapHead<DM> mp{(const char*)S0, (const char*)WCOUT}; pg8::StaticOrder S; S.init(NTILE, DM / 256, G, bx);
        { BRowPlain br{WCOUT, DM, 2}; SEpiResid<1, 2> SE{nullptr, S1, SS + (size_t)MT * 16, nullptr}; sample_gemm<DM, 2, 8>(lds + RING_OFF, S0 + (size_t)MPR * DM, 32, vcu, G, br, SE, lane, wave); }
        pg8::EpiResid<1> E{nullptr, S1, SS, nullptr};
        pg8::gemm_phase<DM, pg8::EpiResid<1>, pg8::MapHead<DM>>(lds + RING_OFF, mp, S, E);
    }
    SEAM(8);
    }
    REP(9) {
    if (IN(9)) {
        PH_TID(); KP(kp); unsigned char* ws = kp->ws; bf16* S1 = (bf16*)(ws + WS_S1); bf16* W1 = (bf16*)(kp->out + O_YP); bf16* H = (bf16*)(ws + WS_H); float* SS = (float*)(ws + WS_SS);
        { BRowPlain br{W1, DM, 4}; SEpiUp SE{H, SS + (size_t)MT * 16}; sample_gemm<DM, 4, 4>(lds + RING_OFF, S1 + (size_t)MPR * DM, 64, vcu, G, br, SE, lane, wave); }
        pg8::MapHead<DM> mp{(const char*)S1, (const char*)W1}; pg8::StaticOrder S; S.init(NTILE, DFF / 256, G, bx);
        build_row_scales(lds, S, SS);
        pg8::EpiUp E{H, (const LAS float*)(lds + RVT_OFF), SS};
        pg8::gemm_phase<DM, pg8::EpiUp, pg8::MapHead<DM>>(lds + RING_OFF, mp, S, E);
    }
    SEAM(9);
    }
    if (IN(10)) {
        PH_TID(); KP(kp); unsigned char* ws = kp->ws; float* out = kp->out; bf16* S1 = (bf16*)(ws + WS_S1); bf16* W2 = (bf16*)(ws + WS_W2B); bf16* H = (bf16*)(ws + WS_H); float* XP = out + O_YP; float* XS = out + O_YS;
        pg8::MapHeadAT<DFF> mp{(const char*)H, (const char*)W2}; pg8::StaticOrder S; S.init(NTILE, DM / 256, G, bx);
        { BRowPlain br{W2, DFF, 2}; SEpiResid<2, 2> SE{nullptr, S1, nullptr, XS}; sample_gemm<DFF, 2, 8>(lds + RING_OFF, H + (size_t)MPR * DFF, 32, vcu, G, br, SE, lane, wave); }
        pg8::EpiResid<2> E{nullptr, S1, nullptr, XP};
        pg8::gemm_phase<DFF, pg8::EpiResid<2>, pg8::MapHeadAT<DFF>>(lds + RING_OFF, mp, S, E);
    }
#undef IN
#undef SEAM
#undef KP
#undef WSP
}

extern "C" void kernel_launch(void* const* d_in, const int* in_sizes, int n_in, void* d_out, int out_size, void* d_ws, size_t ws_size, hipStream_t stream) {
    static int grid = 0;
    if (grid == 0) {
        if (n_in != 21 || in_sizes[0] != MPR * DM || (size_t)out_size != O_END || ws_size < WS_END) {
            fprintf(stderr, "kernel_launch: unexpected problem: n_in %d in0 %d out %d ws %zu (need %zu); nothing launched\n", n_in, n_in > 0 ? in_sizes[0] : -1, out_size, ws_size, (size_t)WS_END); grid = -1; return; }
        int dev = 0, cus = 0, per_cu = 0;
        if (hipGetDevice(&dev) != hipSuccess || hipDeviceGetAttribute(&cus, hipDeviceAttributeMultiprocessorCount, dev) != hipSuccess) { fprintf(stderr, "kernel_launch: device query failed\n"); grid = -1; return; }
        if (hipFuncSetAttribute((const void*)trunk_fwd, hipFuncAttributeMaxDynamicSharedMemorySize, LDS_BYTES) != hipSuccess) { fprintf(stderr, "kernel_launch: hipFuncSetAttribute failed\n"); grid = -1; return; }
        if (hipOccupancyMaxActiveBlocksPerMultiprocessor(&per_cu, (const void*)trunk_fwd, 512, LDS_BYTES) != hipSuccess || per_cu < 1) {
            fprintf(stderr, "kernel_launch: occupancy query reports %d workgroups per CU; nothing launched\n", per_cu); (void)hipGetLastError(); grid = -1; return; }
        grid = cus;
    }
    if (grid < 0) return;
    if (hipMemsetAsync((char*)d_ws + WS_CTL, 0, CTL_ZERO_BYTES, stream) != hipSuccess) { fprintf(stderr, "kernel_launch: memset failed\n"); return; }
    Args a{};
    for (int i = 0; i < 21; ++i) a.in[i] = (const float*)d_in[i];
    a.out = (float*)d_out; a.ws = (unsigned char*)d_ws;
    for (int li = 0; li < N_LAUNCHES; ++li) {
        a.ph_lo = (N_LAUNCHES == 1) ? 0 : li; a.ph_hi = (N_LAUNCHES == 1) ? NPH : li + 1;
        hipLaunchKernelGGL(trunk_fwd, dim3(grid), dim3(512), LDS_BYTES, stream, a);
        const hipError_t le = hipPeekAtLastError();
        if (le != hipSuccess) { fprintf(stderr, "kernel_launch: launch %d failed: %s\n", li, hipGetErrorName(le)); break; }
    }
}
```

```cpp
#include <hip/hip_runtime.h>
#include <cstdio>
#include <cstdint>

#define LAS __attribute__((address_space(3)))
#define GAS __attribute__((address_space(1)))
typedef unsigned short bf16;
typedef short bf16x8 __attribute__((ext_vector_type(8)));
typedef short s16x4 __attribute__((ext_vector_type(4)));
typedef float f32x2 __attribute__((ext_vector_type(2)));
typedef float f32x4 __attribute__((ext_vector_type(4)));
typedef float f32x16 __attribute__((ext_vector_type(16)));
typedef unsigned u32x2 __attribute__((ext_vector_type(2)));
typedef unsigned u32x4 __attribute__((ext_vector_type(4)));
typedef __bf16 bf16x2_t __attribute__((ext_vector_type(2)));

#ifndef MK_N_LAUNCHES
#define MK_N_LAUNCHES 1
#endif
constexpr int NPH = 11;
constexpr int N_LAUNCHES = MK_N_LAUNCHES;
static_assert(N_LAUNCHES == 1 || N_LAUNCHES == NPH, "MK_N_LAUNCHES is 1 or 11");

constexpr int DM = 1024, SEQ = 16384, NBATCH = 2, MPR = NBATCH * SEQ, MSR = 128, MT = MPR + MSR, NTILE = 128;
constexpr int EVIN = 1280, DFF = 4096, CIN = 3072;
constexpr float EPS = 1e-6f, LOG2E = 1.4426950408889634f, QSCALE = 0.125f * 1.4426950408889634f;
constexpr size_t O_YP = 0, O_YS = 33554432, O_KP = 33685504, O_VP = 33718272, O_PP = 33751040, O_CP = 33766400, O_KS = 33770496, O_VS = 33901568, O_PS = 34032640, O_CS = 34094080, O_END = 34110464;
constexpr size_t KiB = 1024, MiB = 1024 * 1024;
constexpr size_t WS_CTL = 0, CTL_ZERO_BYTES = 256 * KiB;
constexpr size_t WS_RINV0 = 256 * KiB;
constexpr size_t WS_SS = 512 * KiB;
constexpr size_t WS_POOLW = 2816 * KiB;
constexpr size_t WS_WIN = 3 * MiB;
constexpr size_t WS_WOUT = WS_WIN + 2560 * KiB;
constexpr size_t WS_W1 = WS_WOUT + 2 * MiB;
constexpr size_t WS_W2 = WS_W1 + 8 * MiB;
constexpr size_t WS_WCIN = WS_W2 + 8 * MiB;
constexpr size_t WS_WCOUT = WS_WCIN + 6 * MiB;
constexpr size_t WS_S0 = 32 * MiB;
constexpr size_t WS_S1 = WS_S0 + 65 * MiB;
constexpr size_t WS_QKVU = WS_S1 + 65 * MiB;
constexpr size_t WS_H = WS_QKVU + 81 * MiB;
constexpr size_t WS_W2B = WS_H + 257 * MiB;
constexpr size_t WS_END = WS_W2B + 8 * MiB;
static_assert(WS_WCOUT + 2 * MiB <= WS_S0 && (size_t)MT * 2048 <= 65 * MiB && (size_t)MT * 2560 <= 81 * MiB && (size_t)MT * 8192 <= 257 * MiB && WS_END <= 512 * MiB, "ws map");
static_assert(WS_SS + (size_t)MT * 64 + 128 * 32 * 4 <= WS_POOLW, "ws map ss (+ the sample rows' 32-slot table behind it)");
constexpr int CW_BAR = 4096;

__device__ __forceinline__ unsigned pk2(float lo, float hi) { f32x2 v = {lo, hi}; bf16x2_t b = __builtin_convertvector(v, bf16x2_t); return __builtin_bit_cast(unsigned, b); }
__device__ __forceinline__ u32x4 pk8(f32x4 a, f32x4 b) { u32x4 w; w.x = pk2(a[0], a[1]); w.y = pk2(a[2], a[3]); w.z = pk2(b[0], b[1]); w.w = pk2(b[2], b[3]); return w; }
__device__ __forceinline__ float bf_lo(unsigned w) { return __uint_as_float(w << 16); }
__device__ __forceinline__ float bf_hi(unsigned w) { return __uint_as_float(w & 0xffff0000u); }
__device__ __forceinline__ float sq4(f32x4 v) { return (v[0] * v[0] + v[1] * v[1]) + (v[2] * v[2] + v[3] * v[3]); }
__device__ __forceinline__ float wave_sum(float v) {
#pragma unroll
    for (int o = 1; o < 64; o <<= 1) v += __shfl_xor(v, o);
    return v;
}
__device__ __forceinline__ size_t be_off(size_t r, int c) { return (r >> 8) * (size_t)(256 * 2048) + (size_t)(c >> 5) * 8192 + (r & 255) * 32 + (c & 31); }
#define LDS_WAIT() asm volatile("s_waitcnt lgkmcnt(0)" ::: "memory")
#define VM_WAIT() asm volatile("s_waitcnt vmcnt(0)" ::: "memory")

namespace pg8 {
constexpr size_t WS_H_OFF = WS_H, WS_S0_OFF = WS_S0, WS_SS_OFF = WS_SS;
constexpr int RVT_UNITS_ = 12;
constexpr int BM = 256, BK = 64, HALF = 128, HTB = HALF * BK * 2, STAGE_BYTES = 8 * HTB, NXCD = 8, WGM = 8;
__host__ __device__ __forceinline__ int lds_byte(int r, int c) { const int st = (r >> 4) * 2 + (c >> 5), rr = r & 15, cc = c & 31, ob = rr * 64 + cc * 2; return st * 1024 + (ob ^ (((ob >> 9) & 1) << 5)); }
__host__ __device__ __forceinline__ void stage_rc(int b, int& R, int& C) { const int st = b / 1024, sb = b % 1024, swz = sb ^ (((sb >> 9) & 1) << 5); R = (st >> 1) * 16 + swz / 64; C = (st & 1) * 32 + (swz % 64) / 2; }
__host__ __device__ __forceinline__ int perm32(int rho) { const int n = rho >> 4, i = rho & 15; return 8 * (i >> 2) + 4 * n + (i & 3); }
struct Unit { int pm, pn, idx; };
struct StaticOrder {
    int nM, nN, nwg, G, c;
    __device__ void init(int nM_, int nN_, int G_, int c_) { nM = nM_; nN = nN_; nwg = nM * nN; G = G_; c = c_; }
    __device__ bool next(int i, Unit& u) const {
        const long L = (long)i * G + c; if (L >= nwg) return false;
        int wgid = (int)L; { const int q = nwg / NXCD, r = nwg % NXCD, xcd = wgid % NXCD, off = wgid / NXCD; wgid = (xcd < r ? xcd * (q + 1) : r * (q + 1) + (xcd - r) * q) + off; }
        const int nig = WGM * nN, gid = wgid / nig, fm = gid * WGM, gsz = (nM - fm) < WGM ? (nM - fm) : WGM;
        u.pm = fm + ((wgid % nig) % gsz); u.pn = (wgid % nig) / gsz; return true;
    }
};
template <int K> struct MapPlain {
    static constexpr int BMODE = 0; static constexpr bool ATILE = false;
    const char* A; const char* Bt;
    __device__ __forceinline__ void ptrs(const Unit& u, const char*& a, size_t& aH, const char*& b, size_t& bH) const {
        a = A + (size_t)u.pm * 256 * K * 2; aH = (size_t)128 * K * 2;
        b = Bt + (size_t)u.pn * 256 * K * 2; bH = (size_t)128 * K * 2; }
};
template <int K> struct MapHead {
    static constexpr int BMODE = 1; static constexpr bool ATILE = false;
    const char* A; const char* Bt;
    __device__ __forceinline__ void ptrs(const Unit& u, const char*& a, size_t& aH, const char*& b, size_t& bH) const {
        a = A + (size_t)u.pm * 256 * K * 2; aH = (size_t)128 * K * 2;
        b = Bt + (size_t)u.pn * 256 * K * 2; bH = (size_t)32 * K * 2; }
};
template <int K> struct MapHeadAT {
    static constexpr int BMODE = 1; static constexpr bool ATILE = true;
    const char* A; const char* Bt;
    __device__ __forceinline__ void ptrs(const Unit& u, const char*& a, size_t& aH, const char*& b, size_t& bH) const {
        a = A + (size_t)u.pm * 256 * K * 2; aH = (size_t)128 * 32 * 2;
        b = Bt + (size_t)u.pn * 256 * K * 2; bH = (size_t)32 * K * 2; }
};
template <int K> struct MapConvIn {
    static constexpr int BMODE = 0; static constexpr bool ATILE = false;
    const char* A; const char* Bt;
    __device__ __forceinline__ void ptrs(const Unit& u, const char*& a, size_t& aH, const char*& b, size_t& bH) const {
        a = A + (size_t)u.pm * 256 * K * 2; aH = (size_t)128 * K * 2;
        if (u.pn < 4) { b = Bt + (size_t)u.pn * 256 * K * 2; bH = (size_t)128 * K * 2; }
        else { b = Bt + (size_t)(1024 + 128 * (u.pn - 4)) * K * 2; bH = (size_t)1024 * K * 2; } }
};

template <int K> struct MapConvE {
    static constexpr int BMODE = 0; static constexpr bool ATILE = false;
    const char* A; const char* Bt;
    __device__ __forceinline__ void ptrs(const Unit& u, const char*& a, size_t& aH, const char*& b, size_t& bH) const {
        a = A + (size_t)u.pm * 256 * K * 2; aH = (size_t)128 * K * 2;
        b = Bt + (size_t)(1024 + 128 * u.pn) * K * 2; bH = (size_t)1024 * K * 2; }
};

template <int K, class Epi, class Map>
__device__ __forceinline__ void gemm_phase(LAS unsigned char* lds, const Map& MPp, const StaticOrder& S, const Epi& E) {
    int tid = threadIdx.x; asm volatile("" : "+v"(tid));
    const int wid = __builtin_amdgcn_readfirstlane(tid >> 6), lane = tid & 63, wr = wid >> 2, wc = wid & 3, fr = lane & 15, fq = lane >> 4;
    constexpr int nt = K / BK;
    unsigned voffA[2], voffB[2];
#pragma unroll
    for (int i = 0; i < 2; ++i) { int R, C; stage_rc(tid * 16 + i * 8192, R, C);
        const int Rb = (Map::BMODE == 1) ? (64 * (R >> 5) + perm32(R & 31)) : ((R & ~31) + perm32(R & 31));
        voffA[i] = Map::ATILE ? (unsigned)((C >> 5) * 8192 + R * 32 + (C & 31)) * 2u : (unsigned)(R * K + C) * 2u; voffB[i] = (unsigned)(Rb * K + C) * 2u; }
    const size_t kstep = (size_t)(BK * 2), kstepA = Map::ATILE ? (size_t)(256 * 64 * 2) : (size_t)(BK * 2);
    const unsigned ldsw = (unsigned)wid * 1024u;
    const int aoff = lds_byte(wr * 64 + fr, fq * 8), boff = lds_byte(wc * 32 + fr, fq * 8);
#define PG8_SA(b, h) (((b) * 2 + (h)) * HTB)
#define PG8_SB(b, h) ((4 + (b) * 2 + (h)) * HTB)
#define PG8_STAGE(bufoff, gbase, voff) do { _Pragma("unroll") for (int _i = 0; _i < 2; ++_i) \
        __builtin_amdgcn_global_load_lds((const unsigned*)((const char*)(gbase) + (voff)[_i]), (LAS unsigned*)(lds + (bufoff) + ldsw + _i * 8192), 16, 0, 0); } while (0)
#define PG8_LDA(dst, b, h) do { _Pragma("unroll") for (int m = 0; m < 4; ++m) _Pragma("unroll") for (int k = 0; k < 2; ++k) dst[m][k] = *(const LAS bf16x8*)(lds + PG8_SA(b, h) + aoff + m * 2048 + k * 1024); } while (0)
#define PG8_LDB(dst, b, h) do { _Pragma("unroll") for (int n = 0; n < 2; ++n) _Pragma("unroll") for (int k = 0; k < 2; ++k) dst[n][k] = *(const LAS bf16x8*)(lds + PG8_SB(b, h) + boff + n * 2048 + k * 1024); } while (0)
#define PG8_MMA(ai, bj, At, Bt) do { __builtin_amdgcn_s_setprio(1); _Pragma("unroll") for (int m = 0; m < 4; ++m) _Pragma("unroll") for (int n = 0; n < 2; ++n) _Pragma("unroll") for (int k = 0; k < 2; ++k) \
        acc[ai][bj][m][n] = __builtin_amdgcn_mfma_f32_16x16x32_bf16(Bt[n][k], At[m][k], acc[ai][bj][m][n], 0, 0, 0); __builtin_amdgcn_s_setprio(0); } while (0)
#define PG8_WAIT_V(n) asm volatile("s_waitcnt vmcnt(" #n ")" ::: "memory")
#define PG8_WAIT_L(n) asm volatile("s_waitcnt lgkmcnt(" #n ")" ::: "memory")
#define PG8_BAR __builtin_amdgcn_s_barrier()
#define PG8_SCHED __builtin_amdgcn_sched_barrier(0)
    Unit cur, nxt; int ui = 0; cur.idx = 0;
    if (!S.next(0, cur)) return;
    f32x4 acc[2][2][4][2];
#pragma unroll
    for (int a = 0; a < 2; ++a)
#pragma unroll
        for (int b = 0; b < 2; ++b)
#pragma unroll
            for (int m = 0; m < 4; ++m)
#pragma unroll
                for (int n = 0; n < 2; ++n) acc[a][b][m][n] = (f32x4){0.f, 0.f, 0.f, 0.f};
    bf16x8 At[4][2], B0[2][2], B1[2][2];
    const char* cA; const char* cB; size_t cAH, cBH;
    MPp.ptrs(cur, cA, cAH, cB, cBH);
    PG8_STAGE(PG8_SB(0, 0), cB, voffB); PG8_STAGE(PG8_SB(0, 1), cB + cBH, voffB); PG8_STAGE(PG8_SA(0, 0), cA, voffA); PG8_STAGE(PG8_SA(0, 1), cA + cAH, voffA);
    if (wr == 1) PG8_BAR;
    PG8_WAIT_V(2); PG8_BAR;
    PG8_STAGE(PG8_SB(1, 0), cB + kstep, voffB); PG8_STAGE(PG8_SA(1, 0), cA + kstepA, voffA); PG8_STAGE(PG8_SB(1, 1), cB + cBH + kstep, voffB);
    PG8_WAIT_V(6); PG8_BAR;
    for (;;) {
        const bool has_next = S.next(ui + 1, nxt); nxt.idx = ui + 1;
        const char* nA = cA; const char* nB = cB; size_t nAH = cAH, nBH = cBH;
        if (has_next) MPp.ptrs(nxt, nA, nAH, nB, nBH);
        for (int t = 0; t < nt; t += 2) {
            const bool last = (t == nt - 2);
            const char* a1 = cA + (size_t)(t + 1) * kstepA;
            const char* a2 = last ? nA : cA + (size_t)(t + 2) * kstepA; const char* b2 = last ? nB : cB + (size_t)(t + 2) * kstep;
            const size_t a2H = last ? nAH : cAH, b2H = last ? nBH : cBH;
            const char* a3 = a2 + kstepA; const char* b3 = b2 + kstep;
            PG8_LDB(B0, 0, 0); PG8_LDB(B1, 0, 1); PG8_SCHED; PG8_LDA(At, 0, 0); PG8_STAGE(PG8_SA(1, 1), a1 + cAH, voffA);
            PG8_WAIT_V(8); PG8_WAIT_L(0); PG8_BAR; PG8_MMA(0, 0, At, B0); PG8_MMA(0, 1, At, B1); PG8_BAR; PG8_SCHED;
            PG8_LDA(At, 0, 1); PG8_STAGE(PG8_SB(0, 0), b2, voffB); PG8_STAGE(PG8_SB(0, 1), b2 + b2H, voffB); PG8_STAGE(PG8_SA(0, 0), a2, voffA);
            PG8_WAIT_V(8); PG8_WAIT_L(0); PG8_BAR; PG8_MMA(1, 0, At, B0); PG8_MMA(1, 1, At, B1); PG8_BAR; PG8_SCHED;
            PG8_LDB(B0, 1, 0); PG8_LDB(B1, 1, 1); PG8_SCHED; PG8_LDA(At, 1, 0); PG8_STAGE(PG8_SA(0, 1), a2 + a2H, voffA);
            PG8_WAIT_V(8); PG8_WAIT_L(0); PG8_BAR; PG8_MMA(0, 0, At, B0); PG8_MMA(0, 1, At, B1); PG8_BAR; PG8_SCHED;
            PG8_LDA(At, 1, 1); PG8_STAGE(PG8_SB(1, 0), b3, voffB); PG8_STAGE(PG8_SB(1, 1), b3 + b2H, voffB); PG8_STAGE(PG8_SA(1, 0), a3, voffA);
            PG8_WAIT_V(8); PG8_WAIT_L(0); PG8_BAR; PG8_MMA(1, 0, At, B0); PG8_MMA(1, 1, At, B1); PG8_BAR; PG8_SCHED;
        }
        if (wr == 0) PG8_BAR;
        E(acc, cur, wr, wc, fr, fq);
        if (!has_next) break;
#pragma unroll
        for (int a = 0; a < 2; ++a)
#pragma unroll
            for (int b = 0; b < 2; ++b)
#pragma unroll
                for (int m = 0; m < 4; ++m)
#pragma unroll
                    for (int n = 0; n < 2; ++n) acc[a][b][m][n] = (f32x4){0.f, 0.f, 0.f, 0.f};
        cur = nxt; cA = nA; cB = nB; cAH = nAH; cBH = nBH; ++ui;
        if (wr == 1) PG8_BAR;
    }
    PG8_WAIT_V(0);
    PG8_BAR;
#undef PG8_SA
#undef PG8_SB
#undef PG8_STAGE
#undef PG8_LDA
#undef PG8_LDB
#undef PG8_MMA
#undef PG8_WAIT_V
#undef PG8_WAIT_L
#undef PG8_BAR
#undef PG8_SCHED
}

template <int K> struct MapR5 {
    static constexpr int BMODE = 1;
    const char* A; const char* Bt;
    __device__ __forceinline__ void ptrs(const Unit& u, const char*& a, size_t& aH, const char*& b, size_t& bH) const {
        a = A + (size_t)u.pm * 256 * K * 2; aH = (size_t)128 * 32 * 2;
        b = Bt + (size_t)u.pn * 256 * K * 2; bH = (size_t)32 * 32 * 2; }
};
__host__ __device__ __forceinline__ int fswz(int r) { const int g = (r >> 2) & 3; return g == 0 ? 0 : (g == 1 ? 2 : (g == 2 ? 3 : 1)); }
constexpr int NSTG = 5, STGB = 32768, RINGB = NSTG * STGB, SLICEB = 16384;
template <int K, class Epi, class Map>
__device__ __forceinline__ void gemm_phase_r5(LAS unsigned char* lds, const Map& MPp, const StaticOrder& S, const Epi& E) {
    int tid = threadIdx.x; asm volatile("" : "+v"(tid));
    const int wid = __builtin_amdgcn_readfirstlane(tid >> 6), lane = tid & 63, wr = wid >> 2, wc = wid & 3, fr = lane & 15, fq = lane >> 4;
    constexpr int nt = K / 32;
    const int R = wid * 16 + (lane >> 2), cs = (lane & 3) ^ fswz(lane >> 2);
    const int Rb = (Map::BMODE == 1) ? (64 * (R >> 5) + perm32(R & 31)) : ((R & ~31) + perm32(R & 31));
    const unsigned voffA = (unsigned)(R * 32 + 8 * cs) * 2u, voffB = (unsigned)(Rb * 32 + 8 * cs) * 2u;
    const unsigned ldsw = (unsigned)wid * 1024u;
    const int lrd = fr * 64 + ((fq ^ fswz(fr)) << 4);
    const int aoff = (4 * wr) * 1024 + lrd, boff = 16384 + (2 * wc) * 1024 + lrd;
#define PG8_GLDS(dstoff, gptr) __builtin_amdgcn_global_load_lds((const unsigned*)(gptr), (LAS unsigned*)(lds + (dstoff) + ldsw), 16, 0, 0)
#define PG8_STAGE4(so_, pa, paH, pb, pbH) do { PG8_GLDS((so_), (pa) + voffA); PG8_GLDS((so_) + 8192, (pa) + (paH) + voffA); PG8_GLDS((so_) + 16384, (pb) + voffB); PG8_GLDS((so_) + 24576, (pb) + (pbH) + voffB); } while (0)
#define PG8_WAIT_V(n) asm volatile("s_waitcnt vmcnt(" #n ")" ::: "memory")
#define PG8_WAIT_L(n) asm volatile("s_waitcnt lgkmcnt(" #n ")" ::: "memory")
#define PG8_BAR __builtin_amdgcn_s_barrier()
#define PG8_SCHED __builtin_amdgcn_sched_barrier(0)
    Unit cur, nxt; int ui = 0; cur.idx = 0;
    if (!S.next(0, cur)) return;
    f32x4 acc[2][2][4][2];
#pragma unroll
    for (int a = 0; a < 2; ++a)
#pragma unroll
        for (int b = 0; b < 2; ++b)
#pragma unroll
            for (int m = 0; m < 4; ++m)
#pragma unroll
                for (int n = 0; n < 2; ++n) acc[a][b][m][n] = (f32x4){0.f, 0.f, 0.f, 0.f};
    const char* cA; const char* cB; size_t cAH, cBH;
    MPp.ptrs(cur, cA, cAH, cB, cBH);
#pragma unroll
    for (int j = 0; j < 4; ++j) PG8_STAGE4(j * STGB, cA + (size_t)j * SLICEB, cAH, cB + (size_t)j * SLICEB, cBH);
    if (wr == 1) PG8_BAR;
    PG8_WAIT_V(12); PG8_BAR; PG8_BAR;
    int so = 0, sprev = (NSTG - 1) * STGB;
    for (;;) {
        const bool has_next = S.next(ui + 1, nxt); nxt.idx = ui + 1;
        const char* nA = cA; const char* nB = cB; size_t nAH = cAH, nBH = cBH;
        if (has_next) MPp.ptrs(nxt, nA, nAH, nB, nBH);
#pragma unroll 2
        for (int t = 0; t < nt; ++t) {
            bf16x8 At0[4], At1[4], B0f[2], B1f[2];
#pragma unroll
            for (int n = 0; n < 2; ++n) { B0f[n] = *(const LAS bf16x8*)(lds + so + boff + n * 1024); B1f[n] = *(const LAS bf16x8*)(lds + so + 8192 + boff + n * 1024); }
            PG8_SCHED;
#pragma unroll
            for (int m = 0; m < 4; ++m) { At0[m] = *(const LAS bf16x8*)(lds + so + aoff + m * 1024); At1[m] = *(const LAS bf16x8*)(lds + so + 8192 + aoff + m * 1024); }
            { const bool own = (t + 4 < nt); const int ts = own ? t + 4 : t + 4 - nt;
              const char* sa = (own ? cA : nA) + (size_t)ts * SLICEB; const char* sb = (own ? cB : nB) + (size_t)ts * SLICEB;
              PG8_STAGE4(sprev, sa, own ? cAH : nAH, sb, own ? cBH : nBH); }
            PG8_WAIT_V(12); PG8_WAIT_L(0); PG8_BAR;
            __builtin_amdgcn_s_setprio(1);
#pragma unroll
            for (int m = 0; m < 4; ++m)
#pragma unroll
                for (int n = 0; n < 2; ++n) {
                    acc[0][0][m][n] = __builtin_amdgcn_mfma_f32_16x16x32_bf16(B0f[n], At0[m], acc[0][0][m][n], 0, 0, 0);
                    acc[0][1][m][n] = __builtin_amdgcn_mfma_f32_16x16x32_bf16(B1f[n], At0[m], acc[0][1][m][n], 0, 0, 0);
                    acc[1][0][m][n] = __builtin_amdgcn_mfma_f32_16x16x32_bf16(B0f[n], At1[m], acc[1][0][m][n], 0, 0, 0);
                    acc[1][1][m][n] = __builtin_amdgcn_mfma_f32_16x16x32_bf16(B1f[n], At1[m], acc[1][1][m][n], 0, 0, 0); }
            __builtin_amdgcn_s_setprio(0);
            PG8_BAR; PG8_SCHED;
            sprev = so; so += STGB; if (so == RINGB) so = 0;
        }
        if (wr == 0) PG8_BAR;
        E(acc, cur, wr, wc, fr, fq);
        if (!has_next) break;
#pragma unroll
        for (int a = 0; a < 2; ++a)
#pragma unroll
            for (int b = 0; b < 2; ++b)
#pragma unroll
                for (int m = 0; m < 4; ++m)
#pragma unroll
                    for (int n = 0; n < 2; ++n) acc[a][b][m][n] = (f32x4){0.f, 0.f, 0.f, 0.f};
        cur = nxt; cA = nA; cB = nB; cAH = nAH; cBH = nBH; ++ui;
        if (wr == 1) PG8_BAR;
    }
    PG8_WAIT_V(0);
    PG8_BAR;
#undef PG8_GLDS
#undef PG8_STAGE4
#undef PG8_WAIT_V
#undef PG8_WAIT_L
#undef PG8_BAR
#undef PG8_SCHED
}

typedef const f32x4 (&AccRef)[2][2][4][2];
struct EpiInProj {
    bf16* QKVU; const float* rinv0; const float* qn; const float* kn; float* out;
    __device__ __forceinline__ void operator()(AccRef acc, const Unit& u, int wr, int wc, int fr, int fq) const {
        asm volatile("" : "+v"(fr), "+v"(fq));
        const int pn = u.pn;
        const int cb = 256 * pn + 64 * wc;
        const int kind = pn < 2 ? 0 : (pn == 2 ? (wc < 2 ? 1 : 2) : 3);
        const int g = wc & 1;
        f32x4 gv[2][2];
#pragma unroll
        for (int bj = 0; bj < 2; ++bj)
#pragma unroll
            for (int n = 0; n < 2; ++n) gv[bj][n] = (f32x4){1.f, 1.f, 1.f, 1.f};
        if (kind <= 1) { const float* gp = kind == 0 ? qn : kn; const float sc = kind == 0 ? QSCALE : 1.f;
#pragma unroll
            for (int bj = 0; bj < 2; ++bj)
#pragma unroll
                for (int n = 0; n < 2; ++n) gv[bj][n] = *(const f32x4*)(gp + 32 * bj + 8 * fq + 4 * n) * sc; }
        float rvs[2][4];
#pragma unroll
        for (int ai = 0; ai < 2; ++ai)
#pragma unroll
            for (int m = 0; m < 4; ++m) rvs[ai][m] = rinv0[256 * u.pm + 128 * ai + 64 * wr + 16 * m + fr];
#pragma unroll
        for (int ai = 0; ai < 2; ++ai) {
#pragma unroll
            for (int m = 0; m < 4; ++m) {
                const int rt = 128 * ai + 64 * wr + 16 * m + fr; const int r = 256 * u.pm + rt;
                const float rv = rvs[ai][m];
                f32x4 v[2][2];
#pragma unroll
                for (int bj = 0; bj < 2; ++bj)
#pragma unroll
                    for (int n = 0; n < 2; ++n) v[bj][n] = acc[ai][bj][m][n] * rv;
                if (kind <= 1) {
                    float ss = (sq4(v[0][0]) + sq4(v[0][1])) + (sq4(v[1][0]) + sq4(v[1][1]));
                    ss += __shfl_xor(ss, 16); ss += __shfl_xor(ss, 32);
                    const float rn = rsqrtf(ss * (1.0f / 64.0f) + EPS);
#pragma unroll
                    for (int bj = 0; bj < 2; ++bj)
#pragma unroll
                        for (int n = 0; n < 2; ++n) v[bj][n] = v[bj][n] * rn * gv[bj][n];
                }
                bf16* rowp = QKVU + (size_t)r * EVIN + cb + 8 * fq;
#pragma unroll
                for (int bj = 0; bj < 2; ++bj) *(u32x4*)(rowp + 32 * bj) = pk8(v[bj][0], v[bj][1]);
                if (kind == 1 || kind == 2) {
                    float* dst = nullptr;
                    if (ai == 1 && (u.pm & 63) == 63) { const int bb = u.pm >> 6, j = rt - 128; dst = out + (kind == 1 ? O_KP : O_VP) + ((size_t)(bb * 128 + j) * 2 + g) * 64; }
                    if (dst) {
#pragma unroll
                        for (int bj = 0; bj < 2; ++bj)
#pragma unroll
                            for (int n = 0; n < 2; ++n) *(f32x4*)(dst + 32 * bj + 8 * fq + 4 * n) = v[bj][n]; }
                } else if (kind == 3) {
                    const int ucol = 256 * (pn - 3) + 64 * wc + 8 * fq;
                    float* dst = nullptr;
                    if (ai == 1 && (u.pm & 63) == 63 && rt >= 241) { const int bb = u.pm >> 6; dst = out + O_PP + (size_t)(bb * 15 + rt - 241) * 512 + ucol; }
                    if (dst) {
#pragma unroll
                        for (int bj = 0; bj < 2; ++bj)
#pragma unroll
                            for (int n = 0; n < 2; ++n) *(f32x4*)(dst + 32 * bj + 4 * n) = v[bj][n]; }
                }
            }
        }
    }
};
__device__ __forceinline__ f32x4 bf4_lo(u32x4 w) { return (f32x4){bf_lo(w.x), bf_hi(w.x), bf_lo(w.y), bf_hi(w.y)}; }
__device__ __forceinline__ f32x4 bf4_hi(u32x4 w) { return (f32x4){bf_lo(w.z), bf_hi(w.z), bf_lo(w.w), bf_hi(w.w)}; }
template <int MODE> struct EpiResid {
    const float* xin_f; bf16* XR; float* SS; float* yout;
    __device__ __forceinline__ void operator()(AccRef acc, const Unit& u, int wr, int wc, int fr, int fq) const {
        asm volatile("" : "+v"(fr), "+v"(fq));
        const int c0 = 256 * u.pn + 64 * wc + 8 * fq;
        const size_t rbase = (size_t)256 * u.pm + 64 * wr + fr;
        if (MODE == 0) {
#pragma unroll
            for (int ai = 0; ai < 2; ++ai) {
                f32x4 xr[4][2][2];
#pragma unroll
                for (int m = 0; m < 4; ++m)
#pragma unroll
                    for (int bj = 0; bj < 2; ++bj) { const float* p = xin_f + (rbase + 128 * ai + 16 * m) * DM + c0 + 32 * bj; xr[m][bj][0] = *(const f32x4*)p; xr[m][bj][1] = *(const f32x4*)(p + 4); }
#pragma unroll
                for (int m = 0; m < 4; ++m) { const size_t r = rbase + 128 * ai + 16 * m; float ss = 0.f;
#pragma unroll
                    for (int bj = 0; bj < 2; ++bj) { const f32x4 v0 = acc[ai][bj][m][0] + xr[m][bj][0], v1 = acc[ai][bj][m][1] + xr[m][bj][1]; ss += sq4(v0) + sq4(v1);
                        *(u32x4*)(XR + r * DM + c0 + 32 * bj) = pk8(v0, v1); }
                    ss += __shfl_xor(ss, 16); ss += __shfl_xor(ss, 32); if (fq == 0) SS[r * 16 + 4 * u.pn + wc] = ss; }
            }
        } else {
            u32x4 xr[2][4][2];
#pragma unroll
            for (int ai = 0; ai < 2; ++ai)
#pragma unroll
                for (int m = 0; m < 4; ++m)
#pragma unroll
                    for (int bj = 0; bj < 2; ++bj) xr[ai][m][bj] = *(const u32x4*)(XR + (rbase + 128 * ai + 16 * m) * DM + c0 + 32 * bj);
#pragma unroll
            for (int ai = 0; ai < 2; ++ai)
#pragma unroll
                for (int m = 0; m < 4; ++m) { const size_t r = rbase + 128 * ai + 16 * m; float ss = 0.f;
#pragma unroll
                    for (int bj = 0; bj < 2; ++bj) { const f32x4 v0 = acc[ai][bj][m][0] + bf4_lo(xr[ai][m][bj]), v1 = acc[ai][bj][m][1] + bf4_hi(xr[ai][m][bj]);
                        if (MODE == 1) { ss += sq4(v0) + sq4(v1); *(u32x4*)(XR + r * DM + c0 + 32 * bj) = pk8(v0, v1); }
                        else { float* yp = yout + r * DM + c0 + 32 * bj; *(f32x4*)yp = v0; *(f32x4*)(yp + 4) = v1; } }
                    if (MODE == 1) { ss += __shfl_xor(ss, 16); ss += __shfl_xor(ss, 32); if (fq == 0) SS[r * 16 + 4 * u.pn + wc] = ss; } }
        }
    }
};
__device__ __forceinline__ float row_rinv(const float* SS, size_t r, int fq) {
    const f32x4 s4 = *(const f32x4*)(SS + r * 16 + 4 * fq); float s = (s4[0] + s4[1]) + (s4[2] + s4[3]);
    s += __shfl_xor(s, 16); s += __shfl_xor(s, 32);
    return rsqrtf(s * (1.0f / 1024.0f) + EPS);
}
__device__ __forceinline__ void rows_rinv(const float* SS, size_t rbase, int fq, float (&rv)[2][4]) {
    f32x4 s4[2][4];
#pragma unroll
    for (int ai = 0; ai < 2; ++ai)
#pragma unroll
        for (int m = 0; m < 4; ++m) s4[ai][m] = *(const f32x4*)(SS + (rbase + 128 * ai + 16 * m) * 16 + 4 * fq);
#pragma unroll
    for (int ai = 0; ai < 2; ++ai)
#pragma unroll
        for (int m = 0; m < 4; ++m) { float t = (s4[ai][m][0] + s4[ai][m][1]) + (s4[ai][m][2] + s4[ai][m][3]); t += __shfl_xor(t, 16); t += __shfl_xor(t, 32); rv[ai][m] = rsqrtf(t * (1.0f / 1024.0f) + EPS); }
}
struct EpiUp {
    bf16* H; const LAS float* rvt; const float* SS; int rsh;
    __device__ __forceinline__ void operator()(AccRef acc, const Unit& u, int wr, int wc, int fr, int fq) const {
        asm volatile("" : "+v"(fr), "+v"(fq));
        const int c0 = 256 * u.pn + 64 * wc + 8 * fq;
        float rvs[2][4];
        if ((u.idx >> rsh) < RVT_UNITS_) {
#pragma unroll
            for (int ai = 0; ai < 2; ++ai)
#pragma unroll
                for (int m = 0; m < 4; ++m) rvs[ai][m] = rvt[(u.idx >> rsh) * 256 + 128 * ai + 64 * wr + 16 * m + fr];
        } else rows_rinv(SS, (size_t)256 * u.pm + 64 * wr + fr, fq, rvs);
#pragma unroll
        for (int ai = 0; ai < 2; ++ai) {
#pragma unroll
            for (int m = 0; m < 4; ++m) {
                const size_t r = (size_t)256 * u.pm + 128 * ai + 64 * wr + 16 * m + fr;
                const float rv = rvs[ai][m];
#pragma unroll
                for (int bj = 0; bj < 2; ++bj) {
                    f32x4 v0 = acc[ai][bj][m][0] * rv, v1 = acc[ai][bj][m][1] * rv;
#pragma unroll
                    for (int i = 0; i < 4; ++i) { const float a = fmaxf(v0[i], 0.f), b = fmaxf(v1[i], 0.f); v0[i] = a * a; v1[i] = b * b; }
                    __builtin_nontemporal_store(pk8(v0, v1), (u32x4*)(H + (size_t)u.pm * 256 * DFF + (size_t)(8 * u.pn + 2 * wc + bj) * 8192 + (size_t)(128 * ai + 64 * wr + 16 * m + fr) * 32 + 8 * fq));
                }
            }
        }
    }
};
struct EpiConvE {
    bf16* BE; const LAS float* rvt; const float* SS; float* out; int rsh;
    __device__ __forceinline__ void operator()(AccRef acc, const Unit& u, int wr, int wc, int fr, int fq) const {
        asm volatile("" : "+v"(fr), "+v"(fq));
        float rvs[2][4];
        if ((u.idx >> rsh) < RVT_UNITS_) {
#pragma unroll
            for (int ai = 0; ai < 2; ++ai)
#pragma unroll
                for (int m = 0; m < 4; ++m) rvs[ai][m] = rvt[(u.idx >> rsh) * 256 + 128 * ai + 64 * wr + 16 * m + fr];
        } else rows_rinv(SS, (size_t)256 * u.pm + 64 * wr + fr, fq, rvs);
        const int ch0 = 128 * u.pn + 32 * wc + 8 * fq;
#pragma unroll
        for (int ai = 0; ai < 2; ++ai) {
#pragma unroll
            for (int m = 0; m < 4; ++m) {
                const int rt = 128 * ai + 64 * wr + 16 * m + fr; const size_t r = (size_t)256 * u.pm + rt;
                const float rv = rvs[ai][m];
                const f32x4 e0 = (acc[ai][0][m][0] * rv) * (acc[ai][1][m][0] * rv), e1 = (acc[ai][0][m][1] * rv) * (acc[ai][1][m][1] * rv);
                *(u32x4*)(BE + be_off(r, 1024 + ch0)) = pk8(e0, e1);
                float* dst = nullptr;
                if (ai == 1 && (u.pm & 63) == 63 && rt >= 254) { const int bb = u.pm >> 6; dst = out + O_CP + (size_t)(bb * 2 + rt - 254) * 1024 + ch0; }
                if (dst) { *(f32x4*)dst = e0; *(f32x4*)(dst + 4) = e1; }
            }
        }
    }
};
struct EpiConvB {
    unsigned char* ws; const float* cw; const LAS float* rvt; int tsh;
    __device__ __forceinline__ void operator()(AccRef acc, const Unit& u, int wr, int wc, int fr, int fq) const {
        asm volatile("" : "+v"(fr), "+v"(fq));
        const bf16* BE = (const bf16*)(ws + WS_H_OFF); bf16* S0 = (bf16*)(ws + WS_S0_OFF);
        const int tslot = u.idx << tsh; const LAS float* rvp = rvt + (tslot < RVT_UNITS_ ? tslot : 0) * 256 + 64 * wr + fr;
        const unsigned rb = 256u * (unsigned)u.pm + 64u * (unsigned)wr + (unsigned)fr;
#pragma unroll
        for (int bj = 0; bj < 2; ++bj) {
            const int ch0 = 256 * u.pn + 128 * bj + 32 * wc + 8 * fq;
            const u32x4 W0 = pk8(*(const f32x4*)(cw + ch0), *(const f32x4*)(cw + ch0 + 4)), W1 = pk8(*(const f32x4*)(cw + DM + ch0), *(const f32x4*)(cw + DM + ch0 + 4)),
                        W2 = pk8(*(const f32x4*)(cw + 2 * DM + ch0), *(const f32x4*)(cw + 2 * DM + ch0 + 4));
#define ECB_OFF(r_) ((((r_) >> 8) * (unsigned)(256 * 2048) + (unsigned)((1024 + ch0) >> 5) * 8192u + ((r_) & 255u) * 32u + (unsigned)(ch0 & 31)) * 2u)
#define ECB_LDX(k_) (*(const u32x4*)((const char*)BE + ECB_OFF(rb + 128u * ((k_) >> 2) + 16u * ((k_) & 3))))
#define ECB_LDH(ai_) (*(const u32x4*)((const char*)BE + ECB_OFF((rb - (unsigned)fr + 128u * (ai_) >= 16u ? rb + 128u * (ai_) - 16u : rb + 128u * (ai_)))))
#define ECB_S1(p_, x_) (unsigned)__builtin_amdgcn_update_dpp(__builtin_amdgcn_mov_dpp((int)(p_), 0x121, 0xf, 0xf, false), (int)(x_), 0x111, 0xf, 0xf, false)
#define ECB_S2(p_, x_) (unsigned)__builtin_amdgcn_update_dpp(__builtin_amdgcn_mov_dpp((int)(p_), 0x122, 0xf, 0xf, false), (int)(x_), 0x112, 0xf, 0xf, false)
            u32x4 xc = ECB_LDX(0), xn = xc, pv = ECB_LDH(0), h4 = ECB_LDH(1);
#pragma unroll
            for (int k = 0; k < 8; ++k) {
                if (k + 1 < 8) xn = ECB_LDX(k + 1);
                if (k == 4) pv = h4;
                const int ai = k >> 2, m = k & 3; const unsigned r = rb + 128u * ai + 16u * m; const unsigned pos = r & (unsigned)(SEQ - 1);
                u32x4 x1, x2;
                x1.x = ECB_S1(pv.x, xc.x); x1.y = ECB_S1(pv.y, xc.y); x1.z = ECB_S1(pv.z, xc.z); x1.w = ECB_S1(pv.w, xc.w);
                x2.x = ECB_S2(pv.x, xc.x); x2.y = ECB_S2(pv.y, xc.y); x2.z = ECB_S2(pv.z, xc.z); x2.w = ECB_S2(pv.w, xc.w);
                const f32x4 z4 = {0.f, 0.f, 0.f, 0.f};
                const f32x4 e0a = bf4_lo(xc), e0b = bf4_hi(xc);
                const f32x4 e1a = pos >= 1u ? bf4_lo(x1) : z4, e1b = pos >= 1u ? bf4_hi(x1) : z4;
                const f32x4 e2a = pos >= 2u ? bf4_lo(x2) : z4, e2b = pos >= 2u ? bf4_hi(x2) : z4;
                const f32x4 ya = bf4_lo(W0) * e2a + bf4_lo(W1) * e1a + bf4_lo(W2) * e0a, yb = bf4_hi(W0) * e2b + bf4_hi(W1) * e1b + bf4_hi(W2) * e0b;
                const float rv = (tslot < RVT_UNITS_) ? rvp[128 * ai + 16 * m] : row_rinv((const float*)(ws + WS_SS_OFF), (size_t)r, fq);
                *(u32x4*)((char*)S0 + (r * (unsigned)DM + (unsigned)ch0) * 2u) = pk8((acc[ai][bj][m][0] * rv) * ya, (acc[ai][bj][m][1] * rv) * yb);
                pv = xc; xc = xn;
            }
#undef ECB_LDX
#undef ECB_LDH
#undef ECB_S1
#undef ECB_S2
#undef ECB_OFF
        }
    }
};
}


template <int K, int NF, int KS, class BRow, class Epi>
__device__ __forceinline__ void sample_gemm(LAS unsigned char* lds, const bf16* As, const int n_items, const int first, const int stride, const BRow& brow, const Epi& E, int lane, const int wave) {
    asm volatile("" : "+v"(lane));
    const int fr = lane & 15, fq = lane >> 4;
    constexpr int KQ = K / KS, UPI = (KS == 4) ? 4 : 8;
    for (int un = first; un < n_items * UPI; un += stride) {
        const int item = (KS == 4) ? (un >> 2) : (un >> 3), rg = (KS == 4) ? (un & 3) : ((un >> 1) & 3), mf = (KS == 4) ? (wave & 1) : (un & 1), kq = (KS == 4) ? (wave >> 1) : wave, mfs = (KS == 4) ? mf : 0;
        const int row = 32 * rg + 16 * mf + fr;
        const bf16* ap = As + (size_t)row * K + kq * KQ + 8 * fq;
        const bf16* bp[NF];
#pragma unroll
        for (int nf = 0; nf < NF; ++nf) bp[nf] = brow.base(item, nf, fr, kq * KQ, fq);
        f32x4 acc[NF];
#pragma unroll
        for (int nf = 0; nf < NF; ++nf) acc[nf] = (f32x4){0.f, 0.f, 0.f, 0.f};
        typename Epi::Pre pre = {};
        if (kq == 0) pre = E.pre(item, row, fr, fq);
#pragma unroll 8
        for (int ks = 0; ks < KQ / 32; ++ks) {
            const bf16x8 a = *(const bf16x8*)(ap + 32 * ks);
#pragma unroll
            for (int nf = 0; nf < NF; ++nf) { const bf16x8 b = *(const bf16x8*)(bp[nf] + brow.step(ks)); acc[nf] = __builtin_amdgcn_mfma_f32_16x16x32_bf16(b, a, acc[nf], 0, 0, 0); }
        }
        LAS f32x4* red = (LAS f32x4*)lds;
        if (kq > 0) {
#pragma unroll
            for (int nf = 0; nf < NF; ++nf) red[(((kq - 1) * 2 + mfs) * 64 + lane) * NF + nf] = acc[nf]; }
        __syncthreads();
        if (kq == 0) {
#pragma unroll
            for (int q = 0; q < KS - 1; ++q)
#pragma unroll
                for (int nf = 0; nf < NF; ++nf) acc[nf] += red[((q * 2 + mfs) * 64 + lane) * NF + nf];
            E(item, row, fr, fq, acc, pre);
        }
        __syncthreads();
    }
}
struct BRowPlain { const bf16* Bt; int K, NF;
    __device__ __forceinline__ const bf16* base(int item, int nf, int fr, int k0, int fq) const { return Bt + (size_t)((item * NF + nf) * 16 + fr) * K + k0 + 8 * fq; }
    __device__ __forceinline__ int step(int ks) const { return 32 * ks; } };
struct BRowB32 { const bf16* Bt; int K, NF;
    __device__ __forceinline__ const bf16* base(int item, int nf, int fr, int k0, int fq) const { const int n = (item * NF + nf) * 16 + fr; return Bt + (size_t)(n >> 8) * 256 * K + (size_t)(k0 >> 5) * 8192 + (size_t)(n & 255) * 32 + 8 * fq; }
    __device__ __forceinline__ int step(int ks) const { return ks * 8192; } };
struct BRowConvIn { const bf16* Bt;
    __device__ __forceinline__ const bf16* base(int item, int nf, int fr, int k0, int fq) const { return Bt + (size_t)(1024 * nf + 16 * item + fr) * DM + k0 + 8 * fq; }
    __device__ __forceinline__ int step(int ks) const { return 32 * ks; } };
struct SEpiInProj {
    bf16* QKVU; const float* rinv0; const float* qn; const float* kn; float* out;
    struct Pre { float rv; };
    __device__ __forceinline__ Pre pre(int item, int row, int fr, int fq) const { Pre p; p.rv = rinv0[(size_t)MPR + row]; return p; }
    __device__ __forceinline__ void operator()(int item, int row, int fr, int fq, f32x4 (&acc)[4], const Pre& pr) const {
        const int kind = item < 8 ? 0 : (item < 10 ? 1 : (item < 12 ? 2 : 3)), g = item & 1;
        const size_t r = (size_t)MPR + row; const float rv = pr.rv;
        f32x4 v[4];
#pragma unroll
        for (int nf = 0; nf < 4; ++nf) v[nf] = acc[nf] * rv;
        if (kind <= 1) {
            float ss = (sq4(v[0]) + sq4(v[1])) + (sq4(v[2]) + sq4(v[3]));
            ss += __shfl_xor(ss, 16); ss += __shfl_xor(ss, 32);
            const float rn = rsqrtf(ss * (1.0f / 64.0f) + EPS) * (kind == 0 ? QSCALE : 1.f); const float* gp = (kind == 0 ? qn : kn) + 4 * fq;
#pragma unroll
            for (int nf = 0; nf < 4; ++nf) v[nf] = v[nf] * rn * *(const f32x4*)(gp + 16 * nf);
        }
        bf16* rowp = QKVU + r * EVIN + 64 * item + 4 * fq;
#pragma unroll
        for (int nf = 0; nf < 4; ++nf) { u32x2 w; w.x = pk2(v[nf][0], v[nf][1]); w.y = pk2(v[nf][2], v[nf][3]); *(u32x2*)(rowp + 16 * nf) = w; }
        const int b = row >> 4, i16 = row & 15;
        float* dst = nullptr;
        if (kind == 1 || kind == 2) dst = out + (kind == 1 ? O_KS : O_VS) + ((size_t)(b * 128 + 112 + i16) * 2 + g) * 64 + 4 * fq;
        else if (kind == 3 && i16 >= 1) dst = out + O_PS + (size_t)(b * 15 + i16 - 1) * 512 + 64 * (item - 12) + 4 * fq;
        if (dst) {
#pragma unroll
            for (int nf = 0; nf < 4; ++nf) *(f32x4*)(dst + 16 * nf) = v[nf]; }
    }
};
template <int MODE, int NF> struct SEpiResid {
    const float* xin_f; bf16* XR; float* SSS; float* yout;
    struct Pre { u32x2 w[NF]; };
    __device__ __forceinline__ Pre pre(int item, int row, int fr, int fq) const { Pre p;
#pragma unroll
        for (int nf = 0; nf < NF; ++nf) p.w[nf] = *(const u32x2*)(XR + ((size_t)MPR + row) * DM + 16 * NF * item + 4 * fq + 16 * nf);
        return p; }
    __device__ __forceinline__ void operator()(int item, int row, int fr, int fq, f32x4 (&acc)[NF], const Pre& pr) const {
        const size_t r = (size_t)MPR + row; const int c = 16 * NF * item + 4 * fq;
        float ss = 0.f;
#pragma unroll
        for (int nf = 0; nf < NF; ++nf) {
            f32x4 x;
            if (MODE == 0) x = *(const f32x4*)(xin_f + (size_t)row * DM + c + 16 * nf);
            else { const u32x2 w = pr.w[nf]; x[0] = bf_lo(w.x); x[1] = bf_hi(w.x); x[2] = bf_lo(w.y); x[3] = bf_hi(w.y); }
            const f32x4 v = acc[nf] + x;
            if (MODE == 2) *(f32x4*)(yout + (size_t)row * DM + c + 16 * nf) = v;
            else { ss += sq4(v); u32x2 w; w.x = pk2(v[0], v[1]); w.y = pk2(v[2], v[3]); *(u32x2*)(XR + r * DM + c + 16 * nf) = w; }
        }
        if (MODE != 2) { static_assert(MODE == 2 || NF == 2, "32-slot layout"); ss += __shfl_xor(ss, 16); ss += __shfl_xor(ss, 32); if (fq == 0) SSS[row * 32 + item] = ss; }
    }
};
struct SRowPre { f32x4 a, b; };
__device__ __forceinline__ SRowPre srow_pre(const float* SSS, int row, int fq) { SRowPre p; p.a = *(const f32x4*)(SSS + row * 32 + 8 * fq); p.b = *(const f32x4*)(SSS + row * 32 + 8 * fq + 4); return p; }
__device__ __forceinline__ float srow_rinv(const SRowPre& p) {
    float s = ((p.a[0] + p.a[1]) + (p.a[2] + p.a[3])) + ((p.b[0] + p.b[1]) + (p.b[2] + p.b[3]));
    s += __shfl_xor(s, 16); s += __shfl_xor(s, 32);
    return rsqrtf(s * (1.0f / 1024.0f) + EPS);
}
struct SEpiUp {
    bf16* H; const float* SS;
    typedef SRowPre Pre;
    __device__ __forceinline__ Pre pre(int item, int row, int fr, int fq) const { return srow_pre(SS, row, fq); }
    __device__ __forceinline__ void operator()(int item, int row, int fr, int fq, f32x4 (&acc)[4], const Pre& pr) const {
        const size_t r = (size_t)MPR + row; const float rv = srow_rinv(pr);
#pragma unroll
        for (int nf = 0; nf < 4; ++nf) { f32x4 v = acc[nf] * rv;
#pragma unroll
            for (int i = 0; i < 4; ++i) { const float a = fmaxf(v[i], 0.f); v[i] = a * a; }
            u32x2 w; w.x = pk2(v[0], v[1]); w.y = pk2(v[2], v[3]); *(u32x2*)(H + r * DFF + 64 * item + 16 * nf + 4 * fq) = w; }
    }
};
struct SEpiConvIn {
    bf16* BE; const float* SS; float* out;
    typedef SRowPre Pre;
    __device__ __forceinline__ Pre pre(int item, int row, int fr, int fq) const { return srow_pre(SS, row, fq); }
    __device__ __forceinline__ void operator()(int item, int row, int fr, int fq, f32x4 (&acc)[3], const Pre& pr) const {
        const size_t r = (size_t)MPR + row; const float rv = srow_rinv(pr);
        const int ch0 = 16 * item + 4 * fq;
        { const f32x4 v = acc[0] * rv; u32x2 w; w.x = pk2(v[0], v[1]); w.y = pk2(v[2], v[3]); *(u32x2*)(BE + r * 2048 + ch0) = w; }
        const f32x4 e = (acc[1] * rv) * (acc[2] * rv);
        u32x2 w; w.x = pk2(e[0], e[1]); w.y = pk2(e[2], e[3]); *(u32x2*)(BE + r * 2048 + 1024 + ch0) = w;
        const int b = row >> 4, i16 = row & 15;
        if (i16 >= 14) *(f32x4*)(out + O_CS + (size_t)(b * 2 + i16 - 14) * 1024 + ch0) = e;
    }
};

#define XB_TMO      128
#define XB_XCNT(j)  (256  + 64 * (j))
#define XB_XSUB(j)  (1280 + 64 * (j))
#define XB_XGEN(j)  (2304 + 64 * (j))
#define XB_TOP      3328
#define XB_TOPGEN   3392
#define XCD_BAR_WORDS 3456
#define XB_SPIN_CAP (1u << 18)
__device__ __forceinline__ unsigned xb_ld(unsigned* p)              { return __hip_atomic_load(p, __ATOMIC_RELAXED, __HIP_MEMORY_SCOPE_AGENT); }
__device__ __forceinline__ unsigned xb_add(unsigned* p, unsigned v) { return __hip_atomic_fetch_add(p, v, __ATOMIC_RELAXED, __HIP_MEMORY_SCOPE_AGENT); }
__device__ __forceinline__ unsigned xb_xcc_id() { return (unsigned)__builtin_amdgcn_s_getreg((3 << 11) | 20) & 0xFu; }
#define XB_SPIN(cond, bar) do { unsigned _sp = 0; while (cond) { __builtin_amdgcn_s_sleep(1); \
    if ((++_sp & 255u) == 0u) { if (xb_ld(&(bar)[XB_TMO])) break; if (_sp > XB_SPIN_CAP) { atomicAdd(&(bar)[XB_TMO], 1u); break; } } } } while (0)
struct XcdBarrier { unsigned* bar; unsigned x; volatile LAS unsigned* st; };
__device__ __forceinline__ XcdBarrier xcd_barrier_post(unsigned* bar, volatile LAS unsigned* st) {
    XcdBarrier b; b.bar = bar; b.x = xb_xcc_id(); b.st = st;
    if (threadIdx.x == 0) (void)xb_add(&bar[XB_XCNT(b.x)], 1u);
    return b;
}
__device__ __forceinline__ void xcd_barrier_complete(unsigned* bar, unsigned x, unsigned& nloc, unsigned& nx) {
    const unsigned G = gridDim.x * gridDim.y * gridDim.z;
    unsigned sum, cnt, mine, sp = 0u;
    for (;;) {
        sum = 0u; cnt = 0u; mine = 0u;
#pragma unroll
        for (unsigned j = 0; j < 16; ++j) { const unsigned c = xb_ld(&bar[XB_XCNT(j)]); sum += c; cnt += (c > 0u) ? 1u : 0u; mine = (j == x) ? c : mine; }
        if (sum == G) break;
        __builtin_amdgcn_s_sleep(1);
        if ((++sp & 255u) == 0u) { if (xb_ld(&bar[XB_TMO])) break; if (sp > XB_SPIN_CAP) { atomicAdd(&bar[XB_TMO], 1u); break; } }
    }
    nloc = mine > 0u ? mine : 1u; nx = cnt > 0u ? cnt : 1u;
}
__device__ __forceinline__ void xcd_barrier(const XcdBarrier& b) {
    asm volatile("s_waitcnt vmcnt(0)" ::: "memory");
    __syncthreads();
    if (threadIdx.x == 0) {
        unsigned* bar = b.bar; asm volatile("" : "+s"(bar));
        __builtin_amdgcn_s_waitcnt(0);
        unsigned nloc = b.st[0], nx = b.st[1];
        if (nloc == 0u) { xcd_barrier_complete(bar, b.x, nloc, nx); b.st[0] = nloc; b.st[1] = nx; }
        const unsigned old = xb_add(&bar[XB_XSUB(b.x)], 1u);
        const unsigned gen = old / nloc;
        if (old + 1u == (gen + 1u) * nloc) {
            __builtin_amdgcn_fence(__ATOMIC_RELEASE, "agent");
            asm volatile("s_waitcnt vmcnt(0)" ::: "memory");
            const unsigned og = xb_add(&bar[XB_TOP], 1u);
            const unsigned tg = og / nx;
            __builtin_amdgcn_fence(__ATOMIC_ACQUIRE, "agent");
            if (og + 1u == (tg + 1u) * nx) xb_add(&bar[XB_TOPGEN], 1u);
            else XB_SPIN(xb_ld(&bar[XB_TOPGEN]) == tg, bar);
            xb_add(&bar[XB_XGEN(b.x)], 1u);
            asm volatile("s_waitcnt vmcnt(0)" ::: "memory");
        } else {
            __builtin_amdgcn_fence(__ATOMIC_ACQUIRE, "agent");
            XB_SPIN(xb_ld(&bar[XB_XGEN(b.x)]) == gen, bar);
            asm volatile("s_waitcnt vmcnt(0)" ::: "memory");
        }
    }
    __syncthreads();
}

constexpr int RING_OFF = 0, RING_BYTES = 131072;
constexpr int LDSCTL_OFF = RING_BYTES, MISC_OFF = LDSCTL_OFF + 320;
constexpr int RVT_OFF = LDSCTL_OFF + 512, RVT_UNITS = pg8::RVT_UNITS_;
constexpr int LDS_BYTES = 163840;
constexpr int AT_KL = 0, AT_VL = 24576, AT_BIAS = 49152, AT_WSF = 57344, AT_OST = 59392;
constexpr int PL_D = 0, PL_W = 32768;

__device__ __forceinline__ void build_row_scales(LAS unsigned char* lds, const pg8::StaticOrder& S, const float* SS, const int rsh = 0) {
    int tid = threadIdx.x; asm volatile("" : "+v"(tid));
    LAS float* tab = (LAS float*)(lds + RVT_OFF);
    const int half = tid >> 8, t = tid & 255;
    for (int i0 = 0; i0 < RVT_UNITS; i0 += 4) {
        f32x4 p[2][4]; bool ok[2];
#pragma unroll
        for (int j = 0; j < 2; ++j) { pg8::Unit u; ok[j] = S.next((i0 + 2 * j + half) << rsh, u); const size_t r = ok[j] ? (size_t)256 * u.pm + t : 0;
#pragma unroll
            for (int q = 0; q < 4; ++q) p[j][q] = *(const f32x4*)(SS + r * 16 + 4 * q); }
#pragma unroll
        for (int j = 0; j < 2; ++j) if (ok[j]) { const f32x4 a = (p[j][0] + p[j][1]) + (p[j][2] + p[j][3]); tab[(i0 + 2 * j + half) * 256 + t] = rsqrtf(((a[0] + a[1]) + (a[2] + a[3])) * (1.0f / 1024.0f) + EPS); }
        pg8::Unit u2; if (!S.next((i0 + 4) << rsh, u2)) break;
    }
    __syncthreads();
}

template <bool GAIN, bool B32 = false, bool NGAIN = false>
__device__ __forceinline__ void transpose_item(const float* W, int K, int N, bf16* WT, const float* gain, LAS float* scr, int item, int lane) {
    const int nblk = N / 64, kb = item / nblk, nb = item % nblk, k0 = 64 * kb, n0 = 64 * nb;
    float wv[64];
    const float* wp = W + (size_t)k0 * N + n0 + lane;
#pragma unroll
    for (int i = 0; i < 64; ++i) wv[i] = wp[(size_t)i * N];
    float gl = 1.f; if (GAIN) gl = gain[k0 + lane];
    float gn = 1.f; if (NGAIN) gn = gain[n0 + lane];
#pragma unroll
    for (int i = 0; i < 64; ++i) { const float gk = GAIN ? __shfl(gl, i) : (NGAIN ? gn : 1.f); scr[i * 64 + (lane ^ i)] = wv[i] * gk; }
    LDS_WAIT(); asm volatile("" ::: "memory");
    const int c = lane & 7;
#pragma unroll
    for (int j = 0; j < 8; ++j) { const int n = (lane >> 3) + 8 * j;
#define TI_S(q_) scr[(8 * c + (q_)) * 64 + (n ^ (8 * c + (q_)))]
        u32x4 o; o.x = pk2(TI_S(0), TI_S(1)); o.y = pk2(TI_S(2), TI_S(3)); o.z = pk2(TI_S(4), TI_S(5)); o.w = pk2(TI_S(6), TI_S(7));
#undef TI_S
        if (B32) { const int kk = k0 + 8 * c, nn = n0 + n; *(u32x4*)(WT + (size_t)(nn >> 8) * 256 * K + (size_t)(kk >> 5) * 8192 + (size_t)(nn & 255) * 32 + (kk & 31)) = o; }
        else *(u32x4*)(WT + (size_t)(n0 + n) * K + k0 + 8 * c) = o; }
    LDS_WAIT(); asm volatile("" ::: "memory");
}

__device__ __forceinline__ int crow(int r, int hi) { return (r & 3) + 8 * (r >> 2) + 4 * hi; }
__device__ __forceinline__ void pv64(f32x16* o, int vb, bf16x8 pa0, bf16x8 pa1, bf16x8 pa2, bf16x8 pa3) {
#pragma unroll
    for (int d0 = 0; d0 < 2; ++d0) { s16x4 lo[4], hi[4];
#pragma unroll
        for (int ks = 0; ks < 4; ++ks) {
            asm volatile("ds_read_b64_tr_b16 %0,%1 offset:%c2" : "=&v"(lo[ks]) : "v"(vb), "i"(d0 * 4096 + ks * 1024) : "memory");
            asm volatile("ds_read_b64_tr_b16 %0,%1 offset:%c2" : "=&v"(hi[ks]) : "v"(vb), "i"(d0 * 4096 + ks * 1024 + 512) : "memory"); }
        asm volatile("s_waitcnt lgkmcnt(0)" ::: "memory"); __builtin_amdgcn_sched_barrier(0);
#define PK(k) (bf16x8){lo[k][0], lo[k][1], lo[k][2], lo[k][3], hi[k][0], hi[k][1], hi[k][2], hi[k][3]}
        o[d0] = __builtin_amdgcn_mfma_f32_32x32x16_bf16(pa0, PK(0), o[d0], 0, 0, 0);
        o[d0] = __builtin_amdgcn_mfma_f32_32x32x16_bf16(pa1, PK(1), o[d0], 0, 0, 0);
        o[d0] = __builtin_amdgcn_mfma_f32_32x32x16_bf16(pa2, PK(2), o[d0], 0, 0, 0);
        o[d0] = __builtin_amdgcn_mfma_f32_32x32x16_bf16(pa3, PK(3), o[d0], 0, 0, 0);
#undef PK
    }
}
__device__ __forceinline__ void attn_unit(LAS unsigned char* lds, const bf16* QKVU, bf16* MIX, const float* cache_k, const float* cache_v, const float* sinks,
                                          const int samp, const int b, const int c, const int g, const int wid) {
    int tid = threadIdx.x; asm volatile("" : "+v"(tid)); const int lane = tid & 63;
    LAS unsigned char* kl = lds + AT_KL; LAS unsigned char* vl = lds + AT_VL;
    u32x4 kvr[3], vvr[3];
    if (!samp) {
#pragma unroll
        for (int i = 0; i < 3; ++i) {
            const int p = tid + 512 * i, key = p >> 3, ch = p & 7;
            long t = 64 * (c - 2) + key; if (t < 0) t = 0;
            const bf16* rowp = QKVU + ((size_t)b * SEQ + (size_t)t) * EVIN;
            kvr[i] = *(const u32x4*)(rowp + 512 + 64 * g + 8 * ch); vvr[i] = *(const u32x4*)(rowp + 640 + 64 * g + 8 * ch);
        }
    } else {
        f32x4 ck[2][2], cv[2][2];
#pragma unroll
        for (int i = 0; i < 2; ++i) { const int p = tid + 512 * i, key = p >> 3, ch = p & 7; const size_t o = ((size_t)(b * 128 + key) * 2 + g) * 64 + 8 * ch;
            ck[i][0] = *(const f32x4*)(cache_k + o); ck[i][1] = *(const f32x4*)(cache_k + o + 4); cv[i][0] = *(const f32x4*)(cache_v + o); cv[i][1] = *(const f32x4*)(cache_v + o + 4); }
        { const int p = tid + 1024, key = p >> 3, ch = p & 7; const int kk = key < 144 ? key - 128 : 0;
          const bf16* rowp = QKVU + (size_t)(MPR + 16 * b + kk) * EVIN;
          kvr[2] = *(const u32x4*)(rowp + 512 + 64 * g + 8 * ch); vvr[2] = *(const u32x4*)(rowp + 640 + 64 * g + 8 * ch);
          if (key >= 144) { kvr[2] = (u32x4){0u, 0u, 0u, 0u}; vvr[2] = kvr[2]; } }
#pragma unroll
        for (int i = 0; i < 2; ++i) { kvr[i] = pk8(ck[i][0], ck[i][1]); vvr[i] = pk8(cv[i][0], cv[i][1]); }
    }
#pragma unroll
    for (int i = 0; i < 3; ++i) {
        const int p = tid + 512 * i, key = p >> 3, ch = p & 7;
        *(LAS u32x4*)(kl + (key >> 6) * 8192 + ch * 1024 + (key & 63) * 16) = kvr[i];
        *(LAS u32x4*)(vl + (key >> 6) * 8192 + (ch >> 2) * 4096 + ((key & 63) >> 4) * 1024 + (key & 15) * 64 + (ch & 3) * 16) = vvr[i];
    }
    const int hl = wid >> 1, qh = wid & 1, r32 = lane & 31, hi = lane >> 5, head = 4 * g + hl;
    const int q = samp ? (r32 & 15) : (32 * qh + r32);
    const size_t qrow = samp ? (size_t)(MPR + 16 * b + (r32 & 15)) : ((size_t)b * SEQ + 64 * c + q);
    const bf16* qp = QKVU + qrow * EVIN + 64 * head + 8 * hi;
    bf16x8 qr[4];
#pragma unroll
    for (int d0 = 0; d0 < 4; ++d0) qr[d0] = *(const bf16x8*)(qp + 16 * d0);
    __syncthreads();
    const LAS float* bt = (const LAS float*)(lds + AT_BIAS) + head * 256 + 63 - q;
    f32x16 p[6];
#pragma unroll
    for (int kt = 0; kt < 6; ++kt)
#pragma unroll
        for (int r = 0; r < 16; ++r) p[kt][r] = bt[32 * kt + crow(r, hi)];
#pragma unroll
    for (int kt = 0; kt < 6; ++kt) {
        const LAS unsigned char* kb = kl + (kt >> 1) * 8192 + hi * 1024 + ((kt & 1) * 32 + r32) * 16;
#pragma unroll
        for (int d0 = 0; d0 < 4; ++d0) { const bf16x8 kf = *(const LAS bf16x8*)(kb + d0 * 2048); p[kt] = __builtin_amdgcn_mfma_f32_32x32x16_bf16(kf, qr[d0], p[kt], 0, 0, 0); }
    }
    const int j0 = samp ? 0 : (c >= 2 ? 0 : 128 - 64 * c), j1 = samp ? 144 : 192;
    if (j0 > 0 || j1 < 192) {
#pragma unroll
        for (int kt = 0; kt < 6; ++kt)
#pragma unroll
            for (int r = 0; r < 16; ++r) { const int j = 32 * kt + crow(r, hi); if (j < j0 || j >= j1) p[kt][r] = -1e30f; }
    }
    const float sk = sinks[head] * LOG2E;
    float mx = sk;
#pragma unroll
    for (int kt = 0; kt < 6; ++kt)
#pragma unroll
        for (int r = 0; r < 16; ++r) mx = fmaxf(mx, p[kt][r]);
    mx = fmaxf(mx, __shfl_xor(mx, 32));
    float sum = 0.f;
#pragma unroll
    for (int kt = 0; kt < 6; ++kt)
#pragma unroll
        for (int r = 0; r < 16; ++r) { const float e = __builtin_amdgcn_exp2f(p[kt][r] - mx); p[kt][r] = e; sum += e; }
    sum += __shfl_xor(sum, 32);
    const float inv = 1.0f / (sum + __builtin_amdgcn_exp2f(sk - mx));
    f32x16 o[2]; o[0] = f32x16{}; o[1] = f32x16{};
    const int vb0 = (int)(unsigned)(uintptr_t)vl + ((lane >> 4) & 1) * 32 + (lane & 3) * 8 + (4 * hi + ((lane & 15) >> 2)) * 64;
#pragma unroll
    for (int t = 0; t < 3; ++t) {
        const f32x16& pa = p[2 * t]; const f32x16& pb = p[2 * t + 1];
        const u32x4 w0 = {pk2(pa[0], pa[1]), pk2(pa[2], pa[3]), pk2(pa[4], pa[5]), pk2(pa[6], pa[7])}, w1 = {pk2(pa[8], pa[9]), pk2(pa[10], pa[11]), pk2(pa[12], pa[13]), pk2(pa[14], pa[15])};
        const u32x4 w2 = {pk2(pb[0], pb[1]), pk2(pb[2], pb[3]), pk2(pb[4], pb[5]), pk2(pb[6], pb[7])}, w3 = {pk2(pb[8], pb[9]), pk2(pb[10], pb[11]), pk2(pb[12], pb[13]), pk2(pb[14], pb[15])};
        pv64(o, vb0 + t * 8192, __builtin_bit_cast(bf16x8, w0), __builtin_bit_cast(bf16x8, w1), __builtin_bit_cast(bf16x8, w2), __builtin_bit_cast(bf16x8, w3));
    }
    int lane2 = threadIdx.x & 63; asm volatile("" : "+v"(lane2));
    const int r32b = lane2 & 31, hib = lane2 >> 5;
    LAS float* wsf = (LAS float*)(lds + AT_WSF) + wid * 64;
    if (hib == 0) wsf[r32b] = inv;
    LDS_WAIT(); __builtin_amdgcn_wave_barrier();
    float rli[16];
#pragma unroll
    for (int r = 0; r < 16; ++r) rli[r] = wsf[crow(r, hib)];
    LAS bf16* stg = (LAS bf16*)(lds + AT_OST) + wid * 2048;
#pragma unroll
    for (int r = 0; r < 16; ++r) { const int orow = crow(r, hib);
#pragma unroll
        for (int d0 = 0; d0 < 2; ++d0) stg[orow * 64 + d0 * 32 + r32b] = (bf16)(pk2(o[d0][r] * rli[r], 0.f) & 0xffffu); }
    LDS_WAIT(); __builtin_amdgcn_wave_barrier();
#pragma unroll
    for (int i = 0; i < 4; ++i) { const int row = i * 8 + (lane2 >> 3), ch = lane2 & 7; const u32x4 v = *(const LAS u32x4*)(stg + row * 64 + ch * 8);
        if (!samp) *(u32x4*)(MIX + ((size_t)b * SEQ + 64 * c + 32 * qh + row) * DM + 64 * head + ch * 8) = v;
        else if (qh == 0 && row < 16) *(u32x4*)(MIX + (size_t)(MPR + 16 * b + row) * DM + 64 * head + ch * 8) = v; }
    __syncthreads();
}

template <int W> __device__ __forceinline__ void pool_group(LAS unsigned char* dt, const float (&x0)[31], const float (&x1)[31], const int pos0, const bool fixed_cnt, const int lane) {
    float s0 = 0.f, s1 = 0.f;
#pragma unroll
    for (int k = 1; k < W; ++k) { s0 += x0[15 - k]; s1 += x1[15 - k]; }
#pragma unroll
    for (int i = 0; i < 16; ++i) {
        s0 += x0[15 + i]; s1 += x1[15 + i];
        const int pos = pos0 + i; const float cnt = fixed_cnt ? (float)W : (float)((pos + 1) < W ? (pos + 1) : W);
        const float ic = 1.0f / cnt;
        const float d0 = s0 * ic - x0[15 + i], d1 = s1 * ic - x1[15 + i];
        *(LAS unsigned*)(dt + i * 256 + ((((lane >> 2) ^ i) & 15) << 4) + (lane & 3) * 4) = pk2(d0, d1);
        s0 -= x0[15 + i - (W - 1)]; s1 -= x1[15 + i - (W - 1)];
    }
}
template <bool WLDS>
__device__ __forceinline__ void pool_item(LAS unsigned char* lds, const bf16* QKVU, bf16* MIX, const float* state_pool, const bf16* POOLW, const float* pool_scale,
                                          const int samp, const size_t row0  , const int sb  , const int g, const int wid) {
    int lane = threadIdx.x & 63; asm volatile("" : "+v"(lane));
    LAS unsigned char* dt = lds + PL_D + wid * 4096;
    const int fr = lane & 15, fq = lane >> 4;
    const int t0 = samp ? 1024 : (int)(row0 & (SEQ - 1));
    {
        float x0[31], x1[31];
        const int col = 768 + 128 * g + 2 * lane;
        unsigned wseg[16];
#pragma unroll
        for (int e = 0; e < 16; ++e) wseg[e] = *(const unsigned*)(QKVU + (row0 + e) * EVIN + col);
        if (samp) {
            const float* sp = state_pool + (size_t)sb * 15 * 512 + 128 * g + 2 * lane;
            f32x2 hv[15];
#pragma unroll
            for (int e = 0; e < 15; ++e) hv[e] = *(const f32x2*)(sp + (size_t)e * 512);
#pragma unroll
            for (int e = 0; e < 15; ++e) { x0[e] = hv[e][0]; x1[e] = hv[e][1]; }
        } else if (t0 == 0) {
#pragma unroll
            for (int e = 0; e < 15; ++e) { x0[e] = 0.f; x1[e] = 0.f; }
        } else {
            unsigned wh[15];
#pragma unroll
            for (int e = 0; e < 15; ++e) wh[e] = *(const unsigned*)(QKVU + (row0 - 15 + e) * EVIN + col);
#pragma unroll
            for (int e = 0; e < 15; ++e) { x0[e] = bf_lo(wh[e]); x1[e] = bf_hi(wh[e]); }
        }
#pragma unroll
        for (int e = 0; e < 16; ++e) { x0[15 + e] = bf_lo(wseg[e]); x1[15 + e] = bf_hi(wseg[e]); }
        if (g == 0) pool_group<2>(dt, x0, x1, t0, samp != 0, lane);
        else if (g == 1) pool_group<4>(dt, x0, x1, t0, samp != 0, lane);
        else if (g == 2) pool_group<8>(dt, x0, x1, t0, samp != 0, lane);
        else pool_group<16>(dt, x0, x1, t0, samp != 0, lane);
    }
    LDS_WAIT(); __builtin_amdgcn_wave_barrier();
    bf16x8 wf[8][4];
    if (WLDS) {
        const LAS unsigned char* pw = lds + PL_W + (g & 1) * 32768 + fr * 256;
#pragma unroll
        for (int nf = 0; nf < 8; ++nf)
#pragma unroll
            for (int ks = 0; ks < 4; ++ks) wf[nf][ks] = *(const LAS bf16x8*)(pw + nf * 4096 + ((((4 * ks + fq) ^ fr) & 15) << 4));
    } else {
        const bf16* wp = POOLW + (size_t)g * 16384 + (size_t)fr * 128 + 8 * fq;
#pragma unroll
        for (int nf = 0; nf < 8; ++nf)
#pragma unroll
            for (int ks = 0; ks < 4; ++ks) wf[nf][ks] = *(const bf16x8*)(wp + (size_t)nf * 16 * 128 + 32 * ks);
    }
    bf16x8 af[4];
#pragma unroll
    for (int ks = 0; ks < 4; ++ks) af[ks] = *(const LAS bf16x8*)(dt + fr * 256 + ((((4 * ks + fq) ^ fr) & 15) << 4));
    bf16* orow = MIX + (row0 + fr) * DM + 512 + 128 * g + 4 * fq;
#pragma unroll
    for (int nf = 0; nf < 8; nf += 2) {
        u32x2 wp[2];
#pragma unroll
        for (int h = 0; h < 2; ++h) {
            f32x4 acc = {0.f, 0.f, 0.f, 0.f};
#pragma unroll
            for (int ks = 0; ks < 4; ++ks) acc = __builtin_amdgcn_mfma_f32_16x16x32_bf16(wf[nf + h][ks], af[ks], acc, 0, 0, 0);
            wp[h].x = pk2(acc[0], acc[1]); wp[h].y = pk2(acc[2], acc[3]);
        }
        const auto rx = __builtin_amdgcn_permlane16_swap(wp[0].x, wp[1].x, false, false), ry = __builtin_amdgcn_permlane16_swap(wp[0].y, wp[1].y, false, false);
        u32x4 w4; w4.x = rx[0]; w4.y = ry[0]; w4.z = rx[1]; w4.w = ry[1];
        *(u32x4*)(orow - 4 * fq + 16 * (nf + (fq & 1)) + 8 * (fq >> 1)) = w4;
    }
    LDS_WAIT(); __builtin_amdgcn_wave_barrier();
}

template <int W> __device__ __forceinline__ void pool_seg_loads(const bf16* QKVU, const size_t row0, const int g, const int lane, unsigned (&raw)[W + 15]) {
    const bf16* p = QKVU + row0 * EVIN + 768 + 128 * g + 2 * lane;
#pragma unroll
    for (int e = 0; e < 16; ++e) raw[W - 1 + e] = *(const unsigned*)(p + (size_t)e * EVIN);
}
template <int W> __device__ __forceinline__ void pool_halo_loads(const bf16* QKVU, const size_t row0, const int g, const int lane, unsigned (&raw)[W + 15]) {
    const bf16* p = QKVU + row0 * EVIN + 768 + 128 * g + 2 * lane;
#pragma unroll
    for (int e = 0; e < W - 1; ++e) raw[e] = *(const unsigned*)(p - (size_t)(W - 1 - e) * EVIN);
}
template <int W> __device__ __forceinline__ void pool_halo_zero(unsigned (&raw)[W + 15]) {
#pragma unroll
    for (int e = 0; e < W - 1; ++e) raw[e] = 0u;
}
template <int W> __device__ __forceinline__ void pool_compute(LAS unsigned char* lds, bf16* MIX, const float* pool_scale, const unsigned (&raw)[W + 15], const size_t row0, const int t0, const int g, const int wid, const int lane) {
    LAS unsigned char* dt = lds + PL_D + wid * 4096;
    const int fr = lane & 15, fq = lane >> 4;
    float s0 = 0.f, s1 = 0.f;
#pragma unroll
    for (int e = 0; e < W - 1; ++e) { s0 += bf_lo(raw[e]); s1 += bf_hi(raw[e]); }
#pragma unroll
    for (int i = 0; i < 16; ++i) {
        const float u0 = bf_lo(raw[W - 1 + i]), u1 = bf_hi(raw[W - 1 + i]);
        s0 += u0; s1 += u1;
        const int pos = t0 + i; const float ic = 1.0f / (float)((pos + 1) < W ? (pos + 1) : W);
        *(LAS unsigned*)(dt + i * 256 + ((((lane >> 2) ^ i) & 15) << 4) + (lane & 3) * 4) = pk2(s0 * ic - u0, s1 * ic - u1);
        s0 -= bf_lo(raw[i]); s1 -= bf_hi(raw[i]);
    }
    LDS_WAIT(); __builtin_amdgcn_wave_barrier();
    bf16x8 wf[8][4];
    const LAS unsigned char* pw = lds + PL_W + (g & 1) * 32768 + fr * 256;
#pragma unroll
    for (int nf = 0; nf < 8; ++nf)
#pragma unroll
        for (int ks = 0; ks < 4; ++ks) wf[nf][ks] = *(const LAS bf16x8*)(pw + nf * 4096 + ((((4 * ks + fq) ^ fr) & 15) << 4));
    bf16x8 af[4];
#pragma unroll
    for (int ks = 0; ks < 4; ++ks) af[ks] = *(const LAS bf16x8*)(dt + fr * 256 + ((((4 * ks + fq) ^ fr) & 15) << 4));
    bf16* orow = MIX + (row0 + fr) * DM + 512 + 128 * g + 4 * fq;
#pragma unroll
    for (int nf = 0; nf < 8; nf += 2) {
        u32x2 wp[2];
#pragma unroll
        for (int h = 0; h < 2; ++h) {
            f32x4 acc = {0.f, 0.f, 0.f, 0.f};
#pragma unroll
            for (int ks = 0; ks < 4; ++ks) acc = __builtin_amdgcn_mfma_f32_16x16x32_bf16(wf[nf + h][ks], af[ks], acc, 0, 0, 0);
            wp[h].x = pk2(acc[0], acc[1]); wp[h].y = pk2(acc[2], acc[3]);
        }
        const auto rx = __builtin_amdgcn_permlane16_swap(wp[0].x, wp[1].x, false, false), ry = __builtin_amdgcn_permlane16_swap(wp[0].y, wp[1].y, false, false);
        u32x4 w4; w4.x = rx[0]; w4.y = ry[0]; w4.z = rx[1]; w4.w = ry[1];
        *(u32x4*)(orow - 4 * fq + 16 * (nf + (fq & 1)) + 8 * (fq >> 1)) = w4;
    }
    LDS_WAIT(); __builtin_amdgcn_wave_barrier();
}
__device__ __forceinline__ void pool_stage_weights(LAS unsigned char* lds, const u32x4 (&wv)[8], const int t2) {
#pragma unroll
    for (int i = 0; i < 8; ++i) { const int chunk = t2 + 512 * i, row = chunk >> 4, c16 = chunk & 15; *(LAS u32x4*)(lds + PL_W + row * 256 + (((c16 ^ row) & 15) << 4)) = wv[i]; }
}
__device__ __forceinline__ void pool_unit_prompt(LAS unsigned char* lds, const bf16* QKVU, bf16* MIX, const bf16* POOLW, const float* pool_scale, const size_t row0, const int wid) {
    int t2 = threadIdx.x; asm volatile("" : "+v"(t2)); const int lane = t2 & 63;
    const int t0 = (int)(row0 & (SEQ - 1));
    u32x4 wv0[8], wv1[8];
#pragma unroll
    for (int i = 0; i < 8; ++i) wv0[i] = *(const u32x4*)(POOLW + (size_t)(t2 + 512 * i) * 8);
    unsigned r0[17], r1[19], r2[23], r3[31];
    pool_seg_loads<2>(QKVU, row0, 0, lane, r0); pool_seg_loads<4>(QKVU, row0, 1, lane, r1); pool_seg_loads<8>(QKVU, row0, 2, lane, r2); pool_seg_loads<16>(QKVU, row0, 3, lane, r3);
    if (t0 != 0) { pool_halo_loads<2>(QKVU, row0, 0, lane, r0); pool_halo_loads<4>(QKVU, row0, 1, lane, r1); pool_halo_loads<8>(QKVU, row0, 2, lane, r2); pool_halo_loads<16>(QKVU, row0, 3, lane, r3); }
    else { pool_halo_zero<2>(r0); pool_halo_zero<4>(r1); pool_halo_zero<8>(r2); pool_halo_zero<16>(r3); }
#pragma unroll
    for (int i = 0; i < 8; ++i) wv1[i] = *(const u32x4*)(POOLW + 32768 + (size_t)(t2 + 512 * i) * 8);
    pool_stage_weights(lds, wv0, t2);
    __syncthreads();
    pool_compute<2>(lds, MIX, pool_scale, r0, row0, t0, 0, wid, lane);
    pool_compute<4>(lds, MIX, pool_scale, r1, row0, t0, 1, wid, lane);
    __syncthreads();
    pool_stage_weights(lds, wv1, t2);
    __syncthreads();
    pool_compute<8>(lds, MIX, pool_scale, r2, row0, t0, 2, wid, lane);
    pool_compute<16>(lds, MIX, pool_scale, r3, row0, t0, 3, wid, lane);
    __syncthreads();
}

struct Args { const float* in[21]; float* out; unsigned char* ws; int ph_lo, ph_hi; };
static_assert(sizeof(Args) == 21 * 8 + 8 + 8 + 8, "Args has no padding");
static_assert(RVT_OFF + RVT_UNITS * 1024 <= LDS_BYTES, "row-scale table fits");

#define CAS __attribute__((address_space(4)))
__global__ void __launch_bounds__(512, 2) trunk_fwd(Args args_unused) {
    extern __shared__ __attribute__((aligned(16))) unsigned char lds_raw[];
    LAS unsigned char* lds = (LAS unsigned char*)lds_raw;
    volatile LAS unsigned* MISC = (volatile LAS unsigned*)(lds + MISC_OFF);
    const int wave = __builtin_amdgcn_readfirstlane(threadIdx.x >> 6);
    const int G = gridDim.x; const int bx = blockIdx.x; const int vcu = (G % 8 == 0) ? (bx % 8) * (G / 8) + bx / 8 : bx;
    const CAS Args* kp0 = (const CAS Args*)__builtin_amdgcn_kernarg_segment_ptr();
#define KP(name) const CAS Args* name = kp0; asm volatile("" : "+s"(name))
#define WSP(kp, off) ((kp)->ws + (off))
    for (int u = threadIdx.x; u < (LDS_BYTES - LDSCTL_OFF) / 4; u += 512) ((LAS unsigned*)(lds + LDSCTL_OFF))[u] = 0u;
    __syncthreads();
    XcdBarrier bar;
    { KP(kp); unsigned* ctl = (unsigned*)WSP(kp, WS_CTL); bar.bar = ctl + CW_BAR; bar.x = 0; bar.st = nullptr;
      if (N_LAUNCHES == 1) bar = xcd_barrier_post(ctl + CW_BAR, MISC + 8); }
#ifndef PROBE_DUP
#define PROBE_DUP (-1)
#endif
#define REP(k) for (int rep_ = 0; rep_ < ((PROBE_DUP == (k)) ? 2 : 1); ++rep_)
#define IN(k) (true)
#define PH_TID() int tid = threadIdx.x; asm volatile("" : "+v"(tid)); const int lane = tid & 63
#define SEAM(k) do { if (IN(k) && IN((k) + 1)) xcd_barrier(bar); } while (0)
    const int gw = vcu * 8 + wave, NGW = G * 8;

    REP(0) {
    if (IN(0)) {
        PH_TID(); KP(kp); unsigned char* ws = kp->ws; float* out = kp->out;
        const float* x_prompt = kp->in[0]; const float* x_sample = kp->in[1]; const float* cache_k = kp->in[2]; const float* cache_v = kp->in[3];
        const float* norm_mix = kp->in[6]; const float* norm_ffn = kp->in[7]; const float* ffn_w1 = kp->in[8]; const float* ffn_w2 = kp->in[9]; const float* ev_w_in = kp->in[10]; const float* ev_w_out = kp->in[11];
        const float* pool_w = kp->in[16]; const float* conv_w_in = kp->in[18]; const float* conv_w_out = kp->in[20];
        float* RINV0 = (float*)(ws + WS_RINV0); bf16* POOLW = (bf16*)(ws + WS_POOLW); bf16* WIN = (bf16*)(ws + WS_WIN); bf16* WOUT = (bf16*)(ws + WS_WOUT); bf16* W1 = (bf16*)(ws + WS_W1); bf16* W2 = (bf16*)(ws + WS_W2);
        bf16* WCIN = (bf16*)(ws + WS_WCIN); bf16* WCOUT = (bf16*)(ws + WS_WCOUT); bf16* S1 = (bf16*)(ws + WS_S1);
        LAS float* scr = (LAS float*)(lds + RING_OFF + wave * 16384);
        constexpr int I_IN = 16 * 20, I_OUT = 16 * 16, I_W1 = 16 * 64, I_W2 = 64 * 16, I_CIN = 16 * 48, I_COUT = 16 * 16, I_PW = 4 * 4;
        constexpr int NITEMS = I_IN + I_OUT + I_W1 + I_W2 + I_CIN + I_COUT + I_PW;
        for (int it = gw; it < NITEMS; it += NGW) {
            int r = it;
            if (r < I_IN) { transpose_item<true>(ev_w_in, DM, EVIN, WIN, norm_mix, scr, r, lane); continue; } r -= I_IN;
            if (r < I_OUT) { transpose_item<false>(ev_w_out, DM, DM, WOUT, nullptr, scr, r, lane); continue; } r -= I_OUT;
            if (r < I_W1) { transpose_item<true>(ffn_w1, DM, DFF, W1, norm_ffn, scr, r, lane); continue; } r -= I_W1;
            if (r < I_W2) { transpose_item<false, true>(ffn_w2, DFF, DM, W2, nullptr, scr, r, lane); continue; } r -= I_W2;
            if (r < I_CIN) { transpose_item<true>(conv_w_in, DM, CIN, WCIN, norm_mix + DM, scr, r, lane); continue; } r -= I_CIN;
            if (r < I_COUT) { transpose_item<false>(conv_w_out, DM, DM, WCOUT, nullptr, scr, r, lane); continue; } r -= I_COUT;
            { const int g = r >> 2; transpose_item<false, false, true>(pool_w + (size_t)g * 16384, 128, 128, POOLW + (size_t)g * 16384, kp->in[17] + 128 * g, scr, r & 3, lane); }
        }
        for (int m = gw * 4; m < MT; m += NGW * 4) {
            const float* xr = (m < MPR) ? x_prompt + (size_t)m * DM : x_sample + (size_t)(m - MPR) * DM;
            const f32x4* x4 = (const f32x4*)xr + lane;
            f32x4 v[4][4]; float sr[4];
#pragma unroll
            for (int q = 0; q < 4; ++q)
#pragma unroll
                for (int j = 0; j < 4; ++j) v[q][j] = x4[256 * q + 64 * j];
#pragma unroll
            for (int q = 0; q < 4; ++q) { sr[q] = (sq4(v[q][0]) + sq4(v[q][1])) + (sq4(v[q][2]) + sq4(v[q][3])); }
#pragma unroll
            for (int o = 1; o < 64; o <<= 1) {
#pragma unroll
                for (int q = 0; q < 4; ++q) sr[q] += __shfl_xor(sr[q], o); }
            if (lane < 4) { const float sv = lane == 0 ? sr[0] : (lane == 1 ? sr[1] : (lane == 2 ? sr[2] : sr[3])); RINV0[m + lane] = rsqrtf(sv * (1.0f / 1024.0f) + EPS); }
#pragma unroll
            for (int q = 0; q < 4; ++q) { u32x2* o8 = (u32x2*)(S1 + (size_t)(m + q) * DM) + lane;
#pragma unroll
                for (int j = 0; j < 4; ++j) { u32x2 w; w.x = pk2(v[q][j][0], v[q][j][1]); w.y = pk2(v[q][j][2], v[q][j][3]); o8[64 * j] = w; } }
        }
        { const f32x4* ck = (const f32x4*)cache_k; const f32x4* cv = (const f32x4*)cache_v; f32x4* ok = (f32x4*)(out + O_KS); f32x4* ov = (f32x4*)(out + O_VS);
          for (int e = vcu * 512 + tid; e < 2 * 8 * 3584; e += G * 512) { const int which = e / 28672, rem = e % 28672, b = rem / 3584, i = rem % 3584;
              if (which == 0) ok[b * 4096 + i] = ck[b * 4096 + 512 + i]; else ov[b * 4096 + i] = cv[b * 4096 + 512 + i]; } }
    }
    SEAM(0);
    }

    REP(1) {
    if (IN(1)) {
        PH_TID(); KP(kp); unsigned char* ws = kp->ws; float* out = kp->out; const float* q_norm = kp->in[12]; const float* k_norm = kp->in[13];
        bf16* S1 = (bf16*)(ws + WS_S1); bf16* WIN = (bf16*)(ws + WS_WIN); bf16* QKVU = (bf16*)(ws + WS_QKVU); float* RINV0 = (float*)(ws + WS_RINV0);
        { BRowPlain br{WIN, DM, 4}; SEpiInProj SE{QKVU, RINV0, q_norm, k_norm, out};
          sample_gemm<DM, 4, 4>(lds + RING_OFF, S1 + (size_t)MPR * DM, 20, (bx + G / 2) % G, G, br, SE, lane, wave); }
        pg8::MapHead<DM> mp{(const char*)S1, (const char*)WIN}; pg8::StaticOrder S; S.init(NTILE, EVIN / 256, G, bx);
        pg8::EpiInProj E{QKVU, RINV0, q_norm, k_norm, out};
        pg8::gemm_phase<DM, pg8::EpiInProj, pg8::MapHead<DM>>(lds + RING_OFF, mp, S, E);
        { const int nun = NTILE * (EVIN / 256), rem = nun % G, nlate = (rem == 0) ? G : G - rem;
          if (rem == 0 || bx >= rem) {
              const float* norm_ffn = kp->in[7]; const float* ffn_w1 = kp->in[8]; const float* ffn_w2 = kp->in[9];
              bf16* W1B = (bf16*)(out + O_YP); bf16* W2B = (bf16*)(ws + WS_W2B);
              LAS float* scr = (LAS float*)(lds + RING_OFF + wave * 16384);
              constexpr int I_W1 = 16 * 64, I_W2 = 64 * 16;
              for (int it = ((rem == 0) ? bx : bx - rem) * 8 + wave; it < I_W1 + I_W2; it += nlate * 8) {
                  if (it < I_W1) transpose_item<true>(ffn_w1 + (size_t)DM * DFF, DM, DFF, W1B, norm_ffn + DM, scr, it, lane);
                  else transpose_item<false, true>(ffn_w2 + (size_t)DFF * DM, DFF, DM, W2B, nullptr, scr, it - I_W1, lane); } } }
    }
    SEAM(1);
    }

    REP(2) {
    if (IN(2)) {
        PH_TID(); KP(kp); unsigned char* ws = kp->ws; const float* cache_k = kp->in[2]; const float* cache_v = kp->in[3]; const float* state_pool = kp->in[4];
        const float* attn_sinks = kp->in[14]; const float* rel_bias = kp->in[15]; const float* pool_scale = kp->in[17];
        bf16* QKVU = (bf16*)(ws + WS_QKVU); bf16* POOLW = (bf16*)(ws + WS_POOLW);
        bf16* MIX = (bf16*)(ws + WS_S0);
        { LAS float* bt = (LAS float*)(lds + AT_BIAS);
          for (int e = tid; e < 8 * 256; e += 512) { const int h = e >> 8, idx = e & 255; float v = 0.f;
              if (idx < 255) { const int rel = idx - 191, n = rel < 0 ? -rel : rel; int bk = n < 8 ? n : (33 - __builtin_clz((unsigned)(n * n))); if (bk > 15) bk = 15; if (rel > 0) bk += 16; v = rel_bias[bk * 8 + h] * LOG2E; }
              bt[e] = v; } }
        __syncthreads();
        for (int un = vcu * 4, cnt = 0; un < 1040; ) {
            const int samp = un >= 1024 ? 1 : 0, sidx = un - 1024;
            const int ub = samp ? (sidx >> 1) : (un >> 9), ug = samp ? (sidx & 1) : ((un >> 8) & 1), uc = samp ? 0 : (un & 255);
            attn_unit(lds, QKVU, MIX, cache_k, cache_v, attn_sinks, samp, ub, uc, ug, wave);
            ++cnt;
            if (cnt < 4) ++un;
            else if (cnt == 4) un = (4 * G >= 1024) ? 1024 + vcu : 4 * G + vcu;
            else un += G;
        }
        for (int pu = vcu; pu < 256; pu += G) pool_unit_prompt(lds, QKVU, MIX, POOLW, pool_scale, (size_t)pu * 128 + wave * 16, wave);
        if (wave == 0) for (int it = (G >= 64) ? vcu - G / 2 : vcu; it >= 0 && it < 32; it += G) pool_item<false>(lds, QKVU, MIX, state_pool, POOLW, pool_scale, 1, (size_t)MPR + (it >> 2) * 16, it >> 2, it & 3, wave);
    }
    SEAM(2);
    }

    REP(3) {
    if (IN(3)) {
        PH_TID(); KP(kp); unsigned char* ws = kp->ws; float* out = kp->out; const float* x_prompt = kp->in[0]; const float* x_sample = kp->in[1];
        bf16* S0 = (bf16*)(ws + WS_S0); bf16* S1 = (bf16*)(ws + WS_S1); bf16* WOUT = (bf16*)(ws + WS_WOUT); float* SS = (float*)(ws + WS_SS); float* XP = out + O_YP; float* XS = out + O_YS;
        pg8::MapHead<DM> mp{(const char*)S0, (const char*)WOUT}; pg8::StaticOrder S; S.init(NTILE, DM / 256, G, bx);
        { BRowPlain br{WOUT, DM, 2}; SEpiResid<1, 2> SE{nullptr, S1, SS + (size_t)MT * 16, nullptr}; sample_gemm<DM, 2, 8>(lds + RING_OFF, S0 + (size_t)MPR * DM, 32, vcu, G, br, SE, lane, wave); }
        pg8::EpiResid<1> E{nullptr, S1, SS, nullptr};
        pg8::gemm_phase<DM, pg8::EpiResid<1>, pg8::MapHead<DM>>(lds + RING_OFF, mp, S, E);
    }
    SEAM(3);
    }
    REP(4) {
    if (IN(4)) {
        PH_TID(); KP(kp); unsigned char* ws = kp->ws; bf16* S1 = (bf16*)(ws + WS_S1); bf16* W1 = (bf16*)(ws + WS_W1); bf16* H = (bf16*)(ws + WS_H); float* SS = (float*)(ws + WS_SS);
        { BRowPlain br{W1, DM, 4}; SEpiUp SE{H, SS + (size_t)MT * 16}; sample_gemm<DM, 4, 4>(lds + RING_OFF, S1 + (size_t)MPR * DM, 64, vcu, G, br, SE, lane, wave); }
        pg8::MapHead<DM> mp{(const char*)S1, (const char*)W1}; pg8::StaticOrder S; S.init(NTILE, DFF / 256, G, bx);
        const int rsh = (G == 256) ? 2 : 0;
        build_row_scales(lds, S, SS, rsh);
        pg8::EpiUp E{H, (const LAS float*)(lds + RVT_OFF), SS, rsh};
        pg8::gemm_phase<DM, pg8::EpiUp, pg8::MapHead<DM>>(lds + RING_OFF, mp, S, E);
    }
    SEAM(4);
    }
    REP(5) {
    if (IN(5)) {
        PH_TID(); KP(kp); unsigned char* ws = kp->ws; float* out = kp->out; bf16* S1 = (bf16*)(ws + WS_S1); bf16* W2 = (bf16*)(ws + WS_W2); bf16* H = (bf16*)(ws + WS_H); float* SS = (float*)(ws + WS_SS); float* XP = out + O_YP; float* XS = out + O_YS;
        pg8::MapR5<DFF> mp{(const char*)H, (const char*)W2}; pg8::StaticOrder S; S.init(NTILE, DM / 256, G, bx);
        { BRowB32 br{W2, DFF, 2}; SEpiResid<1, 2> SE{nullptr, S1, SS + (size_t)MT * 16, nullptr}; sample_gemm<DFF, 2, 8>(lds + RING_OFF, H + (size_t)MPR * DFF, 32, vcu, G, br, SE, lane, wave); }
        pg8::EpiResid<1> E{nullptr, S1, SS, nullptr};
        { const unsigned st0 = MISC[8], st1 = MISC[9];
          pg8::gemm_phase_r5<DFF, pg8::EpiResid<1>, pg8::MapR5<DFF>>(lds + RING_OFF, mp, S, E);
          if (tid == 0) { MISC[8] = st0; MISC[9] = st1; } __syncthreads(); }
    }
    SEAM(5);
    }
    REP(6) {
    if (IN(6)) {
        PH_TID(); KP(kp); unsigned char* ws = kp->ws; float* out = kp->out; bf16* S1 = (bf16*)(ws + WS_S1); bf16* WCIN = (bf16*)(ws + WS_WCIN); bf16* BE = (bf16*)(ws + WS_H); float* SS = (float*)(ws + WS_SS);
        pg8::MapConvE<DM> mp{(const char*)S1, (const char*)WCIN}; pg8::StaticOrder S; S.init(NTILE, 8, G, bx);
        { BRowConvIn br{WCIN}; SEpiConvIn SE{BE, SS + (size_t)MT * 16, out}; sample_gemm<DM, 3, 4>(lds + RING_OFF, S1 + (size_t)MPR * DM, 64, vcu, G, br, SE, lane, wave); }
        const int rsh = (G == 256) ? 1 : 0;
        build_row_scales(lds, S, SS, rsh);
        pg8::EpiConvE E{BE, (const LAS float*)(lds + RVT_OFF), SS, out, rsh};
        pg8::gemm_phase<DM, pg8::EpiConvE, pg8::MapConvE<DM>>(lds + RING_OFF, mp, S, E);
    }
    SEAM(6);
    }
    REP(7) {
    if (IN(7)) {
        PH_TID(); KP(kp); unsigned char* ws = kp->ws; const float* state_conv = kp->in[5]; const float* conv_w = kp->in[19];
        bf16* S0 = (bf16*)(ws + WS_S0); bf16* S1 = (bf16*)(ws + WS_S1); bf16* WCIN = (bf16*)(ws + WS_WCIN); bf16* BE = (bf16*)(ws + WS_H); float* SS = (float*)(ws + WS_SS);
        for (int b = (G >= 8) ? vcu - (G - 8) : vcu; b >= 0 && b < 8; b += G) {
            const int cg = tid & 127, seg = tid >> 7;
            const f32x4 w0a = *(const f32x4*)(conv_w + 8 * cg), w0b = *(const f32x4*)(conv_w + 8 * cg + 4);
            const f32x4 w1a = *(const f32x4*)(conv_w + DM + 8 * cg), w1b = *(const f32x4*)(conv_w + DM + 8 * cg + 4);
            const f32x4 w2a = *(const f32x4*)(conv_w + 2 * DM + 8 * cg), w2b = *(const f32x4*)(conv_w + 2 * DM + 8 * cg + 4);
            const size_t r0 = (size_t)MPR + 16 * b + 4 * seg;
            f32x4 p2a, p2b, p1a, p1b;
            if (seg == 0) { const float* sp = state_conv + (size_t)b * 2 * DM + 8 * cg;
                p2a = *(const f32x4*)sp; p2b = *(const f32x4*)(sp + 4); p1a = *(const f32x4*)(sp + DM); p1b = *(const f32x4*)(sp + DM + 4); }
            else { const u32x4 e2 = *(const u32x4*)(BE + (r0 - 2) * 2048 + 1024 + 8 * cg), e1 = *(const u32x4*)(BE + (r0 - 1) * 2048 + 1024 + 8 * cg);
                p2a = (f32x4){bf_lo(e2.x), bf_hi(e2.x), bf_lo(e2.y), bf_hi(e2.y)}; p2b = (f32x4){bf_lo(e2.z), bf_hi(e2.z), bf_lo(e2.w), bf_hi(e2.w)};
                p1a = (f32x4){bf_lo(e1.x), bf_hi(e1.x), bf_lo(e1.y), bf_hi(e1.y)}; p1b = (f32x4){bf_lo(e1.z), bf_hi(e1.z), bf_lo(e1.w), bf_hi(e1.w)}; }
#pragma unroll
            for (int i = 0; i < 4; ++i) {
                const size_t r = r0 + i;
                const u32x4 bw = *(const u32x4*)(BE + r * 2048 + 8 * cg), ew = *(const u32x4*)(BE + r * 2048 + 1024 + 8 * cg);
                const f32x4 ea = {bf_lo(ew.x), bf_hi(ew.x), bf_lo(ew.y), bf_hi(ew.y)}, eb = {bf_lo(ew.z), bf_hi(ew.z), bf_lo(ew.w), bf_hi(ew.w)};
                const f32x4 ba = {bf_lo(bw.x), bf_hi(bw.x), bf_lo(bw.y), bf_hi(bw.y)}, bb = {bf_lo(bw.z), bf_hi(bw.z), bf_lo(bw.w), bf_hi(bw.w)};
                const f32x4 ya = w0a * p2a + w1a * p1a + w2a * ea, yb = w0b * p2b + w1b * p1b + w2b * eb;
                *(u32x4*)(S0 + r * DM + 8 * cg) = pk8(ba * ya, bb * yb);
                p2a = p1a; p2b = p1b; p1a = ea; p1b = eb;
            }
        }
        pg8::MapPlain<DM> mp{(const char*)S1, (const char*)WCIN}; pg8::StaticOrder S; S.init(NTILE, 4, G, bx);
        int tsh = 1;
        { pg8::StaticOrder S6; S6.init(NTILE, 8, G, bx);
          for (int i = 0; i < 6 && tsh; ++i) { pg8::Unit a6, a7; const bool h7 = S.next(i, a7), h6 = S6.next(2 * i, a6); if (h7 && (!h6 || a6.pm != a7.pm)) tsh = 0; if (!h7) break; } }
        if (!tsh) build_row_scales(lds, S, SS);
        else if (G == 256) tsh = 0;
        pg8::EpiConvB E{ws, conv_w, (const LAS float*)(lds + RVT_OFF), tsh};
        pg8::gemm_phase<DM, pg8::EpiConvB, pg8::MapPlain<DM>>(lds + RING_OFF, mp, S, E);
    }
    SEAM(7);
    }
    REP(8) {
    if (IN(8)) {
        PH_TID(); KP(kp); unsigned char* ws = kp->ws; float* out = kp->out; bf16* S0 = (bf16*)(ws + WS_S0); bf16* S1 = (bf16*)(ws + WS_S1); bf16* WCOUT = (bf16*)(ws + WS_WCOUT); float* SS = (float*)(ws + WS_SS); float* XP = out + O_YP; float* XS = out + O_YS;
        pg8::MapHead<DM> mp{(const char*)S0, (const char*)WCOUT}; pg8::StaticOrder S; S.init(NTILE, DM / 256, G, bx);
        { BRowPlain br{WCOUT, DM, 2}; SEpiResid<1, 2> SE{nullptr, S1, SS + (size_t)MT * 16, nullptr}; sample_gemm<DM, 2, 8>(lds + RING_OFF, S0 + (size_t)MPR * DM, 32, vcu, G, br, SE, lane, wave); }
        pg8::EpiResid<1> E{nullptr, S1, SS, nullptr};
        pg8::gemm_phase<DM, pg8::EpiResid<1>, pg8::MapHead<DM>>(lds + RING_OFF, mp, S, E);
    }
    SEAM(8);
    }
    REP(9) {
    if (IN(9)) {
        PH_TID(); KP(kp); unsigned char* ws = kp->ws; bf16* S1 = (bf16*)(ws + WS_S1); bf16* W1 = (bf16*)(kp->out + O_YP); bf16* H = (bf16*)(ws + WS_H); float* SS = (float*)(ws + WS_SS);
        { BRowPlain br{W1, DM, 4}; SEpiUp SE{H, SS + (size_t)MT * 16}; sample_gemm<DM, 4, 4>(lds + RING_OFF, S1 + (size_t)MPR * DM, 64, vcu, G, br, SE, lane, wave); }
        pg8::MapHead<DM> mp{(const char*)S1, (const char*)W1}; pg8::StaticOrder S; S.init(NTILE, DFF / 256, G, bx);
        const int rsh = (G == 256) ? 2 : 0;
        build_row_scales(lds, S, SS, rsh);
        pg8::EpiUp E{H, (const LAS float*)(lds + RVT_OFF), SS, rsh};
        pg8::gemm_phase<DM, pg8::EpiUp, pg8::MapHead<DM>>(lds + RING_OFF, mp, S, E);
    }
    SEAM(9);
    }
    if (IN(10)) {
        PH_TID(); KP(kp); unsigned char* ws = kp->ws; float* out = kp->out; bf16* S1 = (bf16*)(ws + WS_S1); bf16* W2 = (bf16*)(ws + WS_W2B); bf16* H = (bf16*)(ws + WS_H); float* XP = out + O_YP; float* XS = out + O_YS;
        pg8::MapR5<DFF> mp{(const char*)H, (const char*)W2}; pg8::StaticOrder S; S.init(NTILE, DM / 256, G, bx);
        { BRowB32 br{W2, DFF, 2}; SEpiResid<2, 2> SE{nullptr, S1, nullptr, XS}; sample_gemm<DFF, 2, 8>(lds + RING_OFF, H + (size_t)MPR * DFF, 32, vcu, G, br, SE, lane, wave); }
        pg8::EpiResid<2> E{nullptr, S1, nullptr, XP};
        pg8::gemm_phase_r5<DFF, pg8::EpiResid<2>, pg8::MapR5<DFF>>(lds + RING_OFF, mp, S, E);
    }
#undef IN
#undef SEAM
#undef KP
#undef WSP
}

extern "C" void kernel_launch(void* const* d_in, const int* in_sizes, int n_in, void* d_out, int out_size, void* d_ws, size_t ws_size, hipStream_t stream) {
    static int grid = 0;
    if (grid == 0) {
        if (n_in != 21 || in_sizes[0] != MPR * DM || (size_t)out_size != O_END || ws_size < WS_END) {
            fprintf(stderr, "kernel_launch: unexpected problem: n_in %d in0 %d out %d ws %zu (need %zu); nothing launched\n", n_in, n_in > 0 ? in_sizes[0] : -1, out_size, ws_size, (size_t)WS_END); grid = -1; return; }
        int dev = 0, cus = 0, per_cu = 0;
        if (hipGetDevice(&dev) != hipSuccess || hipDeviceGetAttribute(&cus, hipDeviceAttributeMultiprocessorCount, dev) != hipSuccess) { fprintf(stderr, "kernel_launch: device query failed\n"); grid = -1; return; }
        if (hipFuncSetAttribute((const void*)trunk_fwd, hipFuncAttributeMaxDynamicSharedMemorySize, LDS_BYTES) != hipSuccess) { fprintf(stderr, "kernel_launch: hipFuncSetAttribute failed\n"); grid = -1; return; }
        if (hipOccupancyMaxActiveBlocksPerMultiprocessor(&per_cu, (const void*)trunk_fwd, 512, LDS_BYTES) != hipSuccess || per_cu < 1) {
            fprintf(stderr, "kernel_launch: occupancy query reports %d workgroups per CU; nothing launched\n", per_cu); (void)hipGetLastError(); grid = -1; return; }
        grid = cus;
    }
    if (grid < 0) return;
    if (hipMemsetAsync((char*)d_ws + WS_CTL, 0, CTL_ZERO_BYTES, stream) != hipSuccess) { fprintf(stderr, "kernel_launch: memset failed\n"); return; }
    Args a{};
    for (int i = 0; i < 21; ++i) a.in[i] = (const float*)d_in[i];
    a.out = (float*)d_out; a.ws = (unsigned char*)d_ws;
    for (int li = 0; li < N_LAUNCHES; ++li) {
        a.ph_lo = (N_LAUNCHES == 1) ? 0 : li; a.ph_hi = (N_LAUNCHES == 1) ? NPH : li + 1;
        hipLaunchKernelGGL(trunk_fwd, dim3(grid), dim3(512), LDS_BYTES, stream, a);
        const hipError_t le = hipPeekAtLastError();
        if (le != hipSuccess) { fprintf(stderr, "kernel_launch: launch %d failed: %s\n", li, hipGetErrorName(le)); break; }
    }
}
```
